# Optimizing an MI355X kernel written in HIP

```python
import jax, jax.numpy as jnp
from jax import lax
import numpy as np

D_MODEL = 1024
BATCH = 1
SEQ = 16384
DEPTH = 4

HEAD_DIM = 64
ATTN_SCALE = HEAD_DIM ** -0.5
NORM_EPS = 1e-6
NEG_INF = -1e30

ROPE_THETA = 500000.0
ROPE_DIM = HEAD_DIM // 4

SWA_HEADS = 8
SWA_WIDTH = SWA_HEADS * HEAD_DIM
DILATED_PATTERNS = ((128, 1), (512, 4), (2048, 16))
SWA_BLOCK = 128

SSM_HEADS = 8
SSM_HEAD_DIM = 64
SSM_WIDTH = SSM_HEADS * SSM_HEAD_DIM
SSM_STATE = 128
SSM_GROUPS = 2
SSM_CONV = 4
SSM_CHUNK = 256
SSM_CONV_DIM = SSM_WIDTH + 2 * SSM_GROUPS * SSM_STATE

MOBA_HEADS = 8
MOBA_WIDTH = MOBA_HEADS * HEAD_DIM
MOBA_BLOCK = 256
MOBA_TOPK = 3
MOBA_QCHUNK = 128

MIX_WIDTH = SWA_WIDTH + SSM_WIDTH + MOBA_WIDTH
IN_PROJ = 3 * SWA_WIDTH + 3 * MOBA_WIDTH + SSM_WIDTH + SSM_CONV_DIM + SSM_HEADS

FFN_HIDDEN = -(-8 * D_MODEL // (3 * 256)) * 256

kernel_name = "hybrid_dilated_ssd_moba_trunk"


def _rms_norm(x, g):
    x32 = x.astype(jnp.float32)
    y = x32 * lax.rsqrt(jnp.mean(x32 * x32, axis=-1, keepdims=True) + NORM_EPS)
    return (y * g.astype(jnp.float32)).astype(x.dtype)


def _rope_tables(seq):
    pos = jnp.arange(seq, dtype=jnp.float32)
    inv = ROPE_THETA ** (-jnp.arange(0, ROPE_DIM, 2, dtype=jnp.float32) / ROPE_DIM)
    ang = pos[:, None] * inv[None, :]
    return jnp.cos(ang), jnp.sin(ang)


def _apply_rope(t, cos, sin):
    half = ROPE_DIM // 2
    xr = t[..., :ROPE_DIM].astype(jnp.float32)
    x1, x2 = xr[..., :half], xr[..., half:]
    rot = jnp.concatenate([x1 * cos - x2 * sin, x2 * cos + x1 * sin], axis=-1)
    return jnp.concatenate([rot.astype(t.dtype), t[..., ROPE_DIM:]], axis=-1)


def _split_heads(t, n_heads):
    b, s, _ = t.shape
    return t.reshape(b, s, n_heads, HEAD_DIM).transpose(0, 2, 1, 3)


def _merge_heads(t):
    b, h, s, d = t.shape
    return t.transpose(0, 2, 1, 3).reshape(b, s, h * d)


def _prep_qk(t, n_heads, gain, cos, sin):
    return _apply_rope(_rms_norm(_split_heads(t, n_heads), gain), cos, sin)


def _dilated_branch(q, k, v, window, dilation):
    b, h, s, dh = q.shape
    band = window // dilation
    assert band <= SWA_BLOCK
    span = dilation * SWA_BLOCK
    s_pad = -(-s // span) * span
    pad = [(0, 0), (0, 0), (0, s_pad - s), (0, 0)]

    def to_blocks(t):
        t = jnp.pad(t, pad).reshape(b, h, s_pad // dilation, dilation, dh)
        t = jnp.swapaxes(t, 2, 3)
        return t.reshape(b, h, dilation, -1, SWA_BLOCK, dh)

    def with_prev(t):
        prev = jnp.pad(t, [(0, 0)] * 3 + [(1, 0), (0, 0), (0, 0)])[:, :, :, :-1]
        return jnp.concatenate([prev, t], axis=4)

    qb, kb, vb = to_blocks(q), to_blocks(k), to_blocks(v)
    kk, vv = with_prev(kb), with_prev(vb)
    nb = qb.shape[3]
    sc = jnp.einsum('bhrnqd,bhrnkd->bhrnqk', qb, kk,
                    preferred_element_type=jnp.float32) * ATTN_SCALE
    qi = jnp.arange(SWA_BLOCK)[:, None]
    ki = jnp.arange(2 * SWA_BLOCK)[None, :]
    dist = qi + SWA_BLOCK - ki
    band_mask = (dist >= 0) & (dist <= band)
    blk_ok = (jnp.arange(nb)[:, None, None] > 0) | (ki >= SWA_BLOCK)[None]
    mask = band_mask[None] & blk_ok
    sc = jnp.where(mask, sc, NEG_INF)
    m = jnp.max(sc, axis=-1, keepdims=True)
    p = jnp.exp(sc - m)
    l = jnp.sum(p, axis=-1, keepdims=True)
    num = jnp.einsum('bhrnqk,bhrnkd->bhrnqd', p.astype(v.dtype), vv,
                     preferred_element_type=jnp.float32)

    def from_blocks(t):
        t = t.reshape(b, h, dilation, -1, t.shape[-1])
        t = jnp.swapaxes(t, 2, 3).reshape(b, h, s_pad, -1)
        return t[:, :, :s]

    return from_blocks(num), from_blocks(m), from_blocks(l)


def _dilated_attention(q, k, v):
    parts = [_dilated_branch(q, k, v, w, d) for (w, d) in DILATED_PATTERNS]
    m_all = parts[0][1]
    for _, m_i, _ in parts[1:]:
        m_all = jnp.maximum(m_all, m_i)
    num = 0.0
    den = 0.0
    for n_i, m_i, l_i in parts:
        w_i = jnp.exp(m_i - m_all)
        num = num + w_i * n_i
        den = den + w_i * l_i
    return (num / den).astype(q.dtype)


def _moba_attention(q, k, v):
    b, h, s, dh = q.shape
    s_pad = -(-s // MOBA_BLOCK) * MOBA_BLOCK
    pad = [(0, 0), (0, 0), (0, s_pad - s), (0, 0)]
    qp, kp, vp = jnp.pad(q, pad), jnp.pad(k, pad), jnp.pad(v, pad)
    nb = s_pad // MOBA_BLOCK
    kblk = kp.reshape(b, h, nb, MOBA_BLOCK, dh)
    vblk = vp.reshape(b, h, nb, MOBA_BLOCK, dh)
    kmean = jnp.mean(kblk.astype(jnp.float32), axis=3)
    gate = jnp.einsum('bhsd,bhnd->bhsn', qp, kmean.astype(qp.dtype),
                      preferred_element_type=jnp.float32)
    qblk = jnp.arange(s_pad) // MOBA_BLOCK
    past = jnp.arange(nb)[None, :] < qblk[:, None]
    gate = jnp.where(past, gate, NEG_INF)
    n_cols = max(nb, MOBA_TOPK)
    if n_cols > nb:
        gate = jnp.pad(gate, [(0, 0)] * 3 + [(0, n_cols - nb)], constant_values=NEG_INF)
    _, sel = lax.top_k(gate, MOBA_TOPK)
    valid = sel < qblk[:, None]
    sel = jnp.minimum(sel, nb - 1)

    nq = s_pad // MOBA_QCHUNK

    def chunks(t):
        return t.reshape(b, h, nq, MOBA_QCHUNK, t.shape[-1]).transpose(2, 0, 1, 3, 4)

    gather = jax.vmap(jax.vmap(lambda blocks, ids: blocks[ids]))
    n_sel = MOBA_TOPK * MOBA_BLOCK

    def step(args):
        qc, sc_idx, vc, ci = args
        kg = gather(kblk, sc_idx)
        vg = gather(vblk, sc_idx)
        own = (ci * MOBA_QCHUNK) // MOBA_BLOCK
        ko = lax.dynamic_index_in_dim(kblk, own, axis=2, keepdims=False)
        vo = lax.dynamic_index_in_dim(vblk, own, axis=2, keepdims=False)
        s_sel = jnp.einsum('bhqd,bhqjkd->bhqjk', qc, kg,
                           preferred_element_type=jnp.float32) * ATTN_SCALE
        s_sel = jnp.where(vc[..., None], s_sel, NEG_INF).reshape(b, h, MOBA_QCHUNK, n_sel)
        s_own = jnp.einsum('bhqd,bhkd->bhqk', qc, ko,
                           preferred_element_type=jnp.float32) * ATTN_SCALE
        qpos = ci * MOBA_QCHUNK + jnp.arange(MOBA_QCHUNK)
        kpos = own * MOBA_BLOCK + jnp.arange(MOBA_BLOCK)
        s_own = jnp.where(kpos[None, :] <= qpos[:, None], s_own, NEG_INF)
        p = jax.nn.softmax(jnp.concatenate([s_sel, s_own], axis=-1), axis=-1).astype(v.dtype)
        p_sel = p[..., :n_sel].reshape(b, h, MOBA_QCHUNK, MOBA_TOPK, MOBA_BLOCK)
        out = (jnp.einsum('bhqjk,bhqjkd->bhqd', p_sel, vg, preferred_element_type=jnp.float32)
               + jnp.einsum('bhqk,bhkd->bhqd', p[..., n_sel:], vo,
                            preferred_element_type=jnp.float32))
        return out.astype(q.dtype)

    out = lax.map(step, (chunks(qp), chunks(sel), chunks(valid), jnp.arange(nq)))
    out = out.transpose(1, 2, 0, 3, 4).reshape(b, h, s_pad, dh)
    return out[:, :, :s]


def _ssd_mixer(z, xbc, dt_raw, conv_w, conv_b, dt_bias, a_log, d_skip, norm_w):
    b, s, _ = xbc.shape
    xbc = lax.conv_general_dilated(
        xbc, conv_w[:, None, :], window_strides=(1,), padding=((SSM_CONV - 1, 0),),
        dimension_numbers=('NWC', 'WIO', 'NWC'), feature_group_count=SSM_CONV_DIM) + conv_b
    xbc = jax.nn.silu(xbc).astype(jnp.float32)
    gn = SSM_GROUPS * SSM_STATE
    xs = xbc[..., :SSM_WIDTH].reshape(b, s, SSM_HEADS, SSM_HEAD_DIM)
    bm = xbc[..., SSM_WIDTH:SSM_WIDTH + gn].reshape(b, s, SSM_GROUPS, SSM_STATE)
    cm = xbc[..., SSM_WIDTH + gn:].reshape(b, s, SSM_GROUPS, SSM_STATE)
    dt = jax.nn.softplus(dt_raw.astype(jnp.float32) + dt_bias.astype(jnp.float32))
    a = -jnp.exp(a_log.astype(jnp.float32))

    s_pad = -(-s // SSM_CHUNK) * SSM_CHUNK
    nc = s_pad // SSM_CHUNK

    def pad_seq(t):
        return jnp.pad(t, [(0, 0), (0, s_pad - s)] + [(0, 0)] * (t.ndim - 2))

    x_c = pad_seq(xs).reshape(b, nc, SSM_CHUNK, SSM_HEADS, SSM_HEAD_DIM)
    dt_c = pad_seq(dt).reshape(b, nc, SSM_CHUNK, SSM_HEADS)
    b_c = pad_seq(bm).reshape(b, nc, SSM_CHUNK, SSM_GROUPS, SSM_STATE)
    c_c = pad_seq(cm).reshape(b, nc, SSM_CHUNK, SSM_GROUPS, SSM_STATE)
    hpg = SSM_HEADS // SSM_GROUPS
    b_h = jnp.repeat(b_c, hpg, axis=3)
    c_h = jnp.repeat(c_c, hpg, axis=3)

    da_cs = jnp.cumsum((dt_c * a).transpose(0, 3, 1, 2), axis=-1)
    xdt = x_c * dt_c[..., None]
    seg = da_cs[..., :, None] - da_cs[..., None, :]
    causal = jnp.tril(jnp.ones((SSM_CHUNK, SSM_CHUNK), dtype=bool))
    decay = jnp.exp(jnp.where(causal, seg, NEG_INF))
    cb = jnp.einsum('bclgn,bcsgn->bgcls', c_c, b_c)
    cb = jnp.repeat(cb, hpg, axis=1)
    y_diag = jnp.einsum('bhcls,bcshp->bclhp', cb * decay, xdt)

    decay_to_end = jnp.exp(da_cs[..., -1:] - da_cs)
    states = jnp.einsum('bclhn,bhcl,bclhp->bchpn', b_h, decay_to_end, xdt)
    chunk_decay = jnp.exp(da_cs[..., -1])

    def scan_fn(hst, inp):
        st, dec = inp
        return hst * dec[..., None, None] + st, hst

    h0 = jnp.zeros((b, SSM_HEADS, SSM_HEAD_DIM, SSM_STATE), jnp.float32)
    _, h_in = lax.scan(scan_fn, h0, (states.transpose(1, 0, 2, 3, 4),
                                     chunk_decay.transpose(2, 0, 1)))
    h_in = h_in.transpose(1, 0, 2, 3, 4)
    y_off = jnp.einsum('bclhn,bchpn,bhcl->bclhp', c_h, h_in, jnp.exp(da_cs))
    y = y_diag + y_off + x_c * d_skip.astype(jnp.float32)[:, None]
    y = y.reshape(b, s_pad, SSM_WIDTH)[:, :s]

    g = y * jax.nn.silu(z.astype(jnp.float32))
    g = g.reshape(b, s, SSM_GROUPS, SSM_WIDTH // SSM_GROUPS)
    g = g * lax.rsqrt(jnp.mean(g * g, axis=-1, keepdims=True) + NORM_EPS)
    g = g.reshape(b, s, SSM_WIDTH) * norm_w.astype(jnp.float32)
    return g.astype(z.dtype)


def _token_mixer(h, w_in, qn_swa, kn_swa, qn_moba, kn_moba, conv_w, conv_b,
                 dt_bias, a_log, d_skip, ssm_norm, w_out, cos, sin):
    proj = h @ w_in
    sizes = [SWA_WIDTH] * 3 + [MOBA_WIDTH] * 3 + [SSM_WIDTH, SSM_CONV_DIM, SSM_HEADS]
    q_a, k_a, v_a, q_c, k_c, v_c, z, xbc, dt_raw = jnp.split(
        proj, np.cumsum(sizes)[:-1].tolist(), axis=-1)
    y_a = _dilated_attention(_prep_qk(q_a, SWA_HEADS, qn_swa, cos, sin),
                             _prep_qk(k_a, SWA_HEADS, kn_swa, cos, sin),
                             _split_heads(v_a, SWA_HEADS))
    y_b = _ssd_mixer(z, xbc, dt_raw, conv_w, conv_b, dt_bias, a_log, d_skip, ssm_norm)
    y_c = _moba_attention(_prep_qk(q_c, MOBA_HEADS, qn_moba, cos, sin),
                          _prep_qk(k_c, MOBA_HEADS, kn_moba, cos, sin),
                          _split_heads(v_c, MOBA_HEADS))
    mix = jnp.concatenate([_merge_heads(y_a), y_b, _merge_heads(y_c)], axis=-1)
    return mix @ w_out


def setup_inputs(seed: int = 0) -> dict:
    key = jax.random.key(seed)
    ks = jax.random.split(key, 24)
    f32 = jnp.float32

    def nrm(k, shape, scale):
        return jax.random.normal(k, shape, f32) * scale

    dt0 = jnp.exp(jax.random.uniform(ks[13], (DEPTH, SSM_HEADS), f32,
                                     np.log(1e-3), np.log(1e-1)))
    return {
        "x": nrm(ks[0], (BATCH, SEQ, D_MODEL), 1.0),
        "c": nrm(ks[1], (BATCH, D_MODEL), 1.0),
        "ada_w": nrm(ks[2], (DEPTH, D_MODEL, 6 * D_MODEL), 0.5 * D_MODEL ** -0.5),
        "ada_b": nrm(ks[3], (DEPTH, 6 * D_MODEL), 0.02),
        "norm_mix": 1.0 + nrm(ks[4], (DEPTH, D_MODEL), 0.02),
        "w_in": nrm(ks[5], (DEPTH, D_MODEL, IN_PROJ), D_MODEL ** -0.5),
        "qn_swa": 1.0 + nrm(ks[6], (DEPTH, HEAD_DIM), 0.02),
        "kn_swa": 1.0 + nrm(ks[7], (DEPTH, HEAD_DIM), 0.02),
        "qn_moba": 1.0 + nrm(ks[8], (DEPTH, HEAD_DIM), 0.02),
        "kn_moba": 1.0 + nrm(ks[9], (DEPTH, HEAD_DIM), 0.02),
        "conv_w": nrm(ks[10], (DEPTH, SSM_CONV, SSM_CONV_DIM), SSM_CONV ** -0.5),
        "conv_b": nrm(ks[11], (DEPTH, SSM_CONV_DIM), 0.02),
        "dt_bias": dt0 + jnp.log(-jnp.expm1(-dt0)),
        "a_log": jnp.log(jax.random.uniform(ks[12], (DEPTH, SSM_HEADS), f32, 1.0, 16.0)),
        "d_skip": 1.0 + nrm(ks[14], (DEPTH, SSM_HEADS), 0.1),
        "ssm_norm": 1.0 + nrm(ks[15], (DEPTH, SSM_WIDTH), 0.02),
        "w_out": nrm(ks[16], (DEPTH, MIX_WIDTH, D_MODEL), MIX_WIDTH ** -0.5),
        "norm_ffn": 1.0 + nrm(ks[17], (DEPTH, D_MODEL), 0.02),
        "w_gate": nrm(ks[18], (DEPTH, D_MODEL, FFN_HIDDEN), D_MODEL ** -0.5),
        "w_up": nrm(ks[19], (DEPTH, D_MODEL, FFN_HIDDEN), D_MODEL ** -0.5),
        "w_down": nrm(ks[20], (DEPTH, FFN_HIDDEN, D_MODEL), FFN_HIDDEN ** -0.5),
    }


def reference(x, c, ada_w, ada_b, norm_mix, w_in, qn_swa, kn_swa, qn_moba, kn_moba,
              conv_w, conv_b, dt_bias, a_log, d_skip, ssm_norm, w_out, norm_ffn,
              w_gate, w_up, w_down):
    cos, sin = _rope_tables(x.shape[1])
    c_act = jax.nn.silu(c)
    for l in range(DEPTH):
        mod = (c_act @ ada_w[l] + ada_b[l])[:, None, :]
        shift_m, scale_m, gate_m, shift_f, scale_f, gate_f = jnp.split(mod, 6, axis=-1)
        h = _rms_norm(x, norm_mix[l]) * (1.0 + scale_m) + shift_m
        y = _token_mixer(h, w_in[l], qn_swa[l], kn_swa[l], qn_moba[l], kn_moba[l],
                         conv_w[l], conv_b[l], dt_bias[l], a_log[l], d_skip[l],
                         ssm_norm[l], w_out[l], cos, sin)
        x = x + gate_m * y
        h = _rms_norm(x, norm_ffn[l]) * (1.0 + scale_f) + shift_f
        ffn = (jax.nn.silu(h @ w_gate[l]) * (h @ w_up[l])) @ w_down[l]
        x = x + gate_f * ffn
    return x
```

```cpp
#include <hip/hip_runtime.h>
#include <cstdio>
#include <cstdint>
#define MK_ONE_LAUNCH 1
namespace pg8 {
#define PG8_LAS __attribute__((address_space(3)))
typedef unsigned short bf16_t;
typedef short bf16x8 __attribute__((ext_vector_type(8)));
typedef float f32x4 __attribute__((ext_vector_type(4)));
typedef unsigned u32x4 __attribute__((ext_vector_type(4)));
constexpr int BM = 256, BK = 64, HALF = 128, HTB = HALF * BK * 2  , STAGE_BYTES = 8 * HTB, NXCD = 8, WGM = 8;

__host__ __device__ __forceinline__ int lds_byte(int r, int c) { const int st = (r >> 4) * 2 + (c >> 5), rr = r & 15, cc = c & 31, ob = rr * 64 + cc * 2; return st * 1024 + (ob ^ (((ob >> 9) & 1) << 5)); }
__host__ __device__ __forceinline__ void stage_rc(int b, int& R, int& C) { const int st = b / 1024, sb = b % 1024, swz = sb ^ (((sb >> 9) & 1) << 5); R = (st >> 1) * 16 + swz / 64; C = (st & 1) * 32 + (swz % 64) / 2; }
__host__ __device__ __forceinline__ int perm32(int rho) { const int n = rho >> 4, i = rho & 15; return 8 * (i >> 2) + 4 * n + (i & 3); }

struct Unit { int pm, pn; };
struct Gemm { const bf16_t* A; const bf16_t* Bt; int M, N, K; };

struct StaticOrder {
    int nM, nN, nwg, G, c;
    __host__ __device__ void init(int M, int N, int G_, int c_) { nM = M / BM; nN = N / BM; nwg = nM * nN; G = G_; c = c_; }
    __host__ __device__ bool next(int i, Unit& u) const {
        const long L = (long)i * G + c; if (L >= nwg) return false;
        int wgid = (int)L; { const int q = nwg / NXCD, r = nwg % NXCD, xcd = wgid % NXCD, off = wgid / NXCD; wgid = (xcd < r ? xcd * (q + 1) : r * (q + 1) + (xcd - r) * q) + off; }
        const int nig = WGM * nN, gid = wgid / nig, fm = gid * WGM, gsz = (nM - fm) < WGM ? (nM - fm) : WGM;
        u.pm = fm + ((wgid % nig) % gsz); u.pn = (wgid % nig) / gsz; return true;
    }
    __device__ __forceinline__ void a_ready(const Unit&) const {}
    __device__ __forceinline__ void done(const Unit&) const {}
};

__device__ __forceinline__ unsigned cvt_pk_bf16(float lo, float hi) { unsigned r; asm volatile("v_cvt_pk_bf16_f32 %0, %1, %2" : "=v"(r) : "v"(lo), "v"(hi)); return r; }
typedef float f32x2 __attribute__((ext_vector_type(2)));
template <class Epi, class Sched, bool ALIGN_EPI = false, bool SP2 = false, int KC = 0>
__device__ __forceinline__ void gemm_phase(PG8_LAS unsigned char* lds, const Gemm g, const Sched& S, const Epi& E, const int tid_in) {
    int tid_ = tid_in; asm volatile("" : "+v"(tid_));
    const int tid = tid_, wid = __builtin_amdgcn_readfirstlane(tid >> 6), lane = tid & 63, wr = wid >> 2, wc = wid & 3, fr = lane & 15, fq = lane >> 4;
    const int K = KC ? KC : g.K, nt = K / BK;
    unsigned voffA[2], voffB[2];
#pragma unroll
    for (int i = 0; i < 2; ++i) { int R, C; stage_rc(tid * 16 + i * 8192, R, C); const int Rb = Epi::PERM ? ((R & ~31) + perm32(R & 31)) : R;
        voffA[i] = (unsigned)(R * K + C) * 2u; voffB[i] = (unsigned)(Rb * K + C) * 2u; }
    const size_t kstep = (size_t)(BK * 2);
    const size_t hstep = (size_t)HALF * K * 2;
    const size_t tstep = 2 * hstep;
    const unsigned ldsw = (unsigned)wid * 1024u;
    const int aoff = lds_byte(wr * 64 + fr, fq * 8), boff = lds_byte(wc * 32 + fr, fq * 8);
#define PG8_SA(b, h) (((b) * 2 + (h)) * HTB)
#define PG8_SB(b, h) ((4 + (b) * 2 + (h)) * HTB)
#define PG8_STAGE(bufoff, gbase, voff) do { _Pragma("unroll") for (int _i = 0; _i < 2; ++_i) \
        __builtin_amdgcn_global_load_lds((const unsigned*)((const char*)(gbase) + (voff)[_i]), (PG8_LAS unsigned*)(lds + (bufoff) + ldsw + _i * 8192), 16, 0, 0); } while (0)
#define PG8_LDA(dst, b, h) do { _Pragma("unroll") for (int m = 0; m < 4; ++m) _Pragma("unroll") for (int k = 0; k < 2; ++k) dst[m][k] = *(const PG8_LAS bf16x8*)(lds + PG8_SA(b, h) + aoff + m * 2048 + k * 1024); } while (0)
#define PG8_LDB(dst, b, h) do { _Pragma("unroll") for (int n = 0; n < 2; ++n) _Pragma("unroll") for (int k = 0; k < 2; ++k) dst[n][k] = *(const PG8_LAS bf16x8*)(lds + PG8_SB(b, h) + boff + n * 2048 + k * 1024); } while (0)
#define PG8_MMA(ai, bj, At, Bt) do { __builtin_amdgcn_s_setprio(1); _Pragma("unroll") for (int m = 0; m < 4; ++m) _Pragma("unroll") for (int n = 0; n < 2; ++n) _Pragma("unroll") for (int k = 0; k < 2; ++k) \
        acc[ai][bj][m][n] = __builtin_amdgcn_mfma_f32_16x16x32_bf16(Bt[n][k], At[m][k], acc[ai][bj][m][n], 0, 0, 0); __builtin_amdgcn_s_setprio(0); } while (0)
#define PG8_WAIT_V(n) asm volatile("s_waitcnt vmcnt(" #n ")" ::: "memory")
#define PG8_WAIT_L(n) asm volatile("s_waitcnt lgkmcnt(" #n ")" ::: "memory")
#define PG8_BAR __builtin_amdgcn_s_barrier()
#define PG8_SCHED __builtin_amdgcn_sched_barrier(0)
    Unit cur, nxt; int ui = 0;
    if (!S.next(0, cur)) return;
    f32x4 acc[2][2][4][2];
#pragma unroll
    for (int a = 0; a < 2; ++a)
#pragma unroll
        for (int b = 0; b < 2; ++b)
#pragma unroll
            for (int m = 0; m < 4; ++m)
#pragma unroll
                for (int n = 0; n < 2; ++n) acc[a][b][m][n] = (f32x4){0.f, 0.f, 0.f, 0.f};
    bf16x8 At[4][2], B0[2][2], B1[2][2];
    const char* cA = (const char*)g.A + (size_t)cur.pm * tstep; const char* cB = (const char*)g.Bt + (size_t)cur.pn * tstep;
    S.a_ready(cur);
    if constexpr (SP2) {
        PG8_STAGE(PG8_SB(0, 0), cB, voffB); PG8_STAGE(PG8_SB(0, 1), cB + hstep, voffB); PG8_STAGE(PG8_SA(0, 0), cA, voffA); PG8_STAGE(PG8_SA(0, 1), cA + hstep, voffA);
        if (wr == 1) PG8_BAR;
        PG8_WAIT_V(2); PG8_BAR;
        PG8_STAGE(PG8_SB(1, 0), cB + kstep, voffB); PG8_STAGE(PG8_SA(1, 0), cA + kstep, voffA); PG8_STAGE(PG8_SB(1, 1), cB + hstep + kstep, voffB);
        PG8_WAIT_V(6); PG8_BAR;
    } else {
        PG8_STAGE(PG8_SB(0, 0), cB, voffB); PG8_STAGE(PG8_SA(0, 0), cA, voffA); PG8_STAGE(PG8_SB(0, 1), cB + hstep, voffB); PG8_STAGE(PG8_SA(0, 1), cA + hstep, voffA);
        if (wr == 1) PG8_BAR;
        PG8_WAIT_V(4); PG8_BAR;
        PG8_STAGE(PG8_SB(1, 0), cB + kstep, voffB); PG8_STAGE(PG8_SA(1, 0), cA + kstep, voffA); PG8_STAGE(PG8_SB(1, 1), cB + hstep + kstep, voffB);
        PG8_WAIT_V(6); PG8_BAR;
    }
    for (;;) {
        const bool has_next = S.next(ui + 1, nxt);
        const char* nA = has_next ? (const char*)g.A + (size_t)nxt.pm * tstep : cA; const char* nB = has_next ? (const char*)g.Bt + (size_t)nxt.pn * tstep : cB;
        for (int t = 0; t < nt; t += 2) {
            const bool last = (t == nt - 2);
            const char* a1 = cA + (size_t)(t + 1) * kstep;
            const char* a2 = last ? nA : cA + (size_t)(t + 2) * kstep; const char* b2 = last ? nB : cB + (size_t)(t + 2) * kstep;
            const char* a3 = a2 + kstep; const char* b3 = b2 + kstep;
            if (last && has_next) S.a_ready(nxt);
            if constexpr (SP2) {
            PG8_LDB(B0, 0, 0); PG8_LDB(B1, 0, 1); PG8_SCHED; PG8_LDA(At, 0, 0); PG8_STAGE(PG8_SA(1, 1), a1 + hstep, voffA);
            PG8_WAIT_V(8); PG8_WAIT_L(0); PG8_BAR; PG8_MMA(0, 0, At, B0); PG8_MMA(0, 1, At, B1); PG8_BAR; PG8_SCHED;
            PG8_LDA(At, 0, 1); PG8_STAGE(PG8_SB(0, 0), b2, voffB); PG8_STAGE(PG8_SB(0, 1), b2 + hstep, voffB); PG8_STAGE(PG8_SA(0, 0), a2, voffA);
            PG8_WAIT_V(8); PG8_WAIT_L(0); PG8_BAR; PG8_MMA(1, 0, At, B0); PG8_MMA(1, 1, At, B1); PG8_BAR; PG8_SCHED;
            PG8_LDB(B0, 1, 0); PG8_LDB(B1, 1, 1); PG8_SCHED; PG8_LDA(At, 1, 0); PG8_STAGE(PG8_SA(0, 1), a2 + hstep, voffA);
            PG8_WAIT_V(8); PG8_WAIT_L(0); PG8_BAR; PG8_MMA(0, 0, At, B0); PG8_MMA(0, 1, At, B1); PG8_BAR; PG8_SCHED;
            PG8_LDA(At, 1, 1); PG8_STAGE(PG8_SB(1, 0), b3, voffB); PG8_STAGE(PG8_SB(1, 1), b3 + hstep, voffB); PG8_STAGE(PG8_SA(1, 0), a3, voffA);
            PG8_WAIT_V(8); PG8_WAIT_L(0); PG8_BAR; PG8_MMA(1, 0, At, B0); PG8_MMA(1, 1, At, B1); PG8_BAR; PG8_SCHED;
            } else {
            PG8_LDB(B0, 0, 0); PG8_SCHED; PG8_LDA(At, 0, 0); PG8_STAGE(PG8_SA(1, 1), a1 + hstep, voffA);
            PG8_WAIT_L(8); PG8_BAR; PG8_WAIT_L(0); PG8_MMA(0, 0, At, B0); PG8_BAR; PG8_SCHED;
            PG8_LDB(B1, 0, 1); PG8_STAGE(PG8_SB(0, 0), b2, voffB);
            PG8_BAR; PG8_WAIT_L(0); PG8_MMA(0, 1, At, B1); PG8_BAR;
            PG8_LDA(At, 0, 1); PG8_STAGE(PG8_SA(0, 0), a2, voffA);
            PG8_BAR; PG8_WAIT_L(0); PG8_MMA(1, 0, At, B0); PG8_BAR; PG8_SCHED;
            PG8_STAGE(PG8_SB(0, 1), b2 + hstep, voffB);
            PG8_WAIT_V(6); PG8_BAR; PG8_MMA(1, 1, At, B1); PG8_BAR;
            PG8_LDB(B0, 1, 0); PG8_SCHED; PG8_LDA(At, 1, 0); PG8_STAGE(PG8_SA(0, 1), a2 + hstep, voffA);
            PG8_WAIT_L(8); PG8_BAR; PG8_WAIT_L(0); PG8_MMA(0, 0, At, B0); PG8_BAR; PG8_SCHED;
            PG8_LDB(B1, 1, 1); PG8_STAGE(PG8_SB(1, 0), b3, voffB);
            PG8_BAR; PG8_WAIT_L(0); PG8_MMA(0, 1, At, B1); PG8_BAR;
            PG8_LDA(At, 1, 1); PG8_STAGE(PG8_SA(1, 0), a3, voffA);
            PG8_BAR; PG8_WAIT_L(0); PG8_MMA(1, 0, At, B0); PG8_BAR; PG8_SCHED;
            PG8_STAGE(PG8_SB(1, 1), b3 + hstep, voffB);
            PG8_WAIT_V(6); PG8_BAR; PG8_MMA(1, 1, At, B1); PG8_BAR;
            }
        }
        if constexpr (ALIGN_EPI) { if (wr == 0) PG8_BAR; }
        if constexpr (!Epi::AFTER_DRAIN) { E(acc, cur, wr, wc, fr, fq); S.done(cur); }
        if (!has_next) break;
#pragma unroll
        for (int a = 0; a < 2; ++a)
#pragma unroll
            for (int b = 0; b < 2; ++b)
#pragma unroll
                for (int m = 0; m < 4; ++m)
#pragma unroll
                    for (int n = 0; n < 2; ++n) acc[a][b][m][n] = (f32x4){0.f, 0.f, 0.f, 0.f};
        cur = nxt; cA = nA; cB = nB; ++ui;
        if constexpr (ALIGN_EPI) { if (wr == 1) PG8_BAR; }
    }
    PG8_WAIT_V(0);
    if constexpr (!ALIGN_EPI) { if (wr == 0) PG8_BAR; }
    PG8_BAR;
    if constexpr (Epi::AFTER_DRAIN) { E.fused(acc, cur, wr, wc, fr, fq, lds, wid, lane); S.done(cur); }
#undef PG8_SA
#undef PG8_SB
#undef PG8_STAGE
#undef PG8_LDA
#undef PG8_LDB
#undef PG8_MMA
#undef PG8_WAIT_V
#undef PG8_WAIT_L
#undef PG8_BAR
#undef PG8_SCHED
}
}
#define GAS __attribute__((address_space(1)))
#define LAS __attribute__((address_space(3)))
typedef unsigned short bf16;
typedef unsigned v4u __attribute__((ext_vector_type(4)));
typedef float f32x4 __attribute__((ext_vector_type(4)));
typedef short bf16x8 __attribute__((ext_vector_type(8)));
typedef GAS unsigned gu32;
typedef GAS unsigned long long gu64;
#define RLX_AGENT __ATOMIC_RELAXED, __HIP_MEMORY_SCOPE_AGENT
#define LDS_WAIT() asm volatile("s_waitcnt lgkmcnt(0)" ::: "memory")
#define VM_WAIT() asm volatile("s_waitcnt vmcnt(0)" ::: "memory")
__device__ __forceinline__ unsigned long long rt() { return __builtin_amdgcn_s_memrealtime(); }
__device__ __forceinline__ unsigned f2bf(float f) { unsigned u = __builtin_bit_cast(unsigned, f); return (u + 0x7fffu + ((u >> 16) & 1u)) >> 16; }
__device__ __forceinline__ unsigned pk2(float lo, float hi) { return f2bf(lo) | (f2bf(hi) << 16); }
#define XB_TMO      128
#define XB_XCNT(j)  (256  + 64 * (j))
#define XB_XSUB(j)  (1280 + 64 * (j))
#define XB_XGEN(j)  (2304 + 64 * (j))
#define XB_TOP      3328
#define XB_TOPGEN   3392
#define XCD_BAR_WORDS 3456
#define XB_SPIN_CAP (1u << 18)

__device__ __forceinline__ unsigned xb_ld(unsigned* p)              { return __hip_atomic_load(p, __ATOMIC_RELAXED, __HIP_MEMORY_SCOPE_AGENT); }
__device__ __forceinline__ unsigned xb_add(unsigned* p, unsigned v) { return __hip_atomic_fetch_add(p, v, __ATOMIC_RELAXED, __HIP_MEMORY_SCOPE_AGENT); }
__device__ __forceinline__ unsigned xb_xcc_id() { return (unsigned)__builtin_amdgcn_s_getreg((3 << 11) | 20) & 0xFu; }
#define XB_SPIN(cond, bar) do { unsigned _sp = 0; while (cond) { __builtin_amdgcn_s_sleep(1); \
    if ((++_sp & 255u) == 0u) { if (xb_ld(&(bar)[XB_TMO])) break; if (_sp > XB_SPIN_CAP) { atomicAdd(&(bar)[XB_TMO], 1u); break; } } } } while (0)

struct XcdBarrier {
    unsigned* bar; unsigned x;
    volatile LAS unsigned* st;
};

__device__ __forceinline__ XcdBarrier xcd_barrier_post(unsigned* bar, volatile LAS unsigned* st) {
    XcdBarrier b; b.bar = bar; b.x = xb_xcc_id(); b.st = st;
    if (threadIdx.x == 0) (void)xb_add(&bar[XB_XCNT(b.x)], 1u);
    return b;
}
__device__ __forceinline__ void xcd_barrier_complete(unsigned* bar, unsigned x, unsigned& nloc, unsigned& nx) {
    const unsigned G = gridDim.x * gridDim.y * gridDim.z;
    unsigned sum, cnt, mine, sp = 0u;
    for (;;) {
        sum = 0u; cnt = 0u; mine = 0u;
#pragma unroll
        for (unsigned j = 0; j < 16; ++j) { const unsigned c = xb_ld(&bar[XB_XCNT(j)]); sum += c; cnt += (c > 0u) ? 1u : 0u; mine = (j == x) ? c : mine; }
        if (sum == G) break;
        __builtin_amdgcn_s_sleep(1);
        if ((++sp & 255u) == 0u) { if (xb_ld(&bar[XB_TMO])) break; if (sp > XB_SPIN_CAP) { atomicAdd(&bar[XB_TMO], 1u); break; } }
    }
    nloc = mine > 0u ? mine : 1u; nx = cnt > 0u ? cnt : 1u;
}

__device__ __forceinline__ void xcd_barrier(const XcdBarrier& b) {
    asm volatile("s_waitcnt vmcnt(0)" ::: "memory");
    __syncthreads();
    if (threadIdx.x == 0) {
        unsigned* bar = b.bar;
        __builtin_amdgcn_s_waitcnt(0);
        unsigned nloc = b.st[0], nx = b.st[1];
        if (nloc == 0u) { xcd_barrier_complete(bar, b.x, nloc, nx); b.st[0] = nloc; b.st[1] = nx; }
        const unsigned old = xb_add(&bar[XB_XSUB(b.x)], 1u);
        const unsigned gen = old / nloc;
        if (old + 1u == (gen + 1u) * nloc) {
            __builtin_amdgcn_fence(__ATOMIC_RELEASE, "agent");
            asm volatile("s_waitcnt vmcnt(0)" ::: "memory");
            const unsigned og = xb_add(&bar[XB_TOP], 1u);
            const unsigned tg = og / nx;
            if (og + 1u == (tg + 1u) * nx) xb_add(&bar[XB_TOPGEN], 1u);
            else XB_SPIN(xb_ld(&bar[XB_TOPGEN]) == tg, bar);
            __builtin_amdgcn_fence(__ATOMIC_ACQUIRE, "agent");
            xb_add(&bar[XB_XGEN(b.x)], 1u);
            asm volatile("s_waitcnt vmcnt(0)" ::: "memory");
        } else {
            XB_SPIN(xb_ld(&bar[XB_XGEN(b.x)]) == gen, bar);
            __builtin_amdgcn_fence(__ATOMIC_ACQUIRE, "agent");
            asm volatile("s_waitcnt vmcnt(0)" ::: "memory");
        }
    }
    __syncthreads();
}

constexpr int SEQ = 16384, DM = 1024, DEPTH = 4, NH = 8, HD = 64;
constexpr int INP = 4616, INP_PAD = 4864, MIXW = 1536, FFN = 2816, GU = 2 * FFN;
constexpr int NWAVES = 8;
constexpr float EPS = 1e-6f;
constexpr int PH_PER_LAYER = 9, N_PHASES = 1 + DEPTH * PH_PER_LAYER;
#ifndef MK_ONE_LAUNCH
#define MK_ONE_LAUNCH 1
#endif
enum { I_X = 0, I_C, I_ADAW, I_ADAB, I_NMIX, I_WIN, I_QNS, I_KNS, I_QNM, I_KNM, I_CONVW, I_CONVB, I_DTB, I_ALOG, I_DSKIP, I_SNORM, I_WOUT, I_NFFN, I_WG, I_WU, I_WD, N_IN };
constexpr size_t MiB = 1u << 20;
constexpr size_t WS_CTL = 0, CTL_ZERO_BYTES = 1 * MiB;
constexpr size_t WS_MOD = 1 * MiB;
constexpr size_t WS_ROPE = 2 * MiB;
constexpr size_t WS_KMEAN = 3 * MiB;
constexpr size_t WS_DT = 3 * MiB + 512 * 1024;
constexpr size_t WS_WIN = 4 * MiB;
constexpr size_t WS_WOUT = 42 * MiB;
constexpr size_t WS_WGU = 54 * MiB;
constexpr size_t WS_WDN = 98 * MiB;
constexpr size_t WS_H = 120 * MiB;
constexpr size_t WS_QKV = 152 * MiB;
constexpr size_t WS_HID = WS_QKV;
constexpr size_t WS_Z = 248 * MiB;
constexpr size_t WS_XBC = 264 * MiB;
constexpr size_t WS_Y = WS_XBC;
constexpr size_t WS_XC = 296 * MiB;
constexpr size_t WS_MIX = 328 * MiB;
constexpr size_t WS_END = 376 * MiB;
constexpr int CW_BAR = 4096;
constexpr int RING_BYTES = 131072, LDSCTL_OFF = RING_BYTES, MISC_OFF = LDSCTL_OFF + 320, LDS_BYTES = 147456;

struct Args { const void* p[N_IN + 3]; int ph_lo, ph_hi; };
__device__ __forceinline__ const float* inp(const Args& a, int i) { asm volatile("" : "+s"(i)); return (const float*)a.p[i]; }
__device__ __forceinline__ float* outp(const Args& a) { int i = N_IN; asm volatile("" : "+s"(i)); return (float*)a.p[i]; }
__device__ __forceinline__ unsigned char* wsp(const Args& a) { int i = N_IN + 1; asm volatile("" : "+s"(i)); return (unsigned char*)a.p[i]; }

__device__ __forceinline__ float bflo(unsigned w) { return __builtin_bit_cast(float, w << 16); }
__device__ __forceinline__ float bfhi(unsigned w) { return __builtin_bit_cast(float, w & 0xffff0000u); }
__device__ __forceinline__ float bf2f(bf16 b) { return __builtin_bit_cast(float, (unsigned)b << 16); }
__device__ __forceinline__ float wave_sum(float v) {
#pragma unroll
    for (int o = 1; o < 64; o <<= 1) v += __shfl_xor(v, o);
    return v;
}
__device__ __forceinline__ float wave_max(float v) {
#pragma unroll
    for (int o = 1; o < 64; o <<= 1) v = fmaxf(v, __shfl_xor(v, o));
    return v;
}
__device__ __forceinline__ float siluf(float x) { return x / (1.f + __expf(-x)); }
__device__ __forceinline__ void unpack8(const v4u w, float* f) {
    f[0] = bflo(w.x); f[1] = bfhi(w.x); f[2] = bflo(w.y); f[3] = bfhi(w.y); f[4] = bflo(w.z); f[5] = bfhi(w.z); f[6] = bflo(w.w); f[7] = bfhi(w.w);
}
__device__ __forceinline__ void sincos_d(float angf, float& s, float& c) {
    const double a = (double)angf;
    const double k = __builtin_rint(a * 0.63661977236758134308);
    double r = __builtin_fma(-k, 1.57079632679489655800, a);
    r = __builtin_fma(-k, 6.123233995736766036e-17, r);
    const double r2 = r * r;
    double sp = 1.0 / 6227020800.0; sp = sp * r2 - 1.0 / 39916800.0; sp = sp * r2 + 1.0 / 362880.0; sp = sp * r2 - 1.0 / 5040.0; sp = sp * r2 + 1.0 / 120.0; sp = sp * r2 - 1.0 / 6.0; sp = sp * r2 + 1.0;
    const double sr = sp * r;
    double cp = 1.0 / 479001600.0; cp = cp * r2 - 1.0 / 3628800.0; cp = cp * r2 + 1.0 / 40320.0; cp = cp * r2 - 1.0 / 720.0; cp = cp * r2 + 1.0 / 24.0; cp = cp * r2 - 0.5; cp = cp * r2 + 1.0;
    const int q = (int)((long long)k & 3);
    const double ss = (q == 0) ? sr : (q == 1) ? cp : (q == 2) ? -sr : -cp;
    const double cc = (q == 0) ? cp : (q == 1) ? -sr : (q == 2) ? -cp : sr;
    s = (float)ss; c = (float)cc;
}

namespace pg8 {
struct EpiIn {
    static constexpr bool PERM = true, AFTER_DRAIN = false;
    bf16_t* qkv; bf16_t* z; bf16_t* xbc; float* dt;
    __device__ __forceinline__ void operator()(const f32x4 (&acc)[2][2][4][2], const Unit& u, int wr, int wc, int fr, int fq) const {
        const int colt = u.pn * BM;
#pragma unroll
        for (int ai = 0; ai < 2; ++ai)
#pragma unroll
            for (int m = 0; m < 4; ++m) {
                const int row = u.pm * BM + ai * HALF + wr * 64 + m * 16 + fr;
#pragma unroll
                for (int bj = 0; bj < 2; ++bj) {
                    const int c = colt + bj * HALF + wc * 32 + 8 * fq;
                    const f32x4 v0 = acc[ai][bj][m][0], v1 = acc[ai][bj][m][1];
                    if (colt < 4608) {
                        u32x4 w; w.x = cvt_pk_bf16(v0[0], v0[1]); w.y = cvt_pk_bf16(v0[2], v0[3]); w.z = cvt_pk_bf16(v1[0], v1[1]); w.w = cvt_pk_bf16(v1[2], v1[3]);
                        bf16_t* dst;
                        if (colt < 3072) dst = qkv + ((size_t)(c >> 6) * SEQ + row) * 64 + (c & 63);
                        else if (colt < 3584) dst = z + (size_t)row * 512 + (c - 3072);
                        else dst = xbc + (size_t)row * 1024 + (c - 3584);
                        *(u32x4*)dst = w;
                    } else if (c == 4608) {
                        *(f32x4*)(dt + (size_t)row * 8) = v0; *(f32x4*)(dt + (size_t)row * 8 + 4) = v1;
                    }
                }
            }
    }
};
struct EpiRes {
    static constexpr bool PERM = false, AFTER_DRAIN = false;
    const float* base; float* out; const float* gate;
    __device__ __forceinline__ void operator()(const f32x4 (&acc)[2][2][4][2], const Unit& u, int wr, int wc, int fr, int fq) const {
        const int col0 = u.pn * BM + wc * 32 + 4 * fq;
        f32x4 gv[2][2];
#pragma unroll
        for (int bj = 0; bj < 2; ++bj)
#pragma unroll
            for (int n = 0; n < 2; ++n) gv[bj][n] = *(const f32x4*)(gate + col0 + bj * HALF + n * 16);
#pragma unroll
        for (int ai = 0; ai < 2; ++ai)
#pragma unroll
            for (int m = 0; m < 4; ++m) {
                const size_t off = (size_t)(u.pm * BM + ai * HALF + wr * 64 + m * 16 + fr) * DM + col0;
#pragma unroll
                for (int bj = 0; bj < 2; ++bj)
#pragma unroll
                    for (int n = 0; n < 2; ++n) {
                        const f32x4 b = *(const f32x4*)(base + off + bj * HALF + n * 16);
                        *(f32x4*)(out + off + bj * HALF + n * 16) = b + gv[bj][n] * acc[ai][bj][m][n];
                    }
                if (m & 1) asm volatile("" ::: "memory");
            }
    }
};
struct EpiSwiglu {
    static constexpr bool PERM = true, AFTER_DRAIN = false;
    bf16_t* hid;
    __device__ __forceinline__ void operator()(const f32x4 (&acc)[2][2][4][2], const Unit& u, int wr, int wc, int fr, int fq) const {
        const int col0 = u.pn * HALF + wc * 32 + 8 * fq;
#pragma unroll
        for (int ai = 0; ai < 2; ++ai)
#pragma unroll
            for (int m = 0; m < 4; ++m) {
                const int row = u.pm * BM + ai * HALF + wr * 64 + m * 16 + fr;
                float o[8];
#pragma unroll
                for (int n = 0; n < 2; ++n)
#pragma unroll
                    for (int j = 0; j < 4; ++j) { const float g = acc[ai][0][m][n][j], up = acc[ai][1][m][n][j]; o[4 * n + j] = g / (1.f + __expf(-g)) * up; }
                u32x4 w; w.x = cvt_pk_bf16(o[0], o[1]); w.y = cvt_pk_bf16(o[2], o[3]); w.z = cvt_pk_bf16(o[4], o[5]); w.w = cvt_pk_bf16(o[6], o[7]);
                *(u32x4*)(hid + (size_t)row * FFN + col0) = w;
            }
    }
};
}

__device__ __forceinline__ void xpose_item(const float* W, int K, int N, bf16* WT, int k0, int n0, int drow0, LAS float* scr, int lane) {
    const int nn = lane & 31; const bool ok = (n0 + nn) < N;
#pragma unroll 8
    for (int i = 0; i < 32; ++i) { const int kk = 2 * i + (lane >> 5); scr[kk * 33 + nn] = ok ? W[(size_t)(k0 + kk) * N + n0 + nn] : 0.f; }
    LDS_WAIT(); asm volatile("" ::: "memory");
    const int c = lane & 7;
#pragma unroll
    for (int j = 0; j < 4; ++j) { const int n = (lane >> 3) + 8 * j; const LAS float* s = scr + (8 * c) * 33 + n;
        v4u o; o.x = pk2(s[0 * 33], s[1 * 33]); o.y = pk2(s[2 * 33], s[3 * 33]); o.z = pk2(s[4 * 33], s[5 * 33]); o.w = pk2(s[6 * 33], s[7 * 33]);
        *(GAS v4u*)(WT + (size_t)(drow0 + n) * K + k0 + 8 * c) = o; }
    LDS_WAIT(); asm volatile("" ::: "memory");
}
__device__ __forceinline__ void p0_prologue(const Args& a, LAS unsigned char* lds, int tid, int lane, int wave, int G) {
    unsigned char* ws = wsp(a);
    {
        LAS float* cact = (LAS float*)lds; LAS float* red = (LAS float*)(lds + 4096);
        for (int i = tid; i < DM; i += 512) cact[i] = siluf(inp(a, I_C)[i]);
        __syncthreads();
        float* mod = (float*)(ws + WS_MOD);
        for (int item = blockIdx.x; item < DEPTH * 96; item += G) {
            const int l = item / 96, j0 = (item % 96) * 64;
            const float* w = inp(a, I_ADAW) + ((size_t)l * DM + wave * 128) * 6144 + j0 + lane;
            float s = 0.f;
#pragma unroll 16
            for (int k = 0; k < 128; ++k) s += cact[wave * 128 + k] * w[(size_t)k * 6144];
            red[wave * 64 + lane] = s;
            __syncthreads();
            if (wave == 0) { float t = inp(a, I_ADAB)[l * 6144 + j0 + lane];
#pragma unroll
                for (int w8 = 0; w8 < 8; ++w8) t += red[w8 * 64 + lane];
                mod[l * 6144 + j0 + lane] = t; }
            __syncthreads();
        }
    }
    {
        typedef float f32x2 __attribute__((ext_vector_type(2)));
        f32x2* rope = (f32x2*)(ws + WS_ROPE);
        for (int idx = blockIdx.x * 512 + tid; idx < SEQ * 8; idx += G * 512) {
            const int pos = idx >> 3, i = idx & 7;
            const float inv = (i == 0) ? 1.0f : (i == 1) ? 0.1939227432012558f : (i == 2) ? 0.03760603070259094f : (i == 3) ? 0.007292664609849453f : (i == 4) ? 0.0014142135623842478f
                            : (i == 5) ? 0.00027424818836152554f : (i == 6) ? 5.318296098266728e-05f : 1.0313386155758053e-05f;
            float s, c; sincos_d((float)pos * inv, s, c);
            rope[idx] = (f32x2){c, s};
        }
    }
    {
        LAS float* scr = (LAS float*)(lds + wave * 16384);
        const int gw = blockIdx.x * NWAVES + wave, NGW = G * NWAVES;
        constexpr int I_IN = 16 * 145, I_OUT = 24 * 32, I_G = 16 * 88, I_DN = 44 * 32, I_LAYER = I_IN + I_OUT + 2 * I_G + I_DN;
        bf16* win = (bf16*)(ws + WS_WIN); bf16* wout = (bf16*)(ws + WS_WOUT); bf16* wgu = (bf16*)(ws + WS_WGU); bf16* wdn = (bf16*)(ws + WS_WDN);
        for (int it = gw; it < DEPTH * I_LAYER; it += NGW) {
            const int l = it / I_LAYER; int r = it % I_LAYER;
            if (r < I_IN) { const int kb = r / 145, nb = r % 145; xpose_item(inp(a, I_WIN) + (size_t)l * DM * INP, DM, INP, win + (size_t)l * INP_PAD * DM, kb * 64, nb * 32, nb * 32, scr, lane); continue; }
            r -= I_IN;
            if (r < I_OUT) { const int kb = r / 32, nb = r % 32; xpose_item(inp(a, I_WOUT) + (size_t)l * MIXW * DM, MIXW, DM, wout + (size_t)l * DM * MIXW, kb * 64, nb * 32, nb * 32, scr, lane); continue; }
            r -= I_OUT;
            if (r < I_G) { const int kb = r / 88, n0 = (r % 88) * 32; xpose_item(inp(a, I_WG) + (size_t)l * DM * FFN, DM, FFN, wgu + (size_t)l * GU * DM, kb * 64, n0, 256 * (n0 >> 7) + (n0 & 127), scr, lane); continue; }
            r -= I_G;
            if (r < I_G) { const int kb = r / 88, n0 = (r % 88) * 32; xpose_item(inp(a, I_WU) + (size_t)l * DM * FFN, DM, FFN, wgu + (size_t)l * GU * DM, kb * 64, n0, 256 * (n0 >> 7) + 128 + (n0 & 127), scr, lane); continue; }
            r -= I_G;
            { const int kb = r / 32, nb = r % 32; xpose_item(inp(a, I_WD) + (size_t)l * FFN * DM, FFN, DM, wdn + (size_t)l * DM * FFN, kb * 64, nb * 32, nb * 32, scr, lane); }
        }
        constexpr int PADCH = 224 * DM / 8;
        for (int i = blockIdx.x * 512 + tid; i < DEPTH * PADCH; i += G * 512) { const int l = i / PADCH, r = i % PADCH;
            *(GAS v4u*)(win + (size_t)l * INP_PAD * DM + (size_t)4640 * DM + (size_t)r * 8) = (v4u){0u, 0u, 0u, 0u}; }
    }
}

__device__ __forceinline__ void norm_phase(const float* xsrc, const float* nw, const float* scale, const float* shift, bf16* hout, int lane, int gw, int NGW) {
    f32x4 gs[4], sh[4];
#pragma unroll
    for (int j = 0; j < 4; ++j) { const int k = 4 * lane + 256 * j; const f32x4 g = *(const f32x4*)(nw + k), sc = *(const f32x4*)(scale + k); gs[j] = g * (sc + 1.0f); sh[j] = *(const f32x4*)(shift + k); }
    for (int row = gw; row < SEQ; row += NGW) {
        const f32x4* xr = (const f32x4*)(xsrc + (size_t)row * DM) + lane;
        f32x4 v[4]; float s = 0.f;
#pragma unroll
        for (int j = 0; j < 4; ++j) { v[j] = xr[64 * j]; s += (v[j].x * v[j].x + v[j].y * v[j].y) + (v[j].z * v[j].z + v[j].w * v[j].w); }
        const float rstd = 1.0f / sqrtf(wave_sum(s) * (1.f / DM) + EPS);
        unsigned long long* o8 = (unsigned long long*)(hout + (size_t)row * DM) + lane;
#pragma unroll
        for (int j = 0; j < 4; ++j) { const f32x4 y = v[j] * rstd * gs[j] + sh[j]; o8[64 * j] = (unsigned long long)pk2(y.x, y.y) | ((unsigned long long)pk2(y.z, y.w) << 32); }
    }
}

__device__ __forceinline__ void prep_phase(const Args& a, int L, LAS unsigned char* lds, int tid, int G) {
    unsigned char* ws = wsp(a);
    bf16* qkv = (bf16*)(ws + WS_QKV);
    typedef float f32x2 __attribute__((ext_vector_type(2)));
    const f32x2* rope = (const f32x2*)(ws + WS_ROPE);
    float* kmean = (float*)(ws + WS_KMEAN);
    for (int item = blockIdx.x; item < 4 * NH * 64; item += G) {
        const int ts = item >> 9, h = (item >> 6) & 7, blk = item & 63;
        const int tsel = (ts < 2) ? ts : ts + 1;
        const float* gain = ((ts == 0) ? inp(a, I_QNS) : (ts == 1) ? inp(a, I_KNS) : (ts == 2) ? inp(a, I_QNM) : inp(a, I_KNM)) + L * HD;
        const int r = tid >> 1, hf = tid & 1, pos = blk * 256 + r;
        bf16* p = qkv + ((size_t)(tsel * 8 + h) * SEQ + pos) * 64 + hf * 32;
        float v[32];
#pragma unroll
        for (int i = 0; i < 4; ++i) unpack8(*(const v4u*)(p + 8 * i), v + 8 * i);
        float ss = 0.f;
#pragma unroll
        for (int i = 0; i < 32; ++i) ss += v[i] * v[i];
        ss += __shfl_xor(ss, 1);
        const float rstd = 1.0f / sqrtf(ss * (1.f / 64.f) + EPS);
#pragma unroll
        for (int i = 0; i < 32; ++i) v[i] = v[i] * rstd * gain[hf * 32 + i];
        if (hf == 0) {
#pragma unroll
            for (int i = 0; i < 8; ++i) { const f32x2 cs = rope[pos * 8 + i]; const float x1 = v[i], x2 = v[i + 8]; v[i] = x1 * cs.x - x2 * cs.y; v[i + 8] = x2 * cs.x + x1 * cs.y; }
        }
#pragma unroll
        for (int i = 0; i < 4; ++i) { v4u w; w.x = pk2(v[8 * i], v[8 * i + 1]); w.y = pk2(v[8 * i + 2], v[8 * i + 3]); w.z = pk2(v[8 * i + 4], v[8 * i + 5]); w.w = pk2(v[8 * i + 6], v[8 * i + 7]); *(v4u*)(p + 8 * i) = w; }
        if (ts == 3) {
            LAS float* S = (LAS float*)lds;
#pragma unroll
            for (int i = 0; i < 32; ++i) S[r * 65 + hf * 32 + i] = v[i];
            __syncthreads();
            if (tid < 64) { float s = 0.f; for (int rr = 0; rr < 256; ++rr) s += S[rr * 65 + tid]; kmean[(h * 64 + blk) * 64 + tid] = s * (1.f / 256.f); }
            __syncthreads();
        }
    }
    {
        const bf16* xbc = (const bf16*)(ws + WS_XBC); bf16* xc = (bf16*)(ws + WS_XC);
        const float* cw = inp(a, I_CONVW) + (size_t)L * 4 * 1024; const float* cb = inp(a, I_CONVB) + (size_t)L * 1024;
        for (int idx = blockIdx.x * 512 + tid; idx < SEQ * 128; idx += G * 512) {
            const int pos = idx >> 7, ch = (idx & 127) * 8;
            float acc[8];
#pragma unroll
            for (int i = 0; i < 8; ++i) acc[i] = cb[ch + i];
#pragma unroll
            for (int j = 0; j < 4; ++j) { const int p = pos - 3 + j;
                if (p >= 0) { float x[8]; unpack8(*(const v4u*)(xbc + (size_t)p * 1024 + ch), x);
#pragma unroll
                    for (int i = 0; i < 8; ++i) acc[i] += cw[j * 1024 + ch + i] * x[i]; } }
#pragma unroll
            for (int i = 0; i < 8; ++i) acc[i] = siluf(acc[i]);
            v4u w; w.x = pk2(acc[0], acc[1]); w.y = pk2(acc[2], acc[3]); w.z = pk2(acc[4], acc[5]); w.w = pk2(acc[6], acc[7]);
            *(v4u*)(xc + (size_t)pos * 1024 + ch) = w;
        }
    }
    {
        float* dt = (float*)(ws + WS_DT); const float* db = inp(a, I_DTB) + L * 8;
        for (int idx = blockIdx.x * 512 + tid; idx < SEQ * 8; idx += G * 512) { const float x = dt[idx] + db[idx & 7]; dt[idx] = fmaxf(x, 0.f) + log1pf(__expf(-fabsf(x))); }
    }
}

__device__ __forceinline__ float dot64(const float* q, const bf16* krow) {
    float s0 = 0.f, s1 = 0.f;
#pragma unroll
    for (int i = 0; i < 8; ++i) { const v4u w = *(const v4u*)(krow + 8 * i);
        s0 += q[8 * i] * bflo(w.x); s1 += q[8 * i + 1] * bfhi(w.x); s0 += q[8 * i + 2] * bflo(w.y); s1 += q[8 * i + 3] * bfhi(w.y);
        s0 += q[8 * i + 4] * bflo(w.z); s1 += q[8 * i + 5] * bfhi(w.z); s0 += q[8 * i + 6] * bflo(w.w); s1 += q[8 * i + 7] * bfhi(w.w); }
    return s0 + s1;
}
__device__ __forceinline__ void load_q64(const bf16* qrow, float* q) {
#pragma unroll
    for (int i = 0; i < 8; ++i) unpack8(*(const v4u*)(qrow + 8 * i), q + 8 * i);
}
__device__ __forceinline__ void ssd_recurrence(const Args& a, int L, int item, int tid) {
    unsigned char* ws = wsp(a);
    const bf16* xc = (const bf16*)(ws + WS_XC); const float* dt = (const float*)(ws + WS_DT); float* Y = (float*)(ws + WS_Y);
    const int h = item >> 2, pq = item & 3, p = pq * 16 + (tid >> 5), nc = tid & 31, n0 = nc * 4, g = h >> 2;
    const float av = -__expf(inp(a, I_ALOG)[L * 8 + h]), Dk = inp(a, I_DSKIP)[L * 8 + h];
    float st[4] = {0.f, 0.f, 0.f, 0.f};
    const bf16* xp = xc + h * 64 + p; const bf16* bp = xc + 512 + g * 128 + n0; const bf16* cp = xc + 768 + g * 128 + n0;
#pragma unroll 8
    for (int t = 0; t < SEQ; ++t) {
        const float d = dt[t * 8 + h], dA = __expf(av * d), x = bf2f(xp[(size_t)t * 1024]);
        const unsigned long long bw = *(const unsigned long long*)(bp + (size_t)t * 1024), cw = *(const unsigned long long*)(cp + (size_t)t * 1024);
        const float xd = x * d;
        const float b0 = bflo((unsigned)bw), b1 = bfhi((unsigned)bw), b2 = bflo((unsigned)(bw >> 32)), b3 = bfhi((unsigned)(bw >> 32));
        const float c0 = bflo((unsigned)cw), c1 = bfhi((unsigned)cw), c2 = bflo((unsigned)(cw >> 32)), c3 = bfhi((unsigned)(cw >> 32));
        st[0] = st[0] * dA + xd * b0; st[1] = st[1] * dA + xd * b1; st[2] = st[2] * dA + xd * b2; st[3] = st[3] * dA + xd * b3;
        float y = (c0 * st[0] + c1 * st[1]) + (c2 * st[2] + c3 * st[3]);
        y += __shfl_xor(y, 1); y += __shfl_xor(y, 2); y += __shfl_xor(y, 4); y += __shfl_xor(y, 8); y += __shfl_xor(y, 16);
        if (nc == 0) Y[(size_t)t * 512 + h * 64 + p] = y + Dk * x;
    }
}
__device__ __forceinline__ void moba_simple(const Args& a, LAS unsigned char* lds, int lane, int wave, int h, int slot, int nslots) {
    unsigned char* ws = wsp(a);
    const bf16* Q = (const bf16*)(ws + WS_QKV) + (size_t)(3 * 8 + h) * SEQ * 64; const bf16* K = (const bf16*)(ws + WS_QKV) + (size_t)(4 * 8 + h) * SEQ * 64;
    const bf16* V = (const bf16*)(ws + WS_QKV) + (size_t)(5 * 8 + h) * SEQ * 64;
    const float* km = (const float*)(ws + WS_KMEAN) + h * 64 * 64;
    bf16* mix = (bf16*)(ws + WS_MIX);
    LAS float* pl = (LAS float*)(lds + wave * 4096);
    const float NEG = -INFINITY;
    for (int t = slot; t < SEQ; t += nslots) {
        const int qb = t >> 8;
        float q[64]; load_q64(Q + (size_t)t * 64, q);
        float g = NEG;
        if (lane < qb) { float s0 = 0.f, s1 = 0.f; const f32x4* kr = (const f32x4*)(km + lane * 64);
#pragma unroll
            for (int i = 0; i < 16; ++i) { const f32x4 kv = kr[i]; s0 += q[4 * i] * kv.x + q[4 * i + 2] * kv.z; s1 += q[4 * i + 1] * kv.y + q[4 * i + 3] * kv.w; }
            g = s0 + s1; }
        int sel[3];
#pragma unroll
        for (int k = 0; k < 3; ++k) { const float m = wave_max(g); sel[k] = -1;
            if (m > NEG) { const unsigned long long bm = __ballot(g == m); const int idx = __builtin_ctzll(bm); sel[k] = idx; if (lane == idx) g = NEG; } }
        float mx = NEG;
#pragma unroll
        for (int bi = 0; bi < 4; ++bi) { const int b = (bi < 3) ? sel[bi] : qb;
#pragma unroll
            for (int r = 0; r < 4; ++r) { const int key = b * 256 + r * 64 + lane; float s = NEG;
                if (b >= 0 && (bi < 3 || key <= t)) s = dot64(q, K + (size_t)key * 64) * 0.125f;
                pl[bi * 256 + r * 64 + lane] = s; mx = fmaxf(mx, s); } }
        mx = wave_max(mx);
        float sum = 0.f;
#pragma unroll
        for (int i = 0; i < 16; ++i) { const float s = pl[i * 64 + lane]; const float p = (s == NEG) ? 0.f : __expf(s - mx); pl[i * 64 + lane] = p; sum += p; }
        sum = wave_sum(sum);
        LDS_WAIT(); asm volatile("" ::: "memory");
        const int kh = lane >> 5, dp = lane & 31; float a0 = 0.f, a1 = 0.f;
#pragma unroll
        for (int bi = 0; bi < 4; ++bi) { const int b = (bi < 3) ? sel[bi] : qb;
            if (b >= 0) { const bf16* vb = V + (size_t)b * 256 * 64 + 2 * dp;
#pragma unroll 8
                for (int j = 0; j < 128; ++j) { const int kl = 2 * j + kh; const float p = pl[bi * 256 + kl]; const unsigned w = *(const unsigned*)(vb + (size_t)kl * 64); a0 += p * bflo(w); a1 += p * bfhi(w); } } }
        a0 += __shfl_xor(a0, 32); a1 += __shfl_xor(a1, 32);
        const float inv = 1.f / sum;
        if (lane < 32) *(unsigned*)(mix + (size_t)t * MIXW + 1024 + h * 64 + 2 * dp) = pk2(a0 * inv, a1 * inv);
        LDS_WAIT(); asm volatile("" ::: "memory");
    }
}
__device__ __forceinline__ void swa_simple(const Args& a, LAS unsigned char* lds, int lane, int wave, int h, int slot, int nslots) {
    unsigned char* ws = wsp(a);
    const bf16* Q = (const bf16*)(ws + WS_QKV) + (size_t)(0 * 8 + h) * SEQ * 64; const bf16* K = (const bf16*)(ws + WS_QKV) + (size_t)(1 * 8 + h) * SEQ * 64;
    const bf16* V = (const bf16*)(ws + WS_QKV) + (size_t)(2 * 8 + h) * SEQ * 64;
    bf16* mix = (bf16*)(ws + WS_MIX);
    LAS float* pl = (LAS float*)(lds + wave * 4096);
    const float NEG = -INFINITY;
    for (int t = slot; t < SEQ; t += nslots) {
        float q[64]; load_q64(Q + (size_t)t * 64, q);
        float mx = NEG;
#pragma unroll
        for (int i = 0; i < 7; ++i) { const int idx = i * 64 + lane; const int b = idx / 129, j = idx - 129 * b; const int d = (b == 0) ? 1 : (b == 1) ? 4 : 16; const int pos = t - j * d;
            float s = NEG; if (idx < 387 && pos >= 0) s = dot64(q, K + (size_t)pos * 64) * 0.125f;
            pl[idx] = s; mx = fmaxf(mx, s); }
        mx = wave_max(mx);
        float sum = 0.f;
#pragma unroll
        for (int i = 0; i < 7; ++i) { const float s = pl[i * 64 + lane]; const float p = (s == NEG) ? 0.f : __expf(s - mx); pl[i * 64 + lane] = p; sum += p; }
        sum = wave_sum(sum);
        LDS_WAIT(); asm volatile("" ::: "memory");
        const int kh = lane >> 5, dp = lane & 31; float a0 = 0.f, a1 = 0.f;
#pragma unroll 6
        for (int it = 0; it < 194; ++it) { const int idx = 2 * it + kh; const int b = idx / 129, j = idx - 129 * b; const int d = (b == 0) ? 1 : (b == 1) ? 4 : 16; int pos = t - j * d; pos = pos < 0 ? 0 : pos;
            const float p = (idx < 387) ? pl[idx] : 0.f; const unsigned w = *(const unsigned*)(V + (size_t)pos * 64 + 2 * dp); a0 += p * bflo(w); a1 += p * bfhi(w); }
        a0 += __shfl_xor(a0, 32); a1 += __shfl_xor(a1, 32);
        const float inv = 1.f / sum;
        if (lane < 32) *(unsigned*)(mix + (size_t)t * MIXW + h * 64 + 2 * dp) = pk2(a0 * inv, a1 * inv);
        LDS_WAIT(); asm volatile("" ::: "memory");
    }
}
__device__ __forceinline__ void mixer_phase(const Args& a, int L, LAS unsigned char* lds, int tid, int lane, int wave, int G) {
    const int NSSD = 32;
    if ((int)blockIdx.x < NSSD) { for (int item = blockIdx.x; item < 32; item += NSSD) ssd_recurrence(a, L, item, tid); return; }
    const int widx = (int)blockIdx.x - NSSD, h = widx & 7, slot = (widx >> 3) * NWAVES + wave, nslots = ((G - NSSD) >> 3) * NWAVES;
    swa_simple(a, lds, lane, wave, h, slot, nslots);
    moba_simple(a, lds, lane, wave, h, slot, nslots);
}

__device__ __forceinline__ void gatenorm_phase(const Args& a, int L, int lane, int gw, int NGW) {
    unsigned char* ws = wsp(a);
    const float* Y = (const float*)(ws + WS_Y); const bf16* Z = (const bf16*)(ws + WS_Z); bf16* mix = (bf16*)(ws + WS_MIX);
    const float* nw = inp(a, I_SNORM) + L * 512;
    for (int it = gw; it < SEQ * 2; it += NGW) {
        const int pos = it >> 1, g = it & 1, ch = g * 256 + lane * 4;
        const f32x4 y = *(const f32x4*)(Y + (size_t)pos * 512 + ch);
        const unsigned long long zw = *(const unsigned long long*)(Z + (size_t)pos * 512 + ch);
        f32x4 gv; gv.x = y.x * siluf(bflo((unsigned)zw)); gv.y = y.y * siluf(bfhi((unsigned)zw)); gv.z = y.z * siluf(bflo((unsigned)(zw >> 32))); gv.w = y.w * siluf(bfhi((unsigned)(zw >> 32)));
        const float ss = wave_sum((gv.x * gv.x + gv.y * gv.y) + (gv.z * gv.z + gv.w * gv.w));
        const float r = 1.0f / sqrtf(ss * (1.f / 256.f) + EPS);
        const f32x4 w = *(const f32x4*)(nw + ch);
        *(unsigned long long*)(mix + (size_t)pos * MIXW + 512 + ch) = (unsigned long long)pk2(gv.x * r * w.x, gv.y * r * w.y) | ((unsigned long long)pk2(gv.z * r * w.z, gv.w * r * w.w) << 32);
    }
}

__global__ void __launch_bounds__(NWAVES * 64, 2) mk_fwd(Args args) {
    extern __shared__ __attribute__((aligned(16))) unsigned char lds_raw[];
    LAS unsigned char* lds = (LAS unsigned char*)lds_raw;
    volatile LAS unsigned* MISC = (volatile LAS unsigned*)(lds + MISC_OFF);
    const int G = gridDim.x, wave0 = __builtin_amdgcn_readfirstlane(threadIdx.x >> 6);
    gu32* ctl = (gu32*)(wsp(args) + WS_CTL);
    for (int u = threadIdx.x; u < (LDS_BYTES - LDSCTL_OFF) / 4; u += NWAVES * 64) ((LAS unsigned*)(lds + LDSCTL_OFF))[u] = 0u;
    __syncthreads();
    XcdBarrier bar; bar.bar = (unsigned*)(ctl + CW_BAR); bar.x = 0; bar.st = nullptr;
    const bool fused = (args.ph_hi - args.ph_lo) > 1;
    if (fused) bar = xcd_barrier_post((unsigned*)(ctl + CW_BAR), MISC + 8);
    for (int ph = args.ph_lo; ph < args.ph_hi; ++ph) {
        unsigned char* ws = wsp(args);
        float* mod = (float*)(ws + WS_MOD);
        bf16* hb = (bf16*)(ws + WS_H);
#define LANE_TID() int lane = (int)__builtin_amdgcn_mbcnt_hi(~0u, __builtin_amdgcn_mbcnt_lo(~0u, 0u)); asm volatile("" : "+v"(lane)); const int wave = wave0, tid = wave * 64 + lane; (void)tid
#define GW_NGW() const int gw = blockIdx.x * NWAVES + wave, NGW = G * NWAVES
        if (ph == 0) { LANE_TID(); p0_prologue(args, lds, tid, lane, wave, G); }
        else {
            const int L = (ph - 1) / PH_PER_LAYER, k = (ph - 1) % PH_PER_LAYER;
            const float* md = mod + L * 6144;
            const float* xcur = (L == 0) ? inp(args, I_X) : (const float*)outp(args);
            if (k == 0) { LANE_TID(); GW_NGW(); norm_phase(xcur, inp(args, I_NMIX) + L * DM, md + 1024, md, hb, lane, gw, NGW); }
            else if (k == 1) {
                pg8::Gemm g{hb, (const bf16*)(ws + WS_WIN) + (size_t)L * INP_PAD * DM, SEQ, INP_PAD, DM}; pg8::StaticOrder S; S.init(SEQ, INP_PAD, G, (int)blockIdx.x);
                LANE_TID(); pg8::EpiIn E{(bf16*)(ws + WS_QKV), (bf16*)(ws + WS_Z), (bf16*)(ws + WS_XBC), (float*)(ws + WS_DT)};
                pg8::gemm_phase<pg8::EpiIn, pg8::StaticOrder, true, true, DM>(lds, g, S, E, tid);
            }
            else if (k == 2) { LANE_TID(); prep_phase(args, L, lds, tid, G); }
            else if (k == 3) { LANE_TID(); mixer_phase(args, L, lds, tid, lane, wave, G); }
            else if (k == 4) { LANE_TID(); GW_NGW(); gatenorm_phase(args, L, lane, gw, NGW); }
            else if (k == 5) {
                pg8::Gemm g{(const bf16*)(ws + WS_MIX), (const bf16*)(ws + WS_WOUT) + (size_t)L * DM * MIXW, SEQ, DM, MIXW}; pg8::StaticOrder S; S.init(SEQ, DM, G, (int)blockIdx.x);
                LANE_TID(); pg8::EpiRes E{xcur, outp(args), md + 2048};
                pg8::gemm_phase<pg8::EpiRes, pg8::StaticOrder, true, true, MIXW>(lds, g, S, E, tid);
            }
            else if (k == 6) { LANE_TID(); GW_NGW(); norm_phase((const float*)outp(args), inp(args, I_NFFN) + L * DM, md + 4096, md + 3072, hb, lane, gw, NGW); }
            else if (k == 7) {
                pg8::Gemm g{hb, (const bf16*)(ws + WS_WGU) + (size_t)L * GU * DM, SEQ, GU, DM}; pg8::StaticOrder S; S.init(SEQ, GU, G, (int)blockIdx.x);
                LANE_TID(); pg8::EpiSwiglu E{(bf16*)(ws + WS_HID)};
                pg8::gemm_phase<pg8::EpiSwiglu, pg8::StaticOrder, true, true, DM>(lds, g, S, E, tid);
            }
            else {
                pg8::Gemm g{(const bf16*)(ws + WS_HID), (const bf16*)(ws + WS_WDN) + (size_t)L * DM * FFN, SEQ, DM, FFN}; pg8::StaticOrder S; S.init(SEQ, DM, G, (int)blockIdx.x);
                LANE_TID(); pg8::EpiRes E{(const float*)outp(args), outp(args), md + 5120};
                pg8::gemm_phase<pg8::EpiRes, pg8::StaticOrder, true, true, FFN>(lds, g, S, E, tid);
            }
        }
        if (ph + 1 < args.ph_hi) { XcdBarrier b2 = bar; asm volatile("" : "+s"(b2.bar), "+s"(b2.x)); xcd_barrier(b2); }
    }
}

extern "C" void kernel_launch(void* const* d_in, const int* in_sizes, int n_in, void* d_out, int out_size, void* d_ws, size_t ws_size, hipStream_t stream) {
    static int grid = 0;
    if (grid == 0) {
        if (n_in != N_IN || in_sizes[0] != SEQ * DM || out_size != SEQ * DM || ws_size < WS_END) { fprintf(stderr, "kernel_launch: unexpected shapes (n_in %d, in0 %d, out %d, ws %zu < %zu)\n", n_in, n_in > 0 ? in_sizes[0] : -1, out_size, ws_size, (size_t)WS_END); grid = -1; return; }
        int dev = 0, cus = 0, per_cu = 0;
        if (hipGetDevice(&dev) != hipSuccess || hipDeviceGetAttribute(&cus, hipDeviceAttributeMultiprocessorCount, dev) != hipSuccess) { grid = -1; return; }
        if (hipFuncSetAttribute((const void*)mk_fwd, hipFuncAttributeMaxDynamicSharedMemorySize, LDS_BYTES) != hipSuccess) { fprintf(stderr, "kernel_launch: hipFuncSetAttribute failed\n"); grid = -1; return; }
        if (hipOccupancyMaxActiveBlocksPerMultiprocessor(&per_cu, (const void*)mk_fwd, NWAVES * 64, LDS_BYTES) != hipSuccess || per_cu < 1) { fprintf(stderr, "kernel_launch: occupancy query says %d\n", per_cu); per_cu = 1; }
        (void)hipGetLastError();
        grid = cus;
        if (grid != 256) { fprintf(stderr, "kernel_launch: expected 256 CUs, got %d\n", grid); if (grid > 256) grid = 256; if (grid < 64 || (grid & 7)) { grid = -1; return; } }
    }
    if (grid < 0) return;
    if (hipMemsetAsync((char*)d_ws + WS_CTL, 0, CTL_ZERO_BYTES, stream) != hipSuccess) return;
    Args a{};
    for (int i = 0; i < N_IN; ++i) a.p[i] = d_in[i];
    a.p[N_IN] = d_out; a.p[N_IN + 1] = d_ws; a.p[N_IN + 2] = nullptr;
#if MK_ONE_LAUNCH
    a.ph_lo = 0; a.ph_hi = N_PHASES;
    hipLaunchKernelGGL(mk_fwd, dim3(grid), dim3(NWAVES * 64), LDS_BYTES, stream, a);
#else
    for (int ph = 0; ph < N_PHASES; ++ph) { a.ph_lo = ph; a.ph_hi = ph + 1; hipLaunchKernelGGL(mk_fwd, dim3(grid), dim3(NWAVES * 64), LDS_BYTES, stream, a); }
#endif
}
```

```cpp
#include <hip/hip_runtime.h>
#include <cstdio>
#include <cstdint>
#define MK_ONE_LAUNCH 1
__device__ __forceinline__ unsigned opq0() { unsigned z = 0u; asm volatile("" : "+s"(z)); return z; }
namespace pg8 {
#define PG8_LAS __attribute__((address_space(3)))
typedef unsigned short bf16_t;
typedef short bf16x8 __attribute__((ext_vector_type(8)));
typedef float f32x4 __attribute__((ext_vector_type(4)));
typedef unsigned u32x4 __attribute__((ext_vector_type(4)));
constexpr int BM = 256, BK = 64, HALF = 128, HTB = HALF * BK * 2  , STAGE_BYTES = 8 * HTB, NXCD = 8, WGM = 8;

__host__ __device__ __forceinline__ int lds_byte(int r, int c) { const int st = (r >> 4) * 2 + (c >> 5), rr = r & 15, cc = c & 31, ob = rr * 64 + cc * 2; return st * 1024 + (ob ^ (((ob >> 9) & 1) << 5)); }
__host__ __device__ __forceinline__ void stage_rc(int b, int& R, int& C) { const int st = b / 1024, sb = b % 1024, swz = sb ^ (((sb >> 9) & 1) << 5); R = (st >> 1) * 16 + swz / 64; C = (st & 1) * 32 + (swz % 64) / 2; }
__host__ __device__ __forceinline__ int perm32(int rho) { const int n = rho >> 4, i = rho & 15; return 8 * (i >> 2) + 4 * n + (i & 3); }

struct Unit { int pm, pn; };
struct Gemm { const bf16_t* A; const bf16_t* Bt; int M, N, K; };

struct StaticOrder {
    int nM, nN, nwg, G, c;
    __host__ __device__ void init(int M, int N, int G_, int c_) { nM = M / BM; nN = N / BM; nwg = nM * nN; G = G_; c = c_; }
    __host__ __device__ bool next(int i, Unit& u) const {
        const long L = (long)i * G + c; if (L >= nwg) return false;
        int wgid = (int)L; { const int q = nwg / NXCD, r = nwg % NXCD, xcd = wgid % NXCD, off = wgid / NXCD; wgid = (xcd < r ? xcd * (q + 1) : r * (q + 1) + (xcd - r) * q) + off; }
        const int nig = WGM * nN, gid = wgid / nig, fm = gid * WGM, gsz = (nM - fm) < WGM ? (nM - fm) : WGM;
        u.pm = fm + ((wgid % nig) % gsz); u.pn = (wgid % nig) / gsz; return true;
    }
    __device__ __forceinline__ void a_ready(const Unit&) const {}
    __device__ __forceinline__ void done(const Unit&) const {}
};

__device__ __forceinline__ unsigned cvt_pk_bf16(float lo, float hi) { unsigned r; asm volatile("v_cvt_pk_bf16_f32 %0, %1, %2" : "=v"(r) : "v"(lo), "v"(hi)); return r; }
typedef float f32x2 __attribute__((ext_vector_type(2)));
template <class Epi, class Sched, bool ALIGN_EPI = false, bool SP2 = false, int KC = 0>
__device__ __forceinline__ void gemm_phase(PG8_LAS unsigned char* lds, const Gemm g, const Sched& S, const Epi& E, const int tid_in) {
    int lane_ = (int)__builtin_amdgcn_mbcnt_hi(~0u, __builtin_amdgcn_mbcnt_lo(~0u, opq0())); asm volatile("" : "+v"(lane_));
    const int wid = tid_in, lane = lane_, tid = wid * 64 + lane, wr = wid >> 2, wc = wid & 3;
#define PG8_FRFQ() int l2_ = (int)__builtin_amdgcn_mbcnt_hi(~0u, __builtin_amdgcn_mbcnt_lo(~0u, opq0())); asm volatile("" : "+v"(l2_)); const int fr = l2_ & 15, fq = l2_ >> 4
    const int fr0_ = lane & 15, fq0_ = lane >> 4;
    const int K = KC ? KC : g.K, nt = K / BK;
    unsigned voffA[2], voffB[2];
#pragma unroll
    for (int i = 0; i < 2; ++i) { int R, C; stage_rc(tid * 16 + i * 8192, R, C); const int Rb = Epi::PERM ? ((R & ~31) + perm32(R & 31)) : R;
        voffA[i] = (unsigned)(R * K + C) * 2u; voffB[i] = (unsigned)(Rb * K + C) * 2u; }
    const size_t kstep = (size_t)(BK * 2);
    const size_t hstep = (size_t)HALF * K * 2;
    const size_t tstep = 2 * hstep;
    const unsigned ldsw = (unsigned)wid * 1024u;
    const int aoff = lds_byte(wr * 64 + fr0_, fq0_ * 8), boff = lds_byte(wc * 32 + fr0_, fq0_ * 8);
#define PG8_SA(b, h) (((b) * 2 + (h)) * HTB)
#define PG8_SB(b, h) ((4 + (b) * 2 + (h)) * HTB)
#define PG8_STAGE(bufoff, gbase, voff) do { _Pragma("unroll") for (int _i = 0; _i < 2; ++_i) \
        __builtin_amdgcn_global_load_lds((const unsigned*)((const char*)(gbase) + (voff)[_i]), (PG8_LAS unsigned*)(lds + (bufoff) + ldsw + _i * 8192), 16, 0, 0); } while (0)
#define PG8_LDA(dst, b, h) do { _Pragma("unroll") for (int m = 0; m < 4; ++m) _Pragma("unroll") for (int k = 0; k < 2; ++k) dst[m][k] = *(const PG8_LAS bf16x8*)(lds + PG8_SA(b, h) + aoff + m * 2048 + k * 1024); } while (0)
#define PG8_LDB(dst, b, h) do { _Pragma("unroll") for (int n = 0; n < 2; ++n) _Pragma("unroll") for (int k = 0; k < 2; ++k) dst[n][k] = *(const PG8_LAS bf16x8*)(lds + PG8_SB(b, h) + boff + n * 2048 + k * 1024); } while (0)
#define PG8_MMA(ai, bj, At, Bt) do { __builtin_amdgcn_s_setprio(1); _Pragma("unroll") for (int m = 0; m < 4; ++m) _Pragma("unroll") for (int n = 0; n < 2; ++n) _Pragma("unroll") for (int k = 0; k < 2; ++k) \
        acc[ai][bj][m][n] = __builtin_amdgcn_mfma_f32_16x16x32_bf16(Bt[n][k], At[m][k], acc[ai][bj][m][n], 0, 0, 0); __builtin_amdgcn_s_setprio(0); } while (0)
#define PG8_WAIT_V(n) asm volatile("s_waitcnt vmcnt(" #n ")" ::: "memory")
#define PG8_WAIT_L(n) asm volatile("s_waitcnt lgkmcnt(" #n ")" ::: "memory")
#define PG8_BAR __builtin_amdgcn_s_barrier()
#define PG8_SCHED __builtin_amdgcn_sched_barrier(0)
    Unit cur, nxt; int ui = 0;
    if (!S.next(0, cur)) return;
    f32x4 acc[2][2][4][2];
#pragma unroll
    for (int a = 0; a < 2; ++a)
#pragma unroll
        for (int b = 0; b < 2; ++b)
#pragma unroll
            for (int m = 0; m < 4; ++m)
#pragma unroll
                for (int n = 0; n < 2; ++n) acc[a][b][m][n] = (f32x4){0.f, 0.f, 0.f, 0.f};
    bf16x8 At[4][2], B0[2][2], B1[2][2];
    const char* cA = (const char*)g.A + (size_t)cur.pm * tstep; const char* cB = (const char*)g.Bt + (size_t)cur.pn * tstep;
    S.a_ready(cur);
    if constexpr (SP2) {
        PG8_STAGE(PG8_SB(0, 0), cB, voffB); PG8_STAGE(PG8_SB(0, 1), cB + hstep, voffB); PG8_STAGE(PG8_SA(0, 0), cA, voffA); PG8_STAGE(PG8_SA(0, 1), cA + hstep, voffA);
        if (wr == 1) PG8_BAR;
        PG8_WAIT_V(2); PG8_BAR;
        PG8_STAGE(PG8_SB(1, 0), cB + kstep, voffB); PG8_STAGE(PG8_SA(1, 0), cA + kstep, voffA); PG8_STAGE(PG8_SB(1, 1), cB + hstep + kstep, voffB);
        PG8_WAIT_V(6); PG8_BAR;
    } else {
        PG8_STAGE(PG8_SB(0, 0), cB, voffB); PG8_STAGE(PG8_SA(0, 0), cA, voffA); PG8_STAGE(PG8_SB(0, 1), cB + hstep, voffB); PG8_STAGE(PG8_SA(0, 1), cA + hstep, voffA);
        if (wr == 1) PG8_BAR;
        PG8_WAIT_V(4); PG8_BAR;
        PG8_STAGE(PG8_SB(1, 0), cB + kstep, voffB); PG8_STAGE(PG8_SA(1, 0), cA + kstep, voffA); PG8_STAGE(PG8_SB(1, 1), cB + hstep + kstep, voffB);
        PG8_WAIT_V(6); PG8_BAR;
    }
    for (;;) {
        const bool has_next = S.next(ui + 1, nxt);
        const char* nA = has_next ? (const char*)g.A + (size_t)nxt.pm * tstep : cA; const char* nB = has_next ? (const char*)g.Bt + (size_t)nxt.pn * tstep : cB;
        for (int t = 0; t < nt; t += 2) {
            const bool last = (t == nt - 2);
            const char* a1 = cA + (size_t)(t + 1) * kstep;
            const char* a2 = last ? nA : cA + (size_t)(t + 2) * kstep; const char* b2 = last ? nB : cB + (size_t)(t + 2) * kstep;
            const char* a3 = a2 + kstep; const char* b3 = b2 + kstep;
            if (last && has_next) S.a_ready(nxt);
            if constexpr (SP2) {
            PG8_LDB(B0, 0, 0); PG8_LDB(B1, 0, 1); PG8_SCHED; PG8_LDA(At, 0, 0); PG8_STAGE(PG8_SA(1, 1), a1 + hstep, voffA);
            PG8_WAIT_V(8); PG8_WAIT_L(0); PG8_BAR; PG8_MMA(0, 0, At, B0); PG8_MMA(0, 1, At, B1); PG8_BAR; PG8_SCHED;
            PG8_LDA(At, 0, 1); PG8_STAGE(PG8_SB(0, 0), b2, voffB); PG8_STAGE(PG8_SB(0, 1), b2 + hstep, voffB); PG8_STAGE(PG8_SA(0, 0), a2, voffA);
            PG8_WAIT_V(8); PG8_WAIT_L(0); PG8_BAR; PG8_MMA(1, 0, At, B0); PG8_MMA(1, 1, At, B1); PG8_BAR; PG8_SCHED;
            PG8_LDB(B0, 1, 0); PG8_LDB(B1, 1, 1); PG8_SCHED; PG8_LDA(At, 1, 0); PG8_STAGE(PG8_SA(0, 1), a2 + hstep, voffA);
            PG8_WAIT_V(8); PG8_WAIT_L(0); PG8_BAR; PG8_MMA(0, 0, At, B0); PG8_MMA(0, 1, At, B1); PG8_BAR; PG8_SCHED;
            PG8_LDA(At, 1, 1); PG8_STAGE(PG8_SB(1, 0), b3, voffB); PG8_STAGE(PG8_SB(1, 1), b3 + hstep, voffB); PG8_STAGE(PG8_SA(1, 0), a3, voffA);
            PG8_WAIT_V(8); PG8_WAIT_L(0); PG8_BAR; PG8_MMA(1, 0, At, B0); PG8_MMA(1, 1, At, B1); PG8_BAR; PG8_SCHED;
            } else {
            PG8_LDB(B0, 0, 0); PG8_SCHED; PG8_LDA(At, 0, 0); PG8_STAGE(PG8_SA(1, 1), a1 + hstep, voffA);
            PG8_WAIT_L(8); PG8_BAR; PG8_WAIT_L(0); PG8_MMA(0, 0, At, B0); PG8_BAR; PG8_SCHED;
            PG8_LDB(B1, 0, 1); PG8_STAGE(PG8_SB(0, 0), b2, voffB);
            PG8_BAR; PG8_WAIT_L(0); PG8_MMA(0, 1, At, B1); PG8_BAR;
            PG8_LDA(At, 0, 1); PG8_STAGE(PG8_SA(0, 0), a2, voffA);
            PG8_BAR; PG8_WAIT_L(0); PG8_MMA(1, 0, At, B0); PG8_BAR; PG8_SCHED;
            PG8_STAGE(PG8_SB(0, 1), b2 + hstep, voffB);
            PG8_WAIT_V(6); PG8_BAR; PG8_MMA(1, 1, At, B1); PG8_BAR;
            PG8_LDB(B0, 1, 0); PG8_SCHED; PG8_LDA(At, 1, 0); PG8_STAGE(PG8_SA(0, 1), a2 + hstep, voffA);
            PG8_WAIT_L(8); PG8_BAR; PG8_WAIT_L(0); PG8_MMA(0, 0, At, B0); PG8_BAR; PG8_SCHED;
            PG8_LDB(B1, 1, 1); PG8_STAGE(PG8_SB(1, 0), b3, voffB);
            PG8_BAR; PG8_WAIT_L(0); PG8_MMA(0, 1, At, B1); PG8_BAR;
            PG8_LDA(At, 1, 1); PG8_STAGE(PG8_SA(1, 0), a3, voffA);
            PG8_BAR; PG8_WAIT_L(0); PG8_MMA(1, 0, At, B0); PG8_BAR; PG8_SCHED;
            PG8_STAGE(PG8_SB(1, 1), b3 + hstep, voffB);
            PG8_WAIT_V(6); PG8_BAR; PG8_MMA(1, 1, At, B1); PG8_BAR;
            }
        }
        if constexpr (ALIGN_EPI) { if (wr == 0) PG8_BAR; }
        if constexpr (!Epi::AFTER_DRAIN) { PG8_FRFQ(); E(acc, cur, wr, wc, fr, fq); S.done(cur); }
        if (!has_next) break;
#pragma unroll
        for (int a = 0; a < 2; ++a)
#pragma unroll
            for (int b = 0; b < 2; ++b)
#pragma unroll
                for (int m = 0; m < 4; ++m)
#pragma unroll
                    for (int n = 0; n < 2; ++n) acc[a][b][m][n] = (f32x4){0.f, 0.f, 0.f, 0.f};
        cur = nxt; cA = nA; cB = nB; ++ui;
        if constexpr (ALIGN_EPI) { if (wr == 1) PG8_BAR; }
    }
    PG8_WAIT_V(0);
    if constexpr (!ALIGN_EPI) { if (wr == 0) PG8_BAR; }
    PG8_BAR;
    if constexpr (Epi::AFTER_DRAIN) { PG8_FRFQ(); E.fused(acc, cur, wr, wc, fr, fq, lds, wid, lane); S.done(cur); }
#undef PG8_SA
#undef PG8_SB
#undef PG8_STAGE
#undef PG8_LDA
#undef PG8_LDB
#undef PG8_MMA
#undef PG8_WAIT_V
#undef PG8_WAIT_L
#undef PG8_BAR
#undef PG8_SCHED
}
}
#define GAS __attribute__((address_space(1)))
#define LAS __attribute__((address_space(3)))
typedef unsigned short bf16;
typedef unsigned v4u __attribute__((ext_vector_type(4)));
typedef float f32x4 __attribute__((ext_vector_type(4)));
typedef short bf16x8 __attribute__((ext_vector_type(8)));
typedef GAS unsigned gu32;
typedef GAS unsigned long long gu64;
#define RLX_AGENT __ATOMIC_RELAXED, __HIP_MEMORY_SCOPE_AGENT
#define LDS_WAIT() asm volatile("s_waitcnt lgkmcnt(0)" ::: "memory")
#define VM_WAIT() asm volatile("s_waitcnt vmcnt(0)" ::: "memory")
__device__ __forceinline__ unsigned long long rt() { return __builtin_amdgcn_s_memrealtime(); }
__device__ __forceinline__ unsigned f2bf(float f) { unsigned u = __builtin_bit_cast(unsigned, f); return (u + 0x7fffu + ((u >> 16) & 1u)) >> 16; }
__device__ __forceinline__ unsigned pk2(float lo, float hi) { unsigned r; asm volatile("v_cvt_pk_bf16_f32 %0, %1, %2" : "=v"(r) : "v"(lo), "v"(hi)); return r; }
#define XB_TMO      128
#define XB_XCNT(j)  (256  + 64 * (j))
#define XB_XSUB(j)  (1280 + 64 * (j))
#define XB_XGEN(j)  (2304 + 64 * (j))
#define XB_TOP      3328
#define XB_TOPGEN   3392
#define XCD_BAR_WORDS 3456
#define XB_SPIN_CAP (1u << 18)

__device__ __forceinline__ unsigned xb_ld(unsigned* p)              { return __hip_atomic_load(p, __ATOMIC_RELAXED, __HIP_MEMORY_SCOPE_AGENT); }
__device__ __forceinline__ unsigned xb_add(unsigned* p, unsigned v) { return __hip_atomic_fetch_add(p, v, __ATOMIC_RELAXED, __HIP_MEMORY_SCOPE_AGENT); }
__device__ __forceinline__ unsigned xb_xcc_id() { return (unsigned)__builtin_amdgcn_s_getreg((3 << 11) | 20) & 0xFu; }
#define XB_SPIN(cond, bar) do { unsigned _sp = 0; while (cond) { __builtin_amdgcn_s_sleep(1); \
    if ((++_sp & 255u) == 0u) { if (xb_ld(&(bar)[XB_TMO])) break; if (_sp > XB_SPIN_CAP) { atomicAdd(&(bar)[XB_TMO], 1u); break; } } } } while (0)

struct XcdBarrier {
    unsigned* bar; unsigned x; int wave;
    volatile LAS unsigned* st;
};

__device__ __forceinline__ XcdBarrier xcd_barrier_post(unsigned* bar, volatile LAS unsigned* st) {
    XcdBarrier b; b.bar = bar; b.x = xb_xcc_id(); b.st = st; b.wave = 1;
    if (threadIdx.x == 0) (void)xb_add(&bar[XB_XCNT(b.x)], 1u);
    return b;
}
__device__ __forceinline__ void xcd_barrier_complete(unsigned* bar, unsigned x, unsigned& nloc, unsigned& nx) {
    const unsigned G = gridDim.x * gridDim.y * gridDim.z;
    unsigned sum, cnt, mine, sp = 0u;
    for (;;) {
        sum = 0u; cnt = 0u; mine = 0u;
#pragma unroll
        for (unsigned j = 0; j < 16; ++j) { const unsigned c = xb_ld(&bar[XB_XCNT(j)]); sum += c; cnt += (c > 0u) ? 1u : 0u; mine = (j == x) ? c : mine; }
        if (sum == G) break;
        __builtin_amdgcn_s_sleep(1);
        if ((++sp & 255u) == 0u) { if (xb_ld(&bar[XB_TMO])) break; if (sp > XB_SPIN_CAP) { atomicAdd(&bar[XB_TMO], 1u); break; } }
    }
    nloc = mine > 0u ? mine : 1u; nx = cnt > 0u ? cnt : 1u;
}

__device__ __forceinline__ void xcd_barrier(const XcdBarrier& b) {
    asm volatile("s_waitcnt vmcnt(0)" ::: "memory");
    __syncthreads();
    if (b.wave == 0 && (int)__builtin_amdgcn_mbcnt_hi(~0u, __builtin_amdgcn_mbcnt_lo(~0u, opq0())) == 0) {
        unsigned* bar = b.bar;
        __builtin_amdgcn_s_waitcnt(0);
        unsigned nloc = b.st[0], nx = b.st[1];
        if (nloc == 0u) { xcd_barrier_complete(bar, b.x, nloc, nx); b.st[0] = nloc; b.st[1] = nx; }
        const unsigned old = xb_add(&bar[XB_XSUB(b.x)], 1u);
        const unsigned gen = old / nloc;
        if (old + 1u == (gen + 1u) * nloc) {
            __builtin_amdgcn_fence(__ATOMIC_RELEASE, "agent");
            asm volatile("s_waitcnt vmcnt(0)" ::: "memory");
            const unsigned og = xb_add(&bar[XB_TOP], 1u);
            const unsigned tg = og / nx;
            if (og + 1u == (tg + 1u) * nx) xb_add(&bar[XB_TOPGEN], 1u);
            else XB_SPIN(xb_ld(&bar[XB_TOPGEN]) == tg, bar);
            __builtin_amdgcn_fence(__ATOMIC_ACQUIRE, "agent");
            xb_add(&bar[XB_XGEN(b.x)], 1u);
            asm volatile("s_waitcnt vmcnt(0)" ::: "memory");
        } else {
            XB_SPIN(xb_ld(&bar[XB_XGEN(b.x)]) == gen, bar);
            __builtin_amdgcn_fence(__ATOMIC_ACQUIRE, "agent");
            asm volatile("s_waitcnt vmcnt(0)" ::: "memory");
        }
    }
    __syncthreads();
}
#ifndef QKFUSE
#define QKFUSE 1
#endif
#ifdef PROBE_K
#define FLG(a_, m_) ((a_).flags & (m_))
#else
#define FLG(a_, m_) 0
#endif

constexpr int SEQ = 16384, DM = 1024, DEPTH = 4, NH = 8, HD = 64;
constexpr int INP = 4616, INP_PAD = 4864, MIXW = 1536, FFN = 2816, GU = 2 * FFN;
constexpr int NWAVES = 8;
constexpr float EPS = 1e-6f;
constexpr float C2 = 0.125f * 1.4426950408889634f;
constexpr int PH_PER_LAYER = 8, PH0 = 2, N_PHASES = PH0 + DEPTH * PH_PER_LAYER;
#ifndef MK_ONE_LAUNCH
#define MK_ONE_LAUNCH 1
#endif
enum { I_X = 0, I_C, I_ADAW, I_ADAB, I_NMIX, I_WIN, I_QNS, I_KNS, I_QNM, I_KNM, I_CONVW, I_CONVB, I_DTB, I_ALOG, I_DSKIP, I_SNORM, I_WOUT, I_NFFN, I_WG, I_WU, I_WD, N_IN };
constexpr size_t MiB = 1u << 20;
constexpr size_t WS_CTL = 0, CTL_ZERO_BYTES = 1 * MiB;
constexpr size_t WS_MOD = 1 * MiB;
constexpr size_t WS_GAINS = 1 * MiB + 128 * 1024;
constexpr size_t WS_ROPE = 2 * MiB;
constexpr size_t WS_KMEAN = 3 * MiB;
constexpr size_t WS_DT = 3 * MiB + 512 * 1024;
constexpr size_t WS_WIN = 4 * MiB;
constexpr size_t WS_WOUT = 42 * MiB;
constexpr size_t WS_WGU = 54 * MiB;
constexpr size_t WS_WDN = 98 * MiB;
constexpr size_t WS_H = 120 * MiB;
constexpr size_t WS_QKV = 152 * MiB;
constexpr size_t WS_HID = WS_QKV;
constexpr size_t WS_Z = 248 * MiB;
constexpr size_t WS_XBC = 264 * MiB;
constexpr size_t WS_Y = WS_XBC;
constexpr size_t WS_XC = 296 * MiB;
constexpr size_t WS_MIX = 328 * MiB;
constexpr size_t XT_XDTT = 0, XT_XWT = 16 * MiB, XT_STB = 32 * MiB;
constexpr size_t WS_ST = WS_XBC;
constexpr size_t WS_BT = 376 * MiB;
constexpr size_t WS_CS = 384 * MiB;
constexpr size_t WS_LIST = WS_XBC + 16 * MiB;
constexpr size_t WS_PO = WS_QKV;
constexpr size_t WS_PS = 385 * MiB;
constexpr size_t WS_END = 388 * MiB;
constexpr int CW_CNT = 8192;
constexpr int CW_BIAS_IN = 65536, CW_BIAS_GU = CW_BIAS_IN + DEPTH * INP_PAD;
constexpr int CW_RSS = 131072;
constexpr int CW_BAR = 4096;
constexpr float RSS_Q = 1024.f, RSS_IQ = 1.f / (1024.f * 1024.f)  , BIAS_Q = 16777216.f, BIAS_IQ = 1.f / 16777216.f;
__device__ __forceinline__ float rss_ms(const float* rss, int row) { return (float)((const unsigned*)rss)[row] * RSS_IQ; }
__device__ __forceinline__ f32x4 bias4(const float* p) { typedef int i32x4 __attribute__((ext_vector_type(4))); const i32x4 v = *(const i32x4*)p; return (f32x4){(float)v[0] * BIAS_IQ, (float)v[1] * BIAS_IQ, (float)v[2] * BIAS_IQ, (float)v[3] * BIAS_IQ}; }
constexpr int RING_BYTES = 131072, LDSCTL_OFF = RING_BYTES, MISC_OFF = LDSCTL_OFF + 320, LDS_BYTES = 163840;

__device__ __forceinline__ int bidx() { int v = blockIdx.x; asm volatile("" : "+s"(v)); return v; }
struct Args { const void* p[N_IN + 3]; int ph_lo, ph_hi, flags, pad; };
__device__ __forceinline__ const float* inp(const Args& a, int i) { asm volatile("" : "+s"(i)); return (const float*)a.p[i]; }
__device__ __forceinline__ float* outp(const Args& a) { int i = N_IN; asm volatile("" : "+s"(i)); return (float*)a.p[i]; }
__device__ __forceinline__ unsigned char* wsp(const Args& a) { int i = N_IN + 1; asm volatile("" : "+s"(i)); return (unsigned char*)a.p[i]; }

__device__ __forceinline__ float bflo(unsigned w) { return __builtin_bit_cast(float, w << 16); }
__device__ __forceinline__ float bfhi(unsigned w) { return __builtin_bit_cast(float, w & 0xffff0000u); }
__device__ __forceinline__ float bf2f(bf16 b) { return __builtin_bit_cast(float, (unsigned)b << 16); }
template <int O> __device__ __forceinline__ float shx(float x) { static_assert(O < 32, "use swap32 across the halves"); return __builtin_bit_cast(float, __builtin_amdgcn_ds_swizzle(__builtin_bit_cast(int, x), (O << 10) | 0x1f)); }
__device__ __forceinline__ void swap32(float& a, float& b) { asm volatile("s_nop 1\n\tv_permlane32_swap_b32 %0, %1" : "+v"(a), "+v"(b)); }
__device__ __forceinline__ float xadd32(float x) { float a = x, b = x; swap32(a, b); return a + b; }
__device__ __forceinline__ float xadd16(float x) { float a = x, b = x; asm volatile("s_nop 1\n\tv_permlane16_swap_b32 %0, %1" : "+v"(a), "+v"(b)); return a + b; }
__device__ __forceinline__ float wave_sum(float v) {
    v += shx<1>(v); v += shx<2>(v); v += shx<4>(v); v += shx<8>(v); v += shx<16>(v); v = xadd32(v);
    return v;
}
__device__ __forceinline__ float wave_max(float v) {
    v = fmaxf(v, shx<1>(v)); v = fmaxf(v, shx<2>(v)); v = fmaxf(v, shx<4>(v)); v = fmaxf(v, shx<8>(v)); v = fmaxf(v, shx<16>(v)); { float a = v, c = v; swap32(a, c); v = fmaxf(a, c); }
    return v;
}
__device__ __forceinline__ float siluf(float x) { return x * __builtin_amdgcn_rcpf(1.f + __expf(-x)); }
__device__ __forceinline__ void unpack8(const v4u w, float* f) {
    f[0] = bflo(w.x); f[1] = bfhi(w.x); f[2] = bflo(w.y); f[3] = bfhi(w.y); f[4] = bflo(w.z); f[5] = bfhi(w.z); f[6] = bflo(w.w); f[7] = bfhi(w.w);
}
__device__ __forceinline__ void sincos_d(float angf, float& s, float& c) {
    const double a = (double)angf;
    const double k = __builtin_rint(a * 0.63661977236758134308);
    double r = __builtin_fma(-k, 1.57079632679489655800, a);
    r = __builtin_fma(-k, 6.123233995736766036e-17, r);
    const double r2 = r * r;
    double sp = 1.0 / 6227020800.0; sp = sp * r2 - 1.0 / 39916800.0; sp = sp * r2 + 1.0 / 362880.0; sp = sp * r2 - 1.0 / 5040.0; sp = sp * r2 + 1.0 / 120.0; sp = sp * r2 - 1.0 / 6.0; sp = sp * r2 + 1.0;
    const double sr = sp * r;
    double cp = 1.0 / 479001600.0; cp = cp * r2 - 1.0 / 3628800.0; cp = cp * r2 + 1.0 / 40320.0; cp = cp * r2 - 1.0 / 720.0; cp = cp * r2 + 1.0 / 24.0; cp = cp * r2 - 0.5; cp = cp * r2 + 1.0;
    const int q = (int)((long long)k & 3);
    const double ss = (q == 0) ? sr : (q == 1) ? cp : (q == 2) ? -sr : -cp;
    const double cc = (q == 0) ? cp : (q == 1) ? -sr : (q == 2) ? -cp : sr;
    s = (float)ss; c = (float)cc;
}

namespace pg8 {
struct EpiIn {
    static constexpr bool PERM = true, AFTER_DRAIN = false;
    const Args& ar; int L;
    __device__ __forceinline__ void operator()(const f32x4 (&acc)[2][2][4][2], const Unit& u, int wr, int wc, int fr, int fq) const {
        const int colt = u.pn * BM;
        unsigned char* ws = wsp(ar);
        const float* rss = (const float*)(ws + WS_CTL) + CW_RSS + (L * 2 + 0) * SEQ; const float* bias = (const float*)(ws + WS_CTL) + CW_BIAS_IN + L * INP_PAD;
        bf16_t* qkv = (bf16_t*)(ws + WS_QKV); bf16_t* z = (bf16_t*)(ws + WS_Z); bf16_t* xbc = (bf16_t*)(ws + WS_XBC); float* dt = (float*)(ws + WS_DT);
        const float* rope = (const float*)(ws + WS_ROPE); float* kmean2 = (float*)(ws + WS_KMEAN);
        f32x4 bv[2][2];
#pragma unroll
        for (int bj = 0; bj < 2; ++bj)
#pragma unroll
            for (int n = 0; n < 2; ++n) bv[bj][n] = bias4(bias + colt + bj * HALF + wc * 32 + 8 * fq + 4 * n);
        float rms8[2][4];
#pragma unroll
        for (int ai = 0; ai < 2; ++ai)
#pragma unroll
            for (int m = 0; m < 4; ++m) rms8[ai][m] = rss_ms(rss, u.pm * BM + ai * HALF + wr * 64 + m * 16 + fr);
        asm volatile("" : "+v"(rms8[0][0]), "+v"(rms8[0][1]), "+v"(rms8[0][2]), "+v"(rms8[0][3]), "+v"(rms8[1][0]), "+v"(rms8[1][1]), "+v"(rms8[1][2]), "+v"(rms8[1][3]));
        if (QKFUSE && colt < 3072) {
            const int tsel = u.pn >> 1, head = 4 * (u.pn & 1) + wc;
            const bool isv = (tsel == 2 || tsel == 5);
            const float* gain = (const float*)(ws + WS_GAINS) + (L * 4 + ((tsel == 0) ? 0 : (tsel == 1) ? 1 : (tsel == 3) ? 2 : 3)) * 64;
            f32x4 gn[2][2];
            if (!isv) {
#pragma unroll
                for (int bj = 0; bj < 2; ++bj)
#pragma unroll
                    for (int n = 0; n < 2; ++n) gn[bj][n] = *(const f32x4*)(gain + 32 * bj + ((bj == 0 && fq < 2) ? 4 * fq + 8 * n : 8 * fq + 4 * n)) * ((tsel == 0 || tsel == 3) ? 0.125f * 1.4426950408889634f : 1.0f);
            }
            f32x4 ks[2][2];
#pragma unroll
            for (int bj = 0; bj < 2; ++bj)
#pragma unroll
                for (int n = 0; n < 2; ++n) ks[bj][n] = (f32x4){0.f, 0.f, 0.f, 0.f};
            extern __shared__ __attribute__((aligned(16))) unsigned char lds_epi[];
            PG8_LAS float* ropeL = (PG8_LAS float*)((PG8_LAS unsigned char*)lds_epi + 132096);
            if (!isv) {
                const int t_ = (wr * 4 + wc) * 64 + fq * 16 + fr, rr_ = t_ >> 1, hf_ = t_ & 1;
                const f32x4 ra = *(const f32x4*)(rope + (size_t)(u.pm * BM + rr_) * 16 + hf_ * 8), rb = *(const f32x4*)(rope + (size_t)(u.pm * BM + rr_) * 16 + hf_ * 8 + 4);
                *(PG8_LAS f32x4*)(ropeL + rr_ * 28 + hf_ * 4) = (f32x4){ra[0], ra[2], rb[0], rb[2]};
                *(PG8_LAS f32x4*)(ropeL + rr_ * 28 + 8 + hf_ * 4) = (f32x4){ra[1], ra[3], rb[1], rb[3]};
                *(PG8_LAS f32x4*)(ropeL + rr_ * 28 + 16 + hf_ * 4) = (f32x4){-ra[1], -ra[3], -rb[1], -rb[3]};
                if (t_ < 6) *(PG8_LAS f32x4*)(ropeL + 256 * 28 + t_ * 4) = (t_ < 2) ? (f32x4){1.f, 1.f, 1.f, 1.f} : (f32x4){0.f, 0.f, 0.f, 0.f};
                asm volatile("s_waitcnt lgkmcnt(0)" ::: "memory"); __builtin_amdgcn_s_barrier();
            }
            bf16_t* dbase = qkv + (size_t)(tsel * 8 + head) * SEQ * 64 + 8 * fq;
#pragma unroll
            for (int ai = 0; ai < 2; ++ai)
#pragma unroll
                for (int m = 0; m < 4; ++m) {
                    const int row = u.pm * BM + ai * HALF + wr * 64 + m * 16 + fr;
                    const float rstd = __builtin_amdgcn_rsqf(rms8[ai][m] + 1e-6f);
                    f32x4 v[2][2];
#pragma unroll
                    for (int bj = 0; bj < 2; ++bj)
#pragma unroll
                        for (int n = 0; n < 2; ++n) v[bj][n] = acc[ai][bj][m][n] * rstd + bv[bj][n];
                    if (!isv) {
                        float ss = 0.f;
#pragma unroll
                        for (int bj = 0; bj < 2; ++bj)
#pragma unroll
                            for (int n = 0; n < 2; ++n) ss += (v[bj][n][0] * v[bj][n][0] + v[bj][n][1] * v[bj][n][1]) + (v[bj][n][2] * v[bj][n][2] + v[bj][n][3] * v[bj][n][3]);
                        ss = xadd16(ss); ss = xadd32(ss);
                        const float rh = __builtin_amdgcn_rsqf(ss * (1.0f / 64.0f) + 1e-6f);
#pragma unroll
                        for (int bj = 0; bj < 2; ++bj)
#pragma unroll
                            for (int n = 0; n < 2; ++n) v[bj][n] = v[bj][n] * rh * gn[bj][n];
                        {
                            const int rsel = (fq < 2) ? (ai * HALF + wr * 64 + m * 16 + fr) : 256;
                            const f32x4 cv = *(const PG8_LAS f32x4*)(ropeL + rsel * 28 + 4 * (fq & 1)), sv = *(const PG8_LAS f32x4*)(ropeL + rsel * 28 + 8 + 4 * (fq & 1));
                            const f32x4 x1 = v[0][0], x2 = v[0][1];
                            v[0][0] = x1 * cv - x2 * sv; v[0][1] = x2 * cv + x1 * sv; }
                        if (tsel == 4) {
#pragma unroll
                            for (int bj = 0; bj < 2; ++bj)
#pragma unroll
                                for (int n = 0; n < 2; ++n) ks[bj][n] += v[bj][n];
                        }
                    }
#pragma unroll
                    for (int bj = 0; bj < 2; ++bj) { const f32x4 v0 = v[bj][0], v1 = v[bj][1];
                        u32x4 w; w.x = cvt_pk_bf16(v0[0], v0[1]); w.y = cvt_pk_bf16(v0[2], v0[3]); w.z = cvt_pk_bf16(v1[0], v1[1]); w.w = cvt_pk_bf16(v1[2], v1[3]);
                        if (bj == 0 && !isv) {
                            typedef unsigned u32x2e __attribute__((ext_vector_type(2)));
                            const int o0 = (fq < 2) ? 4 * fq : 8 * fq, o1 = (fq < 2) ? 4 * fq + 8 : 8 * fq + 4;
                            bf16_t* d0 = dbase - 8 * fq + (size_t)row * 64;
                            *(u32x2e*)(d0 + o0) = (u32x2e){w.x, w.y}; *(u32x2e*)(d0 + o1) = (u32x2e){w.z, w.w};
                        } else *(u32x4*)(dbase + (size_t)row * 64 + 32 * bj) = w; }
                }
            if (tsel == 4) {
#pragma unroll
                for (int bj = 0; bj < 2; ++bj)
#pragma unroll
                    for (int n = 0; n < 2; ++n)
#pragma unroll
                        for (int j = 0; j < 4; ++j) { float s = ks[bj][n][j]; s += shx<1>(s); s += shx<2>(s); s += shx<4>(s); s += shx<8>(s); ks[bj][n][j] = s; }
                if (fr == 0) {
                    float* kd = kmean2 + ((size_t)(wr * 8 + head) * 64 + u.pm) * 64 + 8 * fq;
                    { const int o0 = (fq < 2) ? 4 * fq : 8 * fq, o1 = (fq < 2) ? 4 * fq + 8 : 8 * fq + 4;
                      *(f32x4*)(kd - 8 * fq + o0) = ks[0][0]; *(f32x4*)(kd - 8 * fq + o1) = ks[0][1]; *(f32x4*)(kd + 32) = ks[1][0]; *(f32x4*)(kd + 32 + 4) = ks[1][1]; }
                }
            }
            return;
        }
#pragma unroll
        for (int ai = 0; ai < 2; ++ai)
#pragma unroll
            for (int m = 0; m < 4; ++m) {
                const int row = u.pm * BM + ai * HALF + wr * 64 + m * 16 + fr;
                const float rstd = __builtin_amdgcn_rsqf(rms8[ai][m] + 1e-6f);
#pragma unroll
                for (int bj = 0; bj < 2; ++bj) {
                    const int c = colt + bj * HALF + wc * 32 + 8 * fq;
                    const f32x4 v0 = acc[ai][bj][m][0] * rstd + bv[bj][0], v1 = acc[ai][bj][m][1] * rstd + bv[bj][1];
                    if (colt < 4608) {
                        u32x4 w; w.x = cvt_pk_bf16(v0[0], v0[1]); w.y = cvt_pk_bf16(v0[2], v0[3]); w.z = cvt_pk_bf16(v1[0], v1[1]); w.w = cvt_pk_bf16(v1[2], v1[3]);
                        bf16_t* dst;
                        if (colt < 3072) dst = qkv + ((size_t)(c >> 6) * SEQ + row) * 64 + (c & 63);
                        else if (colt < 3584) dst = z + (size_t)row * 512 + (c - 3072);
                        else dst = xbc + (size_t)row * 1024 + (c - 3584);
                        *(u32x4*)dst = w;
                    } else if (c == 4608) {
                        *(f32x4*)(dt + (size_t)row * 8) = v0; *(f32x4*)(dt + (size_t)row * 8 + 4) = v1;
                    }
                }
            }
    }
};
struct EpiRes {
    static constexpr bool PERM = true, AFTER_DRAIN = false;
    float* out; const float* gate; bf16_t* xb; float* rss;
    __device__ __forceinline__ void operator()(const f32x4 (&acc)[2][2][4][2], const Unit& u, int wr, int wc, int fr, int fq) const {
        typedef unsigned u32x4 __attribute__((ext_vector_type(4)));
        const int col0 = u.pn * BM + wc * 32 + 8 * fq;
        f32x4 gv[2][2];
#pragma unroll
        for (int bj = 0; bj < 2; ++bj)
#pragma unroll
            for (int n = 0; n < 2; ++n) gv[bj][n] = *(const f32x4*)(gate + col0 + bj * HALF + n * 4);
        u32x4 bb[2][4][2];
        const size_t off0 = (size_t)(u.pm * BM + wr * 64 + fr) * DM + col0;
#pragma unroll
        for (int ai = 0; ai < 2; ++ai)
#pragma unroll
            for (int m = 0; m < 4; ++m)
#pragma unroll
                for (int bj = 0; bj < 2; ++bj) bb[ai][m][bj] = *(const u32x4*)(xb + off0 + (size_t)(ai * HALF + m * 16) * DM + bj * HALF);
#pragma unroll
        for (int ai = 0; ai < 2; ++ai)
#pragma unroll
            for (int m = 0; m < 4; ++m) {
                const int row = u.pm * BM + ai * HALF + wr * 64 + m * 16 + fr;
                const size_t off = off0 + (size_t)(ai * HALF + m * 16) * DM;
                float ss = 0.f;
#pragma unroll
                for (int bj = 0; bj < 2; ++bj) {
                    const u32x4 b_ = bb[ai][m][bj];
                    const f32x4 b0 = {__uint_as_float(b_[0] << 16), __uint_as_float(b_[0] & 0xffff0000u), __uint_as_float(b_[1] << 16), __uint_as_float(b_[1] & 0xffff0000u)};
                    const f32x4 b1 = {__uint_as_float(b_[2] << 16), __uint_as_float(b_[2] & 0xffff0000u), __uint_as_float(b_[3] << 16), __uint_as_float(b_[3] & 0xffff0000u)};
                    const f32x4 o0 = b0 + gv[bj][0] * acc[ai][bj][m][0], o1 = b1 + gv[bj][1] * acc[ai][bj][m][1];
                    if (out) { *(f32x4*)(out + off + bj * HALF) = o0; *(f32x4*)(out + off + bj * HALF + 4) = o1; }
                    *(u32x4*)(xb + off + bj * HALF) = (u32x4){cvt_pk_bf16(o0[0], o0[1]), cvt_pk_bf16(o0[2], o0[3]), cvt_pk_bf16(o1[0], o1[1]), cvt_pk_bf16(o1[2], o1[3])};
                    ss += ((o0[0] * o0[0] + o0[1] * o0[1]) + (o0[2] * o0[2] + o0[3] * o0[3])) + ((o1[0] * o1[0] + o1[1] * o1[1]) + (o1[2] * o1[2] + o1[3] * o1[3]));
                }
                ss = xadd16(ss); ss = xadd32(ss);
                if (rss && fq == 0) atomicAdd((unsigned*)rss + row, (unsigned)__float2uint_rn(ss * RSS_Q));
            }
    }
};
struct EpiSwiglu {
    static constexpr bool PERM = true, AFTER_DRAIN = false;
    bf16_t* hid; const float* rss; const float* bias;
    __device__ __forceinline__ void operator()(const f32x4 (&acc)[2][2][4][2], const Unit& u, int wr, int wc, int fr, int fq) const {
        const int col0 = u.pn * HALF + wc * 32 + 8 * fq, bc0 = u.pn * BM + wc * 32 + 8 * fq;
        f32x4 bv[2][2];
#pragma unroll
        for (int bj = 0; bj < 2; ++bj)
#pragma unroll
            for (int n = 0; n < 2; ++n) bv[bj][n] = bias4(bias + bc0 + bj * HALF + 4 * n);
        float rms8[2][4];
#pragma unroll
        for (int ai = 0; ai < 2; ++ai)
#pragma unroll
            for (int m = 0; m < 4; ++m) rms8[ai][m] = rss_ms(rss, u.pm * BM + ai * HALF + wr * 64 + m * 16 + fr);
        asm volatile("" : "+v"(rms8[0][0]), "+v"(rms8[0][1]), "+v"(rms8[0][2]), "+v"(rms8[0][3]), "+v"(rms8[1][0]), "+v"(rms8[1][1]), "+v"(rms8[1][2]), "+v"(rms8[1][3]));
#pragma unroll
        for (int ai = 0; ai < 2; ++ai)
#pragma unroll
            for (int m = 0; m < 4; ++m) {
                const int row = u.pm * BM + ai * HALF + wr * 64 + m * 16 + fr;
                const float rstd = __builtin_amdgcn_rsqf(rms8[ai][m] + 1e-6f);
                float o[8];
#pragma unroll
                for (int n = 0; n < 2; ++n)
#pragma unroll
                    for (int j = 0; j < 4; ++j) { const float g = acc[ai][0][m][n][j] * rstd + bv[0][n][j], up = acc[ai][1][m][n][j] * rstd + bv[1][n][j]; o[4 * n + j] = g * __builtin_amdgcn_rcpf(1.f + __expf(-g)) * up; }
                u32x4 w; w.x = cvt_pk_bf16(o[0], o[1]); w.y = cvt_pk_bf16(o[2], o[3]); w.z = cvt_pk_bf16(o[4], o[5]); w.w = cvt_pk_bf16(o[6], o[7]);
                *(u32x4*)(hid + (size_t)row * FFN + col0) = w;
            }
    }
};
}

template <bool FOLD>
__device__ __forceinline__ void xpose_item(const float* W, int K, int N, bf16* WT, int k0, int n0, int drow0, LAS float* scr, int lane, const float* nw, const float* scale, const float* shift, float* bias, int qkswz = 0) {
    const int c4 = lane & 7, kk0 = lane >> 3; const bool ok = (n0 + 4 * c4) < N;
    f32x4 w[8];
#pragma unroll
    for (int i = 0; i < 8; ++i) w[i] = ok ? *(const f32x4*)(W + (size_t)(k0 + kk0 + 8 * i) * N + n0 + 4 * c4) : (f32x4){0.f, 0.f, 0.f, 0.f};
    f32x4 bsum = (f32x4){0.f, 0.f, 0.f, 0.f};
#pragma unroll
    for (int i = 0; i < 8; ++i) { const int kk = kk0 + 8 * i;
        if (FOLD) { bsum += w[i] * shift[k0 + kk]; w[i] *= nw[k0 + kk] * (1.0f + scale[k0 + kk]); }
        scr[kk * 33 + 4 * c4] = w[i].x; scr[kk * 33 + 4 * c4 + 1] = w[i].y; scr[kk * 33 + 4 * c4 + 2] = w[i].z; scr[kk * 33 + 4 * c4 + 3] = w[i].w; }
    if (FOLD) {
#pragma unroll
        for (int e = 0; e < 4; ++e) { float s = bsum[e]; s += shx<8>(s); s += shx<16>(s); s = xadd32(s); bsum[e] = s; }
        if (lane < 8 && ok) {
            { const int pc4 = (qkswz && (c4 == 1 || c4 == 2)) ? 3 - c4 : c4;
#pragma unroll
              for (int e = 0; e < 4; ++e) atomicAdd((int*)bias + drow0 + 4 * pc4 + e, __float2int_rn(bsum[e] * BIAS_Q)); } }
    }
    LDS_WAIT(); asm volatile("" ::: "memory");
    const int c = lane & 7;
#pragma unroll
    for (int j = 0; j < 4; ++j) { const int n = (lane >> 3) + 8 * j; const LAS float* s = scr + (8 * c) * 33 + n;
        v4u o; o.x = pk2(s[0 * 33], s[1 * 33]); o.y = pk2(s[2 * 33], s[3 * 33]); o.z = pk2(s[4 * 33], s[5 * 33]); o.w = pk2(s[6 * 33], s[7 * 33]);
        const int pn = (qkswz && n < 16 && ((n >> 2) == 1 || (n >> 2) == 2)) ? (n ^ 12) : n;
        *(GAS v4u*)(WT + (size_t)(drow0 + pn) * K + k0 + 8 * c) = o; }
    LDS_WAIT(); asm volatile("" ::: "memory");
}
__device__ __forceinline__ void p0_prologue(const Args& a, LAS unsigned char* lds, int tid, int lane, int wave, int G) {
    unsigned char* ws = wsp(a);
    {
        LAS float* cact = (LAS float*)lds; LAS float* red = (LAS float*)(lds + 4096);
        for (int i = tid; i < DM; i += 512) cact[i] = siluf(inp(a, I_C)[i]);
        __syncthreads();
        float* mod = (float*)(ws + WS_MOD);
        for (int item = bidx(); item < DEPTH * 96; item += G) {
            const int l = item / 96, j0 = (item % 96) * 64;
            const float* w = inp(a, I_ADAW) + ((size_t)l * DM + wave * 128) * 6144 + j0 + lane;
            float s = 0.f;
#pragma unroll 16
            for (int k = 0; k < 128; ++k) s += cact[wave * 128 + k] * w[(size_t)k * 6144];
            red[wave * 64 + lane] = s;
            __syncthreads();
            if (wave == 0) { float t = inp(a, I_ADAB)[l * 6144 + j0 + lane];
#pragma unroll
                for (int w8 = 0; w8 < 8; ++w8) t += red[w8 * 64 + lane];
                mod[l * 6144 + j0 + lane] = t; }
            __syncthreads();
        }
    }
    {
        typedef float f32x2 __attribute__((ext_vector_type(2)));
        f32x2* rope = (f32x2*)(ws + WS_ROPE);
        for (int idx = bidx() * 512 + tid; idx < SEQ * 8; idx += G * 512) {
            const int pos = idx >> 3, i = idx & 7;
            const float inv = (i == 0) ? 1.0f : (i == 1) ? 0.1939227432012558f : (i == 2) ? 0.03760603070259094f : (i == 3) ? 0.007292664609849453f : (i == 4) ? 0.0014142135623842478f
                            : (i == 5) ? 0.00027424818836152554f : (i == 6) ? 5.318296098266728e-05f : 1.0313386155758053e-05f;
            float s, c; sincos_d((float)pos * inv, s, c);
            rope[idx] = (f32x2){c, s};
        }
    }
    if (bidx() == 0) { float* gt = (float*)(ws + WS_GAINS);
        for (int i = tid; i < DEPTH * 4 * 64; i += 512) { const int l = i >> 8, t4 = (i >> 6) & 3, dd = i & 63; gt[i] = ((t4 == 0) ? inp(a, I_QNS) : (t4 == 1) ? inp(a, I_KNS) : (t4 == 2) ? inp(a, I_QNM) : inp(a, I_KNM))[l * HD + dd]; } }
    {
        bf16* win = (bf16*)(ws + WS_WIN);
        constexpr int PADCH = 224 * DM / 8;
        for (int i = bidx() * 512 + tid; i < DEPTH * PADCH; i += G * 512) { const int l = i / PADCH, r = i % PADCH;
            *(GAS v4u*)(win + (size_t)l * INP_PAD * DM + (size_t)4640 * DM + (size_t)r * 8) = (v4u){0u, 0u, 0u, 0u}; }
    }
    {
        const float* x = inp(a, I_X); bf16* hb = (bf16*)(ws + WS_H); float* rss = (float*)(ws + WS_CTL) + CW_RSS;
        for (int row = bidx() * NWAVES + wave; row < SEQ; row += G * NWAVES) {
            const f32x4* xr = (const f32x4*)(x + (size_t)row * DM) + lane; float s = 0.f;
            unsigned long long* o8 = (unsigned long long*)(hb + (size_t)row * DM) + lane;
#pragma unroll
            for (int j = 0; j < 4; ++j) { const f32x4 v = xr[64 * j]; s += (v.x * v.x + v.y * v.y) + (v.z * v.z + v.w * v.w); o8[64 * j] = (unsigned long long)pk2(v.x, v.y) | ((unsigned long long)pk2(v.z, v.w) << 32); }
            s = wave_sum(s);
            if (lane == 0) ((unsigned*)rss)[row] = (unsigned)__float2uint_rn(s * RSS_Q);
        }
    }
}
__device__ __forceinline__ void p0_weights(const Args& a, LAS unsigned char* lds, int lane, int wave, int G) {
    unsigned char* ws = wsp(a);
    {
        LAS float* scr = (LAS float*)(lds + wave * 16384);
        const int gw = bidx() * NWAVES + wave, NGW = G * NWAVES;
        constexpr int I_IN = 16 * 145, I_OUT = 24 * 32, I_G = 16 * 88, I_DN = 44 * 32, I_LAYER = I_IN + I_OUT + 2 * I_G + I_DN;
        bf16* win = (bf16*)(ws + WS_WIN); bf16* wout = (bf16*)(ws + WS_WOUT); bf16* wgu = (bf16*)(ws + WS_WGU); bf16* wdn = (bf16*)(ws + WS_WDN);
        const float* mod = (const float*)(ws + WS_MOD); float* ctlf = (float*)(ws + WS_CTL);
        for (int it = gw; it < DEPTH * I_LAYER; it += NGW) {
            const int l = it / I_LAYER; int r = it % I_LAYER; const float* md = mod + l * 6144;
            if (r < I_IN) { const int kb = r / 145, nb = r % 145, n0 = nb * 32;
                const int drow = (QKFUSE && n0 < 3072) ? (n0 & ~255) + 128 * ((n0 >> 5) & 1) + 32 * ((n0 >> 6) & 3) : n0;
                xpose_item<true>(inp(a, I_WIN) + (size_t)l * DM * INP, DM, INP, win + (size_t)l * INP_PAD * DM, kb * 64, n0, drow, scr, lane, inp(a, I_NMIX) + l * DM, md + 1024, md, ctlf + CW_BIAS_IN + l * INP_PAD, (QKFUSE && n0 < 3072 && ((n0 >> 9) % 3) != 2 && ((n0 >> 5) & 1) == 0) ? 1 : 0); continue; }
            r -= I_IN;
            if (r < I_OUT) { const int kb = r / 32, nb = r % 32; xpose_item<false>(inp(a, I_WOUT) + (size_t)l * MIXW * DM, MIXW, DM, wout + (size_t)l * DM * MIXW, kb * 64, nb * 32, nb * 32, scr, lane, nullptr, nullptr, nullptr, nullptr); continue; }
            r -= I_OUT;
            if (r < I_G) { const int kb = r / 88, n0 = (r % 88) * 32; xpose_item<true>(inp(a, I_WG) + (size_t)l * DM * FFN, DM, FFN, wgu + (size_t)l * GU * DM, kb * 64, n0, 256 * (n0 >> 7) + (n0 & 127), scr, lane, inp(a, I_NFFN) + l * DM, md + 4096, md + 3072, ctlf + CW_BIAS_GU + l * GU); continue; }
            r -= I_G;
            if (r < I_G) { const int kb = r / 88, n0 = (r % 88) * 32; xpose_item<true>(inp(a, I_WU) + (size_t)l * DM * FFN, DM, FFN, wgu + (size_t)l * GU * DM, kb * 64, n0, 256 * (n0 >> 7) + 128 + (n0 & 127), scr, lane, inp(a, I_NFFN) + l * DM, md + 4096, md + 3072, ctlf + CW_BIAS_GU + l * GU); continue; }
            r -= I_G;
            { const int kb = r / 32, nb = r % 32; xpose_item<false>(inp(a, I_WD) + (size_t)l * FFN * DM, FFN, DM, wdn + (size_t)l * DM * FFN, kb * 64, nb * 32, nb * 32, scr, lane, nullptr, nullptr, nullptr, nullptr); }
        }
    }
}

__device__ __forceinline__ void prep_phase(const Args& a, int L, LAS unsigned char* lds, int tid, int G) {
    unsigned char* ws = wsp(a);
    bf16* qkv = (bf16*)(ws + WS_QKV);
    typedef float f32x2 __attribute__((ext_vector_type(2)));
    const f32x2* rope = (const f32x2*)(ws + WS_ROPE);
    float* kmean = (float*)(ws + WS_KMEAN);
#if !QKFUSE
    for (int item = (a.flags & 1) ? 4 * NH * 64 : (int)blockIdx.x; item < 4 * NH * 64; item += G) {
        const int ts = item >> 9, h = (item >> 6) & 7, blk = item & 63;
        const int tsel = (ts < 2) ? ts : ts + 1;
        const float* gain = ((ts == 0) ? inp(a, I_QNS) : (ts == 1) ? inp(a, I_KNS) : (ts == 2) ? inp(a, I_QNM) : inp(a, I_KNM)) + L * HD;
        const int r = tid >> 1, hf = tid & 1, pos = blk * 256 + r;
        bf16* p = qkv + ((size_t)(tsel * 8 + h) * SEQ + pos) * 64 + hf * 32;
        float v[32];
#pragma unroll
        for (int i = 0; i < 4; ++i) unpack8(*(const v4u*)(p + 8 * i), v + 8 * i);
        float ss = 0.f;
#pragma unroll
        for (int i = 0; i < 32; ++i) ss += v[i] * v[i];
        ss += __shfl_xor(ss, 1);
        const float rstd = 1.0f / sqrtf(ss * (1.f / 64.f) + EPS);
        const float qs = (ts == 0 || ts == 2) ? C2 : 1.0f;
#pragma unroll
        for (int i = 0; i < 32; ++i) v[i] = v[i] * rstd * gain[hf * 32 + i] * qs;
        if (hf == 0) {
#pragma unroll
            for (int i = 0; i < 8; ++i) { const f32x2 cs = rope[pos * 8 + i]; const float x1 = v[i], x2 = v[i + 8]; v[i] = x1 * cs.x - x2 * cs.y; v[i + 8] = x2 * cs.x + x1 * cs.y; }
        }
#pragma unroll
        for (int i = 0; i < 4; ++i) { v4u w; w.x = pk2(v[8 * i], v[8 * i + 1]); w.y = pk2(v[8 * i + 2], v[8 * i + 3]); w.z = pk2(v[8 * i + 4], v[8 * i + 5]); w.w = pk2(v[8 * i + 6], v[8 * i + 7]); *(v4u*)(p + 8 * i) = w; }
        if (ts == 3) {
            LAS float* S = (LAS float*)lds;
#pragma unroll
            for (int i = 0; i < 32; ++i) S[r * 65 + hf * 32 + i] = v[i];
            __syncthreads();
            { const int col = tid & 63, part = tid >> 6; float s = 0.f;
#pragma unroll 8
                for (int rr = 0; rr < 32; ++rr) s += S[(part * 32 + rr) * 65 + col];
                __syncthreads();
                S[part * 65 + col] = s;
                __syncthreads();
                if (tid < 64) { float t = 0.f;
#pragma unroll
                    for (int pp = 0; pp < 8; ++pp) t += S[pp * 65 + tid];
                    kmean[(h * 64 + blk) * 64 + tid] = t; kmean[((8 + h) * 64 + blk) * 64 + tid] = 0.f; } }
            __syncthreads();
        }
    }
#endif
    {
        const bf16* xbc = (const bf16*)(ws + WS_XBC); bf16* xc = (bf16*)(ws + WS_XC);
        const float* cw = inp(a, I_CONVW) + (size_t)L * 4 * 1024; const float* cb = inp(a, I_CONVB) + (size_t)L * 1024;
        const float* dtraw = (const float*)(ws + WS_DT); float* csg = (float*)(ws + WS_CS);
        bf16* xdtT = (bf16*)((unsigned char*)outp(a) + XT_XDTT); bf16* xwT = (bf16*)((unsigned char*)outp(a) + XT_XWT); bf16* BT = (bf16*)(ws + WS_BT);
        const int lane = tid & 63, wave = tid >> 6;
        for (int item = bidx(); item < 64 * 12; item += G) {
            const int c = item / 12, q = item % 12, l0 = c * 256;
            const int chbase = (q < 8) ? q * 64 : (q < 10) ? 512 + (q - 8) * 128 : 768 + (q - 10) * 128;
            const int noct = (q < 8) ? 8 : 16;
            LAS float* xt = (LAS float*)lds;
            LAS bf16* bt = (LAS bf16*)lds;
            LAS float* csL = (LAS float*)(lds + 96 * 1024); LAS float* dtL = csL + 256;
            if (q < 8 && wave == 0) {
                const float av = -__expf(inp(a, I_ALOG)[L * 8 + q]), db = inp(a, I_DTB)[L * 8 + q];
                float dv[4], pc[4]; float run = 0.f;
#pragma unroll
                for (int i = 0; i < 4; ++i) { const float x = dtraw[(size_t)(l0 + 4 * lane + i) * 8 + q] + db; dv[i] = fmaxf(x, 0.f) + log1pf(__expf(-fabsf(x))); run += av * dv[i]; pc[i] = run; }
                float inc = run;
#pragma unroll
                for (int o = 1; o < 64; o <<= 1) { const float t = __builtin_bit_cast(float, __builtin_amdgcn_ds_bpermute(((lane - o) & 63) << 2, __builtin_bit_cast(int, inc))); if (lane >= o) inc += t; }
                const float ex = inc - run;
#pragma unroll
                for (int i = 0; i < 4; ++i) { csL[4 * lane + i] = ex + pc[i]; dtL[4 * lane + i] = dv[i]; }
                *(f32x4*)(csg + (size_t)(c * 8 + q) * 256 + 4 * lane) = (f32x4){ex + pc[0], ex + pc[1], ex + pc[2], ex + pc[3]};
            }
            {
                const int oc = (q < 8) ? (tid & 7) : (tid & 15), rg = (q < 8) ? (tid >> 3) : (tid >> 4), nrow = (q < 8) ? 4 : 8, ch = chbase + oc * 8, lb = rg * nrow;
                float wj[4][8], bs[8];
#pragma unroll
                for (int jj = 0; jj < 4; ++jj) { const f32x4 u = *(const f32x4*)(cw + jj * 1024 + ch), v = *(const f32x4*)(cw + jj * 1024 + ch + 4); wj[jj][0] = u.x; wj[jj][1] = u.y; wj[jj][2] = u.z; wj[jj][3] = u.w; wj[jj][4] = v.x; wj[jj][5] = v.y; wj[jj][6] = v.z; wj[jj][7] = v.w; }
                { const f32x4 u = *(const f32x4*)(cb + ch), v = *(const f32x4*)(cb + ch + 4); bs[0] = u.x; bs[1] = u.y; bs[2] = u.z; bs[3] = u.w; bs[4] = v.x; bs[5] = v.y; bs[6] = v.z; bs[7] = v.w; }
                float x0[8], x1[8], x2[8], x3[8];
                { const int p0 = l0 + lb - 3;
                  if (p0 >= 0) unpack8(*(const v4u*)(xbc + (size_t)p0 * 1024 + ch), x0); else {
#pragma unroll
                      for (int i = 0; i < 8; ++i) x0[i] = 0.f; }
                  if (p0 + 1 >= 0) unpack8(*(const v4u*)(xbc + (size_t)(p0 + 1) * 1024 + ch), x1); else {
#pragma unroll
                      for (int i = 0; i < 8; ++i) x1[i] = 0.f; }
                  if (p0 + 2 >= 0) unpack8(*(const v4u*)(xbc + (size_t)(p0 + 2) * 1024 + ch), x2); else {
#pragma unroll
                      for (int i = 0; i < 8; ++i) x2[i] = 0.f; } }
                v4u raw[8];
#pragma unroll
                for (int rr = 0; rr < 8; ++rr) if (rr < nrow) raw[rr] = *(const v4u*)(xbc + (size_t)(l0 + lb + rr) * 1024 + ch);
#pragma unroll
                for (int rr = 0; rr < 8; ++rr) {
                    if (rr < nrow) {
                    const int l = lb + rr, pos = l0 + l;
                    unpack8(raw[rr], x3);
                    float acc[8];
#pragma unroll
                    for (int i = 0; i < 8; ++i) acc[i] = siluf(bs[i] + wj[0][i] * x0[i] + wj[1][i] * x1[i] + wj[2][i] * x2[i] + wj[3][i] * x3[i]);
#pragma unroll
                    for (int i = 0; i < 8; ++i) { x0[i] = x1[i]; x1[i] = x2[i]; x2[i] = x3[i]; }
                    v4u w; w.x = pk2(acc[0], acc[1]); w.y = pk2(acc[2], acc[3]); w.z = pk2(acc[4], acc[5]); w.w = pk2(acc[6], acc[7]);
                    *(v4u*)(xc + (size_t)pos * 1024 + ch) = w;
                    if (q < 8) {
#pragma unroll
                        for (int i = 0; i < 8; ++i) xt[l * 65 + oc * 8 + i] = acc[i];
                    } else if (q < 10) { *(LAS v4u*)(bt + l * 136 + oc * 8) = w; }
                    }
                }
            }
            __syncthreads();
            if (q < 8) {
                const int p = tid & 63; const float cend = csL[255];
#pragma unroll
                for (int k = 0; k < 4; ++k) { const int lo = (tid >> 6) + 8 * k, lb = 8 * lo; float xd[8], xw[8];
#pragma unroll
                    for (int e = 0; e < 8; ++e) { const float x = xt[(lb + e) * 65 + p]; xd[e] = x * dtL[lb + e]; xw[e] = xd[e] * __expf(cend - csL[lb + e]); }
                    v4u w1, w2; w1.x = pk2(xd[0], xd[1]); w1.y = pk2(xd[2], xd[3]); w1.z = pk2(xd[4], xd[5]); w1.w = pk2(xd[6], xd[7]);
                    w2.x = pk2(xw[0], xw[1]); w2.y = pk2(xw[2], xw[3]); w2.z = pk2(xw[4], xw[5]); w2.w = pk2(xw[6], xw[7]);
                    const size_t o = ((size_t)(c * 8 + q) * 64 + p) * 256 + lb;
                    *(v4u*)(xdtT + o) = w1; *(v4u*)(xwT + o) = w2; }
            } else if (q < 10) {
                const int n = tid & 127;
#pragma unroll
                for (int k = 0; k < 8; ++k) { const int lo = (tid >> 7) + 4 * k, lb = 8 * lo; unsigned short e[8];
#pragma unroll
                    for (int i = 0; i < 8; ++i) e[i] = bt[(lb + i) * 136 + n];
                    v4u w; w.x = e[0] | ((unsigned)e[1] << 16); w.y = e[2] | ((unsigned)e[3] << 16); w.z = e[4] | ((unsigned)e[5] << 16); w.w = e[6] | ((unsigned)e[7] << 16);
                    *(v4u*)(BT + ((size_t)(c * 2 + (q - 8)) * 128 + n) * 256 + lb) = w; }
            }
            __syncthreads();
        }
    }
}

__device__ __forceinline__ float dot64(const float* q, const bf16* krow) {
    float s0 = 0.f, s1 = 0.f;
#pragma unroll
    for (int i = 0; i < 8; ++i) { const v4u w = *(const v4u*)(krow + 8 * i);
        s0 += q[8 * i] * bflo(w.x); s1 += q[8 * i + 1] * bfhi(w.x); s0 += q[8 * i + 2] * bflo(w.y); s1 += q[8 * i + 3] * bfhi(w.y);
        s0 += q[8 * i + 4] * bflo(w.z); s1 += q[8 * i + 5] * bfhi(w.z); s0 += q[8 * i + 6] * bflo(w.w); s1 += q[8 * i + 7] * bfhi(w.w); }
    return s0 + s1;
}
__device__ __forceinline__ void load_q64(const bf16* qrow, float* q) {
#pragma unroll
    for (int i = 0; i < 8; ++i) unpack8(*(const v4u*)(qrow + 8 * i), q + 8 * i);
}
typedef float f32x16 __attribute__((ext_vector_type(16)));
__device__ __forceinline__ int pi32(int r) { return (r & ~12) | ((r & 4) << 1) | ((r & 8) >> 1); }
__device__ __forceinline__ unsigned cvtpk(float lo, float hi) { unsigned r; asm volatile("v_cvt_pk_bf16_f32 %0, %1, %2" : "=v"(r) : "v"(lo), "v"(hi)); return r; }
__device__ __forceinline__ float dot2ones(unsigned w, float acc) { typedef __bf16 bf2_t __attribute__((ext_vector_type(2))); return __builtin_amdgcn_fdot2_f32_bf16(__builtin_bit_cast(bf2_t, w), __builtin_bit_cast(bf2_t, 0x3f803f80u), acc, false); }
__device__ __forceinline__ v4u pack8w(const f32x16& x, int b0) { v4u w; w.x = cvtpk(x[b0], x[b0 + 1]); w.y = cvtpk(x[b0 + 2], x[b0 + 3]); w.z = cvtpk(x[b0 + 4], x[b0 + 5]); w.w = cvtpk(x[b0 + 6], x[b0 + 7]); return w; }
__device__ __forceinline__ bf16x8 pack8(const f32x16& x, int b0) { v4u w; w.x = cvtpk(x[b0], x[b0 + 1]); w.y = cvtpk(x[b0 + 2], x[b0 + 3]); w.z = cvtpk(x[b0 + 4], x[b0 + 5]); w.w = cvtpk(x[b0 + 6], x[b0 + 7]); return __builtin_bit_cast(bf16x8, w); }
__device__ __forceinline__ bf16x8 cvt8(const float* p) { const f32x4 u = *(const f32x4*)p, v = *(const f32x4*)(p + 4); v4u w; w.x = cvtpk(u.x, u.y); w.y = cvtpk(u.z, u.w); w.z = cvtpk(v.x, v.y); w.w = cvtpk(v.z, v.w); return __builtin_bit_cast(bf16x8, w); }
__device__ __forceinline__ void ssd_states(unsigned char* ws, const unsigned char* xt, int lane, int gw, int NGW) {
    const bf16* xwT = (const bf16*)(xt + XT_XWT); const bf16* BT = (const bf16*)(ws + WS_BT); float* ST = (float*)(ws + WS_ST);
    const int r = lane & 31, hh = lane >> 5;
    for (int u = gw; u < 2048; u += NGW) {
        const int c = u >> 5, h = (u >> 2) & 7, j = u & 3, g = h >> 2;
        const bf16* A = xwT + (size_t)(c * 8 + h) * 64 * 256 + (size_t)r * 256 + hh * 8; const bf16* Bm = BT + (size_t)(c * 2 + g) * 128 * 256 + (size_t)(j * 32 + r) * 256 + hh * 8;
        f32x16 acc0 = f32x16{}, acc1 = f32x16{};
#pragma unroll
        for (int half = 0; half < 2; ++half) {
            bf16x8 a0[8], a1[8], bb[8];
#pragma unroll
            for (int k8 = 0; k8 < 8; ++k8) { const int ks = 8 * half + k8; a0[k8] = *(const bf16x8*)(A + ks * 16); a1[k8] = *(const bf16x8*)(A + 32 * 256 + ks * 16); bb[k8] = *(const bf16x8*)(Bm + ks * 16); }
            asm volatile("" : "+v"(a0[0]), "+v"(a0[1]), "+v"(a0[2]), "+v"(a0[3]), "+v"(a0[4]), "+v"(a0[5]), "+v"(a0[6]), "+v"(a0[7]), "+v"(a1[0]), "+v"(a1[1]), "+v"(a1[2]), "+v"(a1[3]), "+v"(a1[4]), "+v"(a1[5]), "+v"(a1[6]), "+v"(a1[7]),
                         "+v"(bb[0]), "+v"(bb[1]), "+v"(bb[2]), "+v"(bb[3]), "+v"(bb[4]), "+v"(bb[5]), "+v"(bb[6]), "+v"(bb[7]));
#pragma unroll
            for (int k8 = 0; k8 < 8; ++k8) { acc0 = __builtin_amdgcn_mfma_f32_32x32x16_bf16(a0[k8], bb[k8], acc0, 0, 0, 0); acc1 = __builtin_amdgcn_mfma_f32_32x32x16_bf16(a1[k8], bb[k8], acc1, 0, 0, 0); }
        }
        float* S = ST + (size_t)(c * 8 + h) * 64 * 128 + j * 32 + r;
#pragma unroll
        for (int reg = 0; reg < 16; ++reg) { const int p = (reg & 3) + 8 * (reg >> 2) + 4 * hh; S[(size_t)p * 128] = acc0[reg]; S[(size_t)(32 + p) * 128] = acc1[reg]; }
    }
}
__device__ __forceinline__ void ssd_scan(unsigned char* ws, unsigned char* xt, LAS unsigned char* lds, int tid, int G) {
    const float* ST = (const float*)(ws + WS_ST); bf16* STB = (bf16*)(xt + XT_STB); const float* csg = (const float*)(ws + WS_CS);
    LAS float* decL = (LAS float*)lds;
    for (int base = bidx() * 256; base < 8 * 8192; base += G * 256) {
        const int h = base >> 13, pn = (base & 8191) + (tid & 255);
        __syncthreads();
        if (tid < 64) decL[tid] = __expf(csg[(size_t)(tid * 8 + h) * 256 + 255]);
        __syncthreads();
        if (tid < 256) {
            float s[64];
#pragma unroll
            for (int c = 0; c < 64; ++c) s[c] = ST[(size_t)(c * 8 + h) * 8192 + pn];
            float hin = 0.f;
#pragma unroll
            for (int c = 0; c < 64; ++c) { STB[(size_t)(c * 8 + h) * 8192 + pn] = (bf16)f2bf(hin); hin = hin * decL[c] + s[c]; }
        }
    }
}
__device__ __forceinline__ void ssd_xt_tile(f32x16& acc0, f32x16& acc1, bf16x8 (&bfr)[8], const bf16x8 (&cf)[8], const bf16* At, const bf16* bnext, bool has_next, int st, const LAS float* csW, float csl, int lrel, int r, int hh) {
    f32x16 X = f32x16{};
#pragma unroll
    for (int k = 0; k < 8; ++k) X = __builtin_amdgcn_mfma_f32_32x32x16_bf16(bfr[k], cf[k], X, 0, 0, 0);
    const bf16x8 a00 = *(const bf16x8*)(At + (size_t)r * 256 + st * 32), a01 = *(const bf16x8*)(At + (size_t)r * 256 + st * 32 + 16);
    const bf16x8 a10 = *(const bf16x8*)(At + (size_t)(32 + r) * 256 + st * 32), a11 = *(const bf16x8*)(At + (size_t)(32 + r) * 256 + st * 32 + 16);
    if (has_next) {
#pragma unroll
        for (int k = 0; k < 8; ++k) bfr[k] = *(const bf16x8*)(bnext + k * 16); }
    f32x4 cw[4];
#pragma unroll
    for (int q4 = 0; q4 < 4; ++q4) cw[q4] = *(const LAS f32x4*)(csW + st * 32 + pi32(8 * q4 + 4 * hh));
    asm volatile("" : "+v"(cw[0]), "+v"(cw[1]), "+v"(cw[2]), "+v"(cw[3]));
#pragma unroll
    for (int q4 = 0; q4 < 4; ++q4) {
        const int s0 = st * 32 + pi32(8 * q4 + 4 * hh);
#pragma unroll
        for (int i = 0; i < 4; ++i) { const int reg = 4 * q4 + i; const float e = __expf(fminf(csl - cw[q4][i], 0.f)); X[reg] = (s0 + i <= lrel) ? X[reg] * e : 0.f; }
    }
    const bf16x8 m0 = pack8(X, 0), m1 = pack8(X, 8);
    acc0 = __builtin_amdgcn_mfma_f32_32x32x16_bf16(a00, m0, acc0, 0, 0, 0); acc0 = __builtin_amdgcn_mfma_f32_32x32x16_bf16(a01, m1, acc0, 0, 0, 0);
    acc1 = __builtin_amdgcn_mfma_f32_32x32x16_bf16(a10, m0, acc1, 0, 0, 0); acc1 = __builtin_amdgcn_mfma_f32_32x32x16_bf16(a11, m1, acc1, 0, 0, 0);
}
__device__ __forceinline__ void ssd_xt_tile_l(f32x16& acc0, f32x16& acc1, const LAS bf16* Bl, const bf16x8 (&cf)[8], const bf16* At, bf16x8 (&af)[4], bool has_next, int st, const LAS float* csW, float csl, int lrel, int r, int hh) {
    f32x16 X = f32x16{};
    const LAS bf16* br = Bl + (st * 32 + pi32(r)) * 136 + hh * 8;
    bf16x8 bk[8];
#pragma unroll
    for (int k = 0; k < 8; ++k) bk[k] = *(const LAS bf16x8*)(br + k * 16);
    asm volatile("" : "+v"(bk[0]), "+v"(bk[1]), "+v"(bk[2]), "+v"(bk[3]), "+v"(bk[4]), "+v"(bk[5]), "+v"(bk[6]), "+v"(bk[7]));
#pragma unroll
    for (int k = 0; k < 8; ++k) X = __builtin_amdgcn_mfma_f32_32x32x16_bf16(bk[k], cf[k], X, 0, 0, 0);
    const bf16x8 a00 = af[0], a01 = af[1], a10 = af[2], a11 = af[3];
    if (has_next) { af[0] = *(const bf16x8*)(At + (size_t)r * 256 + (st + 1) * 32); af[1] = *(const bf16x8*)(At + (size_t)r * 256 + (st + 1) * 32 + 16);
                    af[2] = *(const bf16x8*)(At + (size_t)(32 + r) * 256 + (st + 1) * 32); af[3] = *(const bf16x8*)(At + (size_t)(32 + r) * 256 + (st + 1) * 32 + 16); }
    f32x4 cw[4];
#pragma unroll
    for (int q4 = 0; q4 < 4; ++q4) cw[q4] = *(const LAS f32x4*)(csW + st * 32 + pi32(8 * q4 + 4 * hh));
    asm volatile("" : "+v"(cw[0]), "+v"(cw[1]), "+v"(cw[2]), "+v"(cw[3]));
#pragma unroll
    for (int q4 = 0; q4 < 4; ++q4) {
        const int s0 = st * 32 + pi32(8 * q4 + 4 * hh);
#pragma unroll
        for (int i = 0; i < 4; ++i) { const int reg = 4 * q4 + i; const float e = __expf(fminf(csl - cw[q4][i], 0.f)); X[reg] = (s0 + i <= lrel) ? X[reg] * e : 0.f; }
    }
    const bf16x8 m0 = pack8(X, 0), m1 = pack8(X, 8);
    acc0 = __builtin_amdgcn_mfma_f32_32x32x16_bf16(a00, m0, acc0, 0, 0, 0); acc0 = __builtin_amdgcn_mfma_f32_32x32x16_bf16(a01, m1, acc0, 0, 0, 0);
    acc1 = __builtin_amdgcn_mfma_f32_32x32x16_bf16(a10, m0, acc1, 0, 0, 0); acc1 = __builtin_amdgcn_mfma_f32_32x32x16_bf16(a11, m1, acc1, 0, 0, 0);
}
__device__ __forceinline__ void ssd_out(const Args& a, int L, LAS unsigned char* lds, int lane_in, int wave, int G) {
    unsigned char* ws = wsp(a);
    const bf16* xc = (const bf16*)(ws + WS_XC); const bf16* xdtT = (const bf16*)((const unsigned char*)outp(a) + XT_XDTT); const bf16* STB = (const bf16*)((const unsigned char*)outp(a) + XT_STB); const float* csg = (const float*)(ws + WS_CS);
    const bf16* Z = (const bf16*)(ws + WS_Z); bf16* mix = (bf16*)(ws + WS_MIX);
    LAS bf16* Bl = (LAS bf16*)lds;
    LAS unsigned char* wl = lds + ((wave < 6) ? 69632 + wave * 10240 : 132096 + (wave - 6) * 10240);
    LAS float* csW = (LAS float*)wl;
    LAS bf16* xt = (LAS bf16*)(wl + 1024);
    LAS bf16* zt = (LAS bf16*)(wl + 1024 + 4352);
    LAS float* nwL = (LAS float*)(wl + 1024 + 2 * 4352);
    LAS float* ssx = (LAS float*)(lds + 152576);
    typedef unsigned u32x2 __attribute__((ext_vector_type(2)));
    for (int unit = bidx(); unit < 256; unit += G) {
        int lane = lane_in; asm volatile("" : "+v"(lane));
        const int r = lane & 31, hh = lane >> 5;
        const int c = unit >> 2, g = (unit >> 1) & 1, hd = wave & 3, tpi = wave >> 2, tp = 2 * (unit & 1) + tpi, h = 4 * g + hd;
        {
            const int tid_ = wave * 64 + lane;
            v4u bt[8];
#pragma unroll
            for (int i = 0; i < 8; ++i) { const int id = tid_ + 512 * i; bt[i] = *(const v4u*)(xc + (size_t)(c * 256 + (id >> 4)) * 1024 + 512 + g * 128 + (id & 15) * 8); }
#pragma unroll
            for (int i = 0; i < 8; ++i) { const int id = tid_ + 512 * i; *(LAS v4u*)(Bl + (id >> 4) * 136 + (id & 15) * 8) = bt[i]; }
        }
        *(LAS f32x4*)(csW + 4 * lane) = *(const f32x4*)(csg + (size_t)(c * 8 + h) * 256 + 4 * lane);
        if (lane < 16) *(LAS f32x4*)(nwL + 4 * lane) = *(const f32x4*)(inp(a, I_SNORM) + L * 512 + h * 64 + 4 * lane);
        const float Dk = inp(a, I_DSKIP)[L * 8 + h];
        const bf16* At = xdtT + (size_t)(c * 8 + h) * 64 * 256 + hh * 8;
        const bf16* Hin = STB + (size_t)(c * 8 + h) * 8192 + hh * 8;
        LDS_WAIT(); asm volatile("" ::: "memory");
        __syncthreads();
        for (int ti = 0; ti < 2; ++ti) {
            const int w = ti ? 7 - tp : tp, l0 = 32 * w, posl = c * 256 + l0 + r;
            bf16x8 cf[8];
#pragma unroll
            for (int k = 0; k < 8; ++k) cf[k] = *(const bf16x8*)(xc + (size_t)posl * 1024 + 768 + g * 128 + k * 16 + hh * 8);
            bf16x8 af[4];
            af[0] = *(const bf16x8*)(At + (size_t)r * 256); af[1] = *(const bf16x8*)(At + (size_t)r * 256 + 16); af[2] = *(const bf16x8*)(At + (size_t)(32 + r) * 256); af[3] = *(const bf16x8*)(At + (size_t)(32 + r) * 256 + 16);
            f32x16 acc0 = f32x16{}, acc1 = f32x16{};
            if (!FLG(a, 64)) {
            bf16x8 h0[8], h1[8];
#pragma unroll
            for (int k = 0; k < 8; ++k) { h0[k] = *(const bf16x8*)(Hin + (size_t)r * 128 + k * 16); h1[k] = *(const bf16x8*)(Hin + (size_t)(32 + r) * 128 + k * 16); }
            asm volatile("" : "+v"(h0[0]), "+v"(h0[1]), "+v"(h0[2]), "+v"(h0[3]), "+v"(h0[4]), "+v"(h0[5]), "+v"(h0[6]), "+v"(h0[7]), "+v"(h1[0]), "+v"(h1[1]), "+v"(h1[2]), "+v"(h1[3]), "+v"(h1[4]), "+v"(h1[5]), "+v"(h1[6]), "+v"(h1[7]));
#pragma unroll
            for (int k = 0; k < 8; ++k) { acc0 = __builtin_amdgcn_mfma_f32_32x32x16_bf16(h0[k], cf[k], acc0, 0, 0, 0); acc1 = __builtin_amdgcn_mfma_f32_32x32x16_bf16(h1[k], cf[k], acc1, 0, 0, 0); } }
            const float csl = csW[l0 + r], el = __expf(csl);
#pragma unroll
            for (int i = 0; i < 16; ++i) { acc0[i] *= el; acc1[i] *= el; }
            v4u xvr[4], zvr[4];
#pragma unroll
            for (int k = 0; k < 4; ++k) { const int id = lane + 64 * k, row = id >> 3, oc = id & 7; const size_t pos = (size_t)(c * 256 + l0 + row);
                xvr[k] = *(const v4u*)(xc + pos * 1024 + h * 64 + oc * 8); zvr[k] = *(const v4u*)(Z + pos * 512 + h * 64 + oc * 8); }
            if (!FLG(a, 128)) for (int st = 0; st <= w; ++st) ssd_xt_tile_l(acc0, acc1, Bl, cf, At, af, st < w, st, csW, csl, l0 + r, r, hh);
            float ss = 0.f;
#pragma unroll
            for (int k = 0; k < 4; ++k) { const int id = lane + 64 * k, row = id >> 3, oc = id & 7;
                const v4u xv = xvr[k], zv = zvr[k];
                *(LAS u32x2*)(xt + row * 68 + oc * 8) = (u32x2){xv.x, xv.y}; *(LAS u32x2*)(xt + row * 68 + oc * 8 + 4) = (u32x2){xv.z, xv.w};
                *(LAS u32x2*)(zt + row * 68 + oc * 8) = (u32x2){zv.x, zv.y}; *(LAS u32x2*)(zt + row * 68 + oc * 8 + 4) = (u32x2){zv.z, zv.w}; }
            LDS_WAIT(); asm volatile("" ::: "memory");
            if (!FLG(a, 256))
#pragma unroll
            for (int q = 0; q < 4; ++q) { const int pb = 8 * q + 4 * hh;
                const u32x2 xa = *(const LAS u32x2*)(xt + r * 68 + pb), za = *(const LAS u32x2*)(zt + r * 68 + pb), xb = *(const LAS u32x2*)(xt + r * 68 + 32 + pb), zb = *(const LAS u32x2*)(zt + r * 68 + 32 + pb);
                const float x0[4] = {bflo(xa.x), bfhi(xa.x), bflo(xa.y), bfhi(xa.y)}, z0[4] = {bflo(za.x), bfhi(za.x), bflo(za.y), bfhi(za.y)};
                const float x1[4] = {bflo(xb.x), bfhi(xb.x), bflo(xb.y), bfhi(xb.y)}, z1[4] = {bflo(zb.x), bfhi(zb.x), bflo(zb.y), bfhi(zb.y)};
#pragma unroll
                for (int i = 0; i < 4; ++i) { const int reg = 4 * q + i;
                    { const float gv = (acc0[reg] + Dk * x0[i]) * siluf(z0[i]); acc0[reg] = gv; ss += gv * gv; }
                    { const float gv = (acc1[reg] + Dk * x1[i]) * siluf(z1[i]); acc1[reg] = gv; ss += gv * gv; } } }
            LDS_WAIT(); asm volatile("" ::: "memory");
            ss = xadd32(ss);
            if (lane < 32) ssx[(tpi * 4 + hd) * 32 + r] = ss;
            __syncthreads();
            const LAS float* sp = ssx + tpi * 128 + r;
            const float sst = (sp[0] + sp[32]) + (sp[64] + sp[96]);
            const float rstd = __builtin_amdgcn_rsqf(sst * (1.f / 256.f) + EPS);
#pragma unroll
            for (int q = 0; q < 4; ++q) { const int pb = 8 * q + 4 * hh; const f32x4 n0 = *(const LAS f32x4*)(nwL + pb), n1 = *(const LAS f32x4*)(nwL + 32 + pb);
                *(LAS u32x2*)(xt + r * 68 + pb) = (u32x2){cvtpk(acc0[4 * q] * rstd * n0[0], acc0[4 * q + 1] * rstd * n0[1]), cvtpk(acc0[4 * q + 2] * rstd * n0[2], acc0[4 * q + 3] * rstd * n0[3])};
                *(LAS u32x2*)(xt + r * 68 + 32 + pb) = (u32x2){cvtpk(acc1[4 * q] * rstd * n1[0], acc1[4 * q + 1] * rstd * n1[1]), cvtpk(acc1[4 * q + 2] * rstd * n1[2], acc1[4 * q + 3] * rstd * n1[3])}; }
            LDS_WAIT(); asm volatile("" ::: "memory");
            u32x2 lo[4], hi[4];
#pragma unroll
            for (int k = 0; k < 4; ++k) { const int id = lane + 64 * k, row = id >> 3, oc = id & 7; lo[k] = *(const LAS u32x2*)(xt + row * 68 + oc * 8); hi[k] = *(const LAS u32x2*)(xt + row * 68 + oc * 8 + 4); }
            asm volatile("" : "+v"(lo[0]), "+v"(lo[1]), "+v"(lo[2]), "+v"(lo[3]), "+v"(hi[0]), "+v"(hi[1]), "+v"(hi[2]), "+v"(hi[3]));
#pragma unroll
            for (int k = 0; k < 4; ++k) { const int id = lane + 64 * k, row = id >> 3, oc = id & 7; const size_t pos = (size_t)(c * 256 + l0 + row);
                *(v4u*)(mix + pos * MIXW + 512 + h * 64 + oc * 8) = (v4u){lo[k].x, lo[k].y, hi[k].x, hi[k].y}; }
            LDS_WAIT(); asm volatile("" ::: "memory");
            __syncthreads();
        }
    }
}
struct AttnAcc { f32x16 o0, o1, negm; float l; };
typedef short v4i16_t __attribute__((ext_vector_type(4)));
__device__ __forceinline__ v4i16_t vtr(const LAS bf16* p) { return __builtin_amdgcn_ds_read_tr16_b64_v4i16((LAS v4i16_t*)p); }
struct TileD { int koff, kstride; bool on, mask; };
struct TileR { bf16x8 kf[4]; v4u vv[4]; };
__device__ __forceinline__ void attn_load(TileR& R, const TileD& d, const bf16* Kh, const bf16* Vh, int lane) {
    const int r = lane & 31, hh = lane >> 5;
    int kpa = d.koff + d.kstride * pi32(r); kpa = kpa < 0 ? 0 : (kpa > SEQ - 1 ? SEQ - 1 : kpa);
#pragma unroll
    for (int k = 0; k < 4; ++k) R.kf[k] = *(const bf16x8*)(Kh + (size_t)kpa * 64 + k * 16 + hh * 8);
#pragma unroll
    for (int k = 0; k < 4; ++k) { const int id = lane + 64 * k, key = id >> 3, oc = id & 7; int kp = d.koff + d.kstride * key; kp = kp < 0 ? 0 : (kp > SEQ - 1 ? SEQ - 1 : kp);
        R.vv[k] = *(const v4u*)(Vh + (size_t)kp * 64 + oc * 8); }
}
template <int MASK>
__device__ __forceinline__ void attn_compute(AttnAcc& A, const bf16x8 (&qf)[4], const TileR& R, const TileD& d, int qp, LAS bf16* vt, int lane) {
    const int r = lane & 31, hh = lane >> 5; (void)r;
    const int koff = d.koff, kstride = d.kstride;
#pragma unroll
    for (int k = 0; k < 4; ++k) { const int id = lane + 64 * k, key = id >> 3, oc = id & 7; *(LAS v4u*)(vt + key * 64 + oc * 8) = R.vv[k]; }
    f32x16 X = __builtin_amdgcn_mfma_f32_32x32x16_bf16(R.kf[0], qf[0], A.negm, 0, 0, 0);
#pragma unroll
    for (int k = 1; k < 4; ++k) X = __builtin_amdgcn_mfma_f32_32x32x16_bf16(R.kf[k], qf[k], X, 0, 0, 0);
    if (MASK != 0 && d.mask) {
        const int dq0 = qp - koff; const unsigned lim = (MASK == 1) ? 0x7fffffffu : (unsigned)(128 * kstride);
        if (koff >= 0) {
#pragma unroll
            for (int reg = 0; reg < 16; ++reg) { const int c = pi32((reg & 3) + 8 * (reg >> 2)) ; const unsigned dq = (unsigned)(dq0 - kstride * (c + 8 * hh)); X[reg] = (dq <= lim) ? X[reg] : -INFINITY; }
        } else {
#pragma unroll
            for (int reg = 0; reg < 16; ++reg) { const int c = pi32((reg & 3) + 8 * (reg >> 2)); const int kq = kstride * (c + 8 * hh); const unsigned dq = (unsigned)(dq0 - kq); X[reg] = (dq <= lim && koff + kq >= 0) ? X[reg] : -INFINITY; }
        }
    }
    float ls = 0.f;
#pragma unroll
    for (int reg = 0; reg < 16; ++reg) { X[reg] = __builtin_amdgcn_exp2f(X[reg]); ls += X[reg]; }
    A.l += ls;
    const bf16x8 p0 = pack8(X, 0), p1 = pack8(X, 8);
    LDS_WAIT(); asm volatile("" ::: "memory");
    const LAS bf16* vb = vt + (8 * hh + ((lane & 15) >> 2)) * 64 + 16 * ((lane >> 4) & 1) + 4 * (lane & 3);
#pragma unroll
    for (int dt = 0; dt < 2; ++dt) {
        const v4i16_t a0 = vtr(vb + dt * 32), a1 = vtr(vb + dt * 32 + 4 * 64), a2 = vtr(vb + dt * 32 + 16 * 64), a3 = vtr(vb + dt * 32 + 20 * 64);
        const bf16x8 f0 = (bf16x8){a0[0], a0[1], a0[2], a0[3], a1[0], a1[1], a1[2], a1[3]}, f1 = (bf16x8){a2[0], a2[1], a2[2], a2[3], a3[0], a3[1], a3[2], a3[3]};
        if (dt == 0) { A.o0 = __builtin_amdgcn_mfma_f32_32x32x16_bf16(f0, p0, A.o0, 0, 0, 0); A.o0 = __builtin_amdgcn_mfma_f32_32x32x16_bf16(f1, p1, A.o0, 0, 0, 0); }
        else { A.o1 = __builtin_amdgcn_mfma_f32_32x32x16_bf16(f0, p0, A.o1, 0, 0, 0); A.o1 = __builtin_amdgcn_mfma_f32_32x32x16_bf16(f1, p1, A.o1, 0, 0, 0); }
    }
    LDS_WAIT(); asm volatile("" ::: "memory");
}
template <int MASK, class TF>
__device__ __forceinline__ void attn_run(AttnAcc& A, const bf16x8 (&qf)[4], const bf16* Kh, const bf16* Vh, int qp, LAS bf16* vt, int lane, int ntiles, const TF& tf) {
    TileD d0 = tf(0), d1; TileR R0, R1;
    if (d0.on) attn_load(R0, d0, Kh, Vh, lane);
    for (int n = 0; n < ntiles; n += 2) {
        d1 = (n + 1 < ntiles) ? tf(n + 1) : TileD{0, 1, false, false};
        if (d1.on) attn_load(R1, d1, Kh, Vh, lane);
        if (d0.on) attn_compute<MASK>(A, qf, R0, d0, qp, vt, lane);
        d0 = (n + 2 < ntiles) ? tf(n + 2) : TileD{0, 1, false, false};
        if (d0.on) attn_load(R0, d0, Kh, Vh, lane);
        if (d1.on) attn_compute<MASK>(A, qf, R1, d1, qp, vt, lane);
    }
}
template <int MASK>
__device__ __forceinline__ void attn_run_fast(AttnAcc& A, const bf16x8 (&qf)[4], const bf16* Kh, const bf16* Vh, int qp, LAS bf16* vt, LAS bf16* kt, int lane, int ntiles, int koff0, int kstride, unsigned maskbits) {
    const int r = lane & 31, hh = lane >> 5;
    const size_t rowoff = (size_t)(koff0 + kstride * (lane >> 3)) * 64 + (lane & 7) * 8;
    const bf16* kp = Kh + rowoff; const bf16* vp = Vh + rowoff;
    const int tstep = 32 * kstride * 64, vstep = 8 * kstride * 64;
    v4u kk[4], vv[4];
#pragma unroll
    for (int k = 0; k < 4; ++k) { kk[k] = *(const v4u*)(kp + (size_t)k * vstep); vv[k] = *(const v4u*)(vp + (size_t)k * vstep); }
    const int wrow = lane >> 3, woc = lane & 7;
    const int rho = pi32(r);
    int koff = koff0;
#pragma unroll 1
    for (int n = 0; n < ntiles; ++n) {
        const bool more = (n + 1 < ntiles);
        kp += tstep; vp += tstep;
#pragma unroll
        for (int k = 0; k < 4; ++k) { const int key = wrow + 8 * k; *(LAS v4u*)(kt + key * 64 + ((woc ^ (key & 7)) * 8)) = kk[k]; *(LAS v4u*)(vt + key * 64 + woc * 8) = vv[k]; }
        if (more) {
#pragma unroll
            for (int k = 0; k < 4; ++k) { kk[k] = *(const v4u*)(kp + (size_t)k * vstep); vv[k] = *(const v4u*)(vp + (size_t)k * vstep); } }
        bf16x8 kf[4];
#pragma unroll
        for (int k = 0; k < 4; ++k) kf[k] = *(const LAS bf16x8*)(kt + rho * 64 + (((2 * k + hh) ^ (rho & 7)) * 8));
        f32x16 X = __builtin_amdgcn_mfma_f32_32x32x16_bf16(kf[0], qf[0], A.negm, 0, 0, 0);
#pragma unroll
        for (int k = 1; k < 4; ++k) X = __builtin_amdgcn_mfma_f32_32x32x16_bf16(kf[k], qf[k], X, 0, 0, 0);
        if (MASK != 0 && ((maskbits >> n) & 1u)) {
            const int dq0 = qp - koff; const unsigned lim = (MASK == 1) ? 0x7fffffffu : (unsigned)(128 * kstride);
#pragma unroll
            for (int reg = 0; reg < 16; ++reg) { const int c = pi32((reg & 3) + 8 * (reg >> 2)); const unsigned dq = (unsigned)(dq0 - kstride * (c + 8 * hh)); X[reg] = (dq <= lim) ? X[reg] : -INFINITY; }
        }
        float ls = 0.f;
#pragma unroll
        for (int reg = 0; reg < 16; ++reg) { X[reg] = __builtin_amdgcn_exp2f(X[reg]); ls += X[reg]; }
        A.l += ls;
        const bf16x8 p0 = pack8(X, 0), p1 = pack8(X, 8);
        const LAS bf16* vb = vt + (8 * hh + ((lane & 15) >> 2)) * 64 + 16 * ((lane >> 4) & 1) + 4 * (lane & 3);
#pragma unroll
        for (int dt = 0; dt < 2; ++dt) {
            const v4i16_t a0 = vtr(vb + dt * 32), a1 = vtr(vb + dt * 32 + 4 * 64), a2 = vtr(vb + dt * 32 + 16 * 64), a3 = vtr(vb + dt * 32 + 20 * 64);
            const bf16x8 f0 = (bf16x8){a0[0], a0[1], a0[2], a0[3], a1[0], a1[1], a1[2], a1[3]}, f1 = (bf16x8){a2[0], a2[1], a2[2], a2[3], a3[0], a3[1], a3[2], a3[3]};
            if (dt == 0) { A.o0 = __builtin_amdgcn_mfma_f32_32x32x16_bf16(f0, p0, A.o0, 0, 0, 0); A.o0 = __builtin_amdgcn_mfma_f32_32x32x16_bf16(f1, p1, A.o0, 0, 0, 0); }
            else { A.o1 = __builtin_amdgcn_mfma_f32_32x32x16_bf16(f0, p0, A.o1, 0, 0, 0); A.o1 = __builtin_amdgcn_mfma_f32_32x32x16_bf16(f1, p1, A.o1, 0, 0, 0); }
        }
        koff += 32 * kstride;
    }
}
struct AttnAcc2 { f32x16 o0[2], o1[2]; float l[2], nB; };
template <int MASK>
__device__ __forceinline__ void attn_run_fast2(AttnAcc2& A, const bf16x8 (&qf)[2][4], const bf16* Kh, const bf16* Vh, const int (&qp)[2], LAS bf16* vt, LAS bf16* kt, int lane, int ntiles, int koff0, int kstride,
                                               const unsigned (&skip)[2], const unsigned (&maskb)[2], int n_start = 0) {
    const int r = lane & 31, hh = lane >> 5;
    const size_t rowoff = (size_t)(koff0 + kstride * (32 * n_start + (lane >> 3))) * 64 + (lane & 7) * 8;
    const bf16* kp = Kh + rowoff; const bf16* vp = Vh + rowoff;
    const int tstep = 32 * kstride * 64, vstep = 8 * kstride * 64;
    v4u kk[4], vv[4];
#pragma unroll
    for (int k = 0; k < 4; ++k) { kk[k] = *(const v4u*)(kp + (size_t)k * vstep); vv[k] = *(const v4u*)(vp + (size_t)k * vstep); }
    const int wrow = lane >> 3, woc = lane & 7, rho = pi32(r);
    int koff = koff0 + 32 * kstride * n_start;
#pragma unroll 1
    for (int n = n_start; n < ntiles; ++n) {
        const bool more = (n + 1 < ntiles);
        kp += tstep; vp += tstep;
#pragma unroll
        for (int k = 0; k < 4; ++k) { const int key = wrow + 8 * k; *(LAS v4u*)(kt + key * 64 + ((woc ^ ((key >> 1) & 7)) * 8)) = kk[k]; *(LAS v4u*)(vt + key * 64 + ((woc ^ (4 * ((key >> 1) & 1))) * 8)) = vv[k]; }
        if (more) {
#pragma unroll
            for (int k = 0; k < 4; ++k) { kk[k] = *(const v4u*)(kp + (size_t)k * vstep); vv[k] = *(const v4u*)(vp + (size_t)k * vstep); } }
        bf16x8 kf[4];
#pragma unroll
        for (int k = 0; k < 4; ++k) kf[k] = *(const LAS bf16x8*)(kt + rho * 64 + (((2 * k + hh) ^ ((rho >> 1) & 7)) * 8));
        const LAS bf16* vb = vt + (8 * hh + ((lane & 15) >> 2)) * 64 + ((16 * ((lane >> 4) & 1) + 4 * (lane & 3)) ^ (32 * ((lane >> 3) & 1)));
        bf16x8 vf[2][2];
#pragma unroll
        for (int dt = 0; dt < 2; ++dt) {
            const LAS bf16* vd = dt ? (const LAS bf16*)((unsigned)(size_t)vb ^ 64u) : vb;
            const v4i16_t a0 = vtr(vd), a1 = vtr(vd + 4 * 64), a2 = vtr(vd + 16 * 64), a3 = vtr(vd + 20 * 64);
            vf[dt][0] = (bf16x8){a0[0], a0[1], a0[2], a0[3], a1[0], a1[1], a1[2], a1[3]}; vf[dt][1] = (bf16x8){a2[0], a2[1], a2[2], a2[3], a3[0], a3[1], a3[2], a3[3]};
        }
#pragma unroll
        for (int g = 0; g < 2; ++g) {
            if ((skip[g] >> n) & 1u) continue;
            f32x16 X = __builtin_amdgcn_mfma_f32_32x32x16_bf16(kf[0], qf[g][0], f32x16{}, 0, 0, 0);
#pragma unroll
            for (int k = 1; k < 4; ++k) X = __builtin_amdgcn_mfma_f32_32x32x16_bf16(kf[k], qf[g][k], X, 0, 0, 0);
            if (MASK != 0 && ((maskb[g] >> n) & 1u)) {
                const int dq0 = qp[g] - koff; const unsigned lim = (MASK == 1) ? 0x7fffffffu : (unsigned)(128 * kstride);
#pragma unroll
                for (int reg = 0; reg < 16; ++reg) { const int c = pi32((reg & 3) + 8 * (reg >> 2)); const unsigned dq = (unsigned)(dq0 - kstride * (c + 8 * hh)); X[reg] = (dq <= lim) ? X[reg] : -INFINITY; }
            }
            float ls = 0.f;
#pragma unroll
            for (int reg = 0; reg < 16; ++reg) { X[reg] = __builtin_amdgcn_exp2f(X[reg] + A.nB); ls += X[reg]; }
            A.l[g] += ls;
            const bf16x8 p0 = pack8(X, 0), p1 = pack8(X, 8);
            A.o0[g] = __builtin_amdgcn_mfma_f32_32x32x16_bf16(vf[0][0], p0, A.o0[g], 0, 0, 0); A.o0[g] = __builtin_amdgcn_mfma_f32_32x32x16_bf16(vf[0][1], p1, A.o0[g], 0, 0, 0);
            A.o1[g] = __builtin_amdgcn_mfma_f32_32x32x16_bf16(vf[1][0], p0, A.o1[g], 0, 0, 0); A.o1[g] = __builtin_amdgcn_mfma_f32_32x32x16_bf16(vf[1][1], p1, A.o1[g], 0, 0, 0);
        }
        koff += 32 * kstride;
    }
}
__device__ __forceinline__ void attn_run_lds2(AttnAcc2& A, const bf16x8 (&qf)[2][4], const LAS bf16* ktS, const LAS bf16* vtS, int lane, int ntiles, const unsigned (&skip)[2]) {
    const int r = lane & 31, hh = lane >> 5, rho = pi32(r);
    const LAS bf16* kb = ktS + rho * 64;
    const LAS bf16* vb = vtS + (8 * hh + ((lane & 15) >> 2)) * 64 + ((16 * ((lane >> 4) & 1) + 4 * (lane & 3)) ^ (32 * ((lane >> 3) & 1)));
    f32x16 NB16;
#pragma unroll
    for (int i = 0; i < 16; ++i) NB16[i] = A.nB;
    asm volatile("" : "+v"(NB16));
    const bool both = (skip[1] == 0u);
    auto frags = [&](bf16x8 (&kf)[4], bf16x8 (&vf)[2][2]) {
#pragma unroll
        for (int k = 0; k < 4; ++k) kf[k] = *(const LAS bf16x8*)(kb + (((2 * k + hh) ^ ((rho >> 1) & 7)) * 8));
#pragma unroll
        for (int dt = 0; dt < 2; ++dt) {
            const LAS bf16* vd = dt ? (const LAS bf16*)((unsigned)(size_t)vb ^ 64u) : vb;
            const v4i16_t a0 = vtr(vd), a1 = vtr(vd + 4 * 64), a2 = vtr(vd + 16 * 64), a3 = vtr(vd + 20 * 64);
            vf[dt][0] = (bf16x8){a0[0], a0[1], a0[2], a0[3], a1[0], a1[1], a1[2], a1[3]}; vf[dt][1] = (bf16x8){a2[0], a2[1], a2[2], a2[3], a3[0], a3[1], a3[2], a3[3]};
        }
        kb += 2048; vb += 2048; };
    auto qk = [&](int g, const bf16x8 (&kf)[4]) { f32x16 X = __builtin_amdgcn_mfma_f32_32x32x16_bf16(kf[0], qf[g][0], NB16, 0, 0, 0);
#pragma unroll
        for (int k = 1; k < 4; ++k) X = __builtin_amdgcn_mfma_f32_32x32x16_bf16(kf[k], qf[g][k], X, 0, 0, 0);
        return X; };
    auto soft_pv = [&](int g, f32x16 X, const bf16x8 (&vf)[2][2]) {
#pragma unroll
        for (int reg = 0; reg < 16; ++reg) X[reg] = __builtin_amdgcn_exp2f(X[reg]);
        const v4u w0 = pack8w(X, 0), w1 = pack8w(X, 8);
        float la = A.l[g], lb = 0.f;
        la = dot2ones(w0.x, la); lb = dot2ones(w0.y, lb); la = dot2ones(w0.z, la); lb = dot2ones(w0.w, lb);
        la = dot2ones(w1.x, la); lb = dot2ones(w1.y, lb); la = dot2ones(w1.z, la); lb = dot2ones(w1.w, lb);
        A.l[g] = la + lb;
        bf16x8 p0, p1; __builtin_memcpy(&p0, &w0, 16); __builtin_memcpy(&p1, &w1, 16);
        A.o0[g] = __builtin_amdgcn_mfma_f32_32x32x16_bf16(vf[0][0], p0, A.o0[g], 0, 0, 0); A.o0[g] = __builtin_amdgcn_mfma_f32_32x32x16_bf16(vf[0][1], p1, A.o0[g], 0, 0, 0);
        A.o1[g] = __builtin_amdgcn_mfma_f32_32x32x16_bf16(vf[1][0], p0, A.o1[g], 0, 0, 0); A.o1[g] = __builtin_amdgcn_mfma_f32_32x32x16_bf16(vf[1][1], p1, A.o1[g], 0, 0, 0); };
    if (both) {
#pragma unroll 1
        for (int n = 0; n < ntiles; ++n) {
            bf16x8 kf[4], vf[2][2]; frags(kf, vf);
            const f32x16 X0 = qk(0, kf), X1 = qk(1, kf);
            soft_pv(0, X0, vf); soft_pv(1, X1, vf);
        }
    } else {
#pragma unroll 1
        for (int n = 0; n < ntiles; ++n) {
            bf16x8 kf[4], vf[2][2]; frags(kf, vf);
            if ((skip[0] >> n) & 1u) continue;
            soft_pv(0, qk(0, kf), vf);
        }
    }
}
__device__ __forceinline__ void attn_init2(AttnAcc2& A, float nB) {
#pragma unroll
    for (int g = 0; g < 2; ++g) { A.o0[g] = f32x16{}; A.o1[g] = f32x16{}; A.l[g] = 0.f; }
    A.nB = nB;
}
__device__ __forceinline__ void attn_init(AttnAcc& A, float nB) { A.o0 = f32x16{}; A.o1 = f32x16{};
#pragma unroll
    for (int i = 0; i < 16; ++i) A.negm[i] = nB;
    A.l = 0.f; }
__device__ __forceinline__ float attn_negB(const float* gq, const float* gk, int lane) { return __builtin_bit_cast(float, __builtin_amdgcn_readfirstlane(__builtin_bit_cast(int, -64.0f * C2 * wave_max(fabsf(gq[lane])) * wave_max(fabsf(gk[lane]))))); }
__device__ __forceinline__ void attn_store_rows2(const f32x16& o0, const f32x16& o1, float sc, LAS bf16* ot, bf16* dst0, size_t row_stride, int lane) {
    const int r = lane & 31, hh = lane >> 5;
    typedef unsigned u32x2 __attribute__((ext_vector_type(2)));
#pragma unroll
    for (int q = 0; q < 4; ++q) { const int db = 8 * q + 4 * hh;
        *(LAS u32x2*)(ot + r * 68 + db) = (u32x2){cvtpk(o0[4 * q] * sc, o0[4 * q + 1] * sc), cvtpk(o0[4 * q + 2] * sc, o0[4 * q + 3] * sc)};
        *(LAS u32x2*)(ot + r * 68 + 32 + db) = (u32x2){cvtpk(o1[4 * q] * sc, o1[4 * q + 1] * sc), cvtpk(o1[4 * q + 2] * sc, o1[4 * q + 3] * sc)}; }
    LDS_WAIT(); asm volatile("" ::: "memory");
    u32x2 lo[4], hi[4];
#pragma unroll
    for (int k = 0; k < 4; ++k) { const int id = lane + 64 * k, row = id >> 3, oc = id & 7; lo[k] = *(const LAS u32x2*)(ot + row * 68 + oc * 8); hi[k] = *(const LAS u32x2*)(ot + row * 68 + oc * 8 + 4); }
    asm volatile("" : "+v"(lo[0]), "+v"(lo[1]), "+v"(lo[2]), "+v"(lo[3]), "+v"(hi[0]), "+v"(hi[1]), "+v"(hi[2]), "+v"(hi[3]));
#pragma unroll
    for (int k = 0; k < 4; ++k) { const int id = lane + 64 * k, row = id >> 3, oc = id & 7;
        *(v4u*)(dst0 + (size_t)row * row_stride + oc * 8) = (v4u){lo[k].x, lo[k].y, hi[k].x, hi[k].y}; }
    LDS_WAIT(); asm volatile("" ::: "memory");
}
__device__ __forceinline__ void attn_store_rows(const AttnAcc& A, float sc, LAS bf16* ot, bf16* dst0, size_t row_stride, int lane) { attn_store_rows2(A.o0, A.o1, sc, ot, dst0, row_stride, lane); }
__device__ __forceinline__ void swa_pass(const Args& a, int L, LAS unsigned char* lds, int lane, int wave, int G) {
    unsigned char* ws = wsp(a);
    const float nB = attn_negB(inp(a, I_QNS) + L * HD, inp(a, I_KNS) + L * HD, lane);
    const int h = (int)bidx() & 7, slot = ((int)bidx() >> 3) * NWAVES + wave, nslots = (G >> 3) * NWAVES;
    const bf16* Q = (const bf16*)(ws + WS_QKV) + (size_t)(0 * 8 + h) * SEQ * 64; const bf16* K = (const bf16*)(ws + WS_QKV) + (size_t)(1 * 8 + h) * SEQ * 64;
    const bf16* V = (const bf16*)(ws + WS_QKV) + (size_t)(2 * 8 + h) * SEQ * 64;
    bf16* mix = (bf16*)(ws + WS_MIX); float* SL = (float*)(ws + WS_PS) + (size_t)SEQ * 8 * 3;
    LAS bf16* vt = (LAS bf16*)(lds + wave * 12800); LAS bf16* kt = (LAS bf16*)(lds + wave * 12800 + 4096); LAS bf16* ot = (LAS bf16*)(lds + wave * 12800 + 8192);
    const int r = lane & 31, hh = lane >> 5;
    bf16x8 qn[2][4];
    auto qload = [&](int uu_) { const int br_ = uu_ >> 8, tt_ = uu_ & 255, dsh_ = 2 * br_, d_ = 1 << dsh_, rr_ = tt_ & (d_ - 1), u0_ = 64 * (tt_ >> dsh_);
#pragma unroll
        for (int g = 0; g < 2; ++g) { const int qp_ = rr_ + d_ * (u0_ + 32 * g + r);
#pragma unroll
            for (int k = 0; k < 4; ++k) qn[g][k] = *(const bf16x8*)(Q + (size_t)qp_ * 64 + k * 16 + hh * 8); } };
    if (slot < 768) qload(slot);
    for (int uu = slot; uu < 768; uu += nslots) {
        const int br = uu >> 8, tt = uu & 255, dsh = 2 * br, d = 1 << dsh, rr = tt & (d - 1), u0 = 64 * (tt >> dsh);
        bf16x8 qf[2][4]; int qp[2];
#pragma unroll
        for (int g = 0; g < 2; ++g) { qp[g] = rr + d * (u0 + 32 * g + r);
#pragma unroll
            for (int k = 0; k < 4; ++k) qf[g][k] = qn[g][k]; }
        AttnAcc2 A; attn_init2(A, nB);
        const unsigned sk[2] = {0x20u, 0x01u}, mk[2] = {0x11u, 0x22u};
        const int nst = (u0 >= 128) ? 0 : (128 - u0) >> 5;
        attn_run_fast2<2>(A, qf, K, V, qp, vt, kt, lane, 6, rr + d * (u0 - 128), d, sk, mk, nst);
        if (uu + nslots < 768) qload(uu + nslots);
        asm volatile("" ::: "memory");
#pragma unroll
        for (int g = 0; g < 2; ++g) {
            const float lt = xadd32(A.l[g]);
            if (hh == 0) SL[((size_t)qp[g] * 8 + h) * 3 + br] = lt;
            { int lane2 = lane; asm volatile("" : "+v"(lane2));
              attn_store_rows2(A.o0[g], A.o1[g], 1.0f, ot, mix + (size_t)(rr + d * (u0 + 32 * g)) * MIXW + br * 512 + h * 64, (size_t)d * MIXW, lane2); }
        }
    }
}
__device__ __forceinline__ void swa_merge(unsigned char* ws, int tid, int G) {
    bf16* mix = (bf16*)(ws + WS_MIX); const float* SL = (const float*)(ws + WS_PS) + (size_t)SEQ * 8 * 3;
    for (int idx = bidx() * 512 + tid; idx < SEQ * 64; idx += G * 512) {
        const int q = idx >> 6, h = (idx >> 3) & 7, oc = idx & 7;
        bf16* p = mix + (size_t)q * MIXW + h * 64 + oc * 8;
        float o0[8], o1[8], o2[8]; unpack8(*(const v4u*)p, o0); unpack8(*(const v4u*)(p + 512), o1); unpack8(*(const v4u*)(p + 1024), o2);
        const float* sl = SL + ((size_t)q * 8 + h) * 3; const float inv = 1.0f / (sl[0] + sl[1] + sl[2]);
        float o[8];
#pragma unroll
        for (int i = 0; i < 8; ++i) o[i] = ((o0[i] + o1[i]) + o2[i]) * inv;
        v4u w; w.x = pk2(o[0], o[1]); w.y = pk2(o[2], o[3]); w.z = pk2(o[4], o[5]); w.w = pk2(o[6], o[7]);
        *(v4u*)p = w;
    }
}
__device__ __forceinline__ void top3_insert(float g, int n, float& v0, float& v1, float& v2, int& i0, int& i1, int& i2) {
    const bool c0 = g > v0, c1 = g > v1, c2 = g > v2;
    const float nv2 = c1 ? v1 : (c2 ? g : v2); const int ni2 = c1 ? i1 : (c2 ? n : i2);
    const float nv1 = c0 ? v0 : (c1 ? g : v1); const int ni1 = c0 ? i0 : (c1 ? n : i1);
    v0 = c0 ? g : v0; i0 = c0 ? n : i0; v1 = nv1; i1 = ni1; v2 = nv2; i2 = ni2;
}
__device__ __forceinline__ void gate_group(const LAS bf16* kmL, const bf16* Q, int tq, int qb, int r, int hh, int& o0, int& o1, int& o2) {
    bf16x8 qf[4];
#pragma unroll
    for (int k = 0; k < 4; ++k) qf[k] = *(const bf16x8*)(Q + (size_t)(tq + r) * 64 + k * 16 + hh * 8);
    float v0 = -INFINITY, v1 = -INFINITY, v2 = -INFINITY; int i0 = 0, i1 = 0, i2 = 0;
#pragma unroll
    for (int nt = 0; nt < 2; ++nt) {
        f32x16 X = f32x16{};
#pragma unroll
        for (int k = 0; k < 4; ++k) X = __builtin_amdgcn_mfma_f32_32x32x16_bf16(*(const LAS bf16x8*)(kmL + (nt * 32 + r) * 72 + k * 16 + hh * 8), qf[k], X, 0, 0, 0);
#pragma unroll
        for (int reg = 0; reg < 16; ++reg) { const int n = nt * 32 + (reg & 3) + 8 * (reg >> 2) + 4 * hh; top3_insert((n < qb) ? X[reg] : -INFINITY, n, v0, v1, v2, i0, i1, i2); }
    }
    float pa = v0, pb = v0, qa = v1, qb2 = v1, ra = v2, rb = v2; swap32(pa, pb); swap32(qa, qb2); swap32(ra, rb);
    float ia = __builtin_bit_cast(float, i0), ib = ia, ja = __builtin_bit_cast(float, i1), jb = ja, ka = __builtin_bit_cast(float, i2), kb = ka; swap32(ia, ib); swap32(ja, jb); swap32(ka, kb);
    const float ov0 = hh ? pa : pb, ov1 = hh ? qa : qb2, ov2 = hh ? ra : rb;
    const int oi0 = __builtin_bit_cast(int, hh ? ia : ib), oi1 = __builtin_bit_cast(int, hh ? ja : jb), oi2 = __builtin_bit_cast(int, hh ? ka : kb);
    top3_insert(ov0, oi0, v0, v1, v2, i0, i1, i2); top3_insert(ov1, oi1, v0, v1, v2, i0, i1, i2); top3_insert(ov2, oi2, v0, v1, v2, i0, i1, i2);
    o0 = i0; o1 = i1; o2 = i2;
}
__device__ __forceinline__ void moba_gate(const Args& a, int L, LAS unsigned char* lds, int tid, int G) {
    unsigned char* ws = wsp(a);
    const float* km = (const float*)(ws + WS_KMEAN); unsigned short* list = (unsigned short*)(ws + WS_LIST);
    unsigned* cnt = (unsigned*)(ws + WS_CTL) + CW_CNT + L * 512;
    LAS bf16* kmL = (LAS bf16*)lds;
    const int lane = tid & 63, wave = tid >> 6, r = lane & 31, hh = lane >> 5;
    for (int unit = bidx(); unit < 256; unit += G) {
        const int h = unit & 7, qc = unit >> 3, t0 = 512 * qc + 64 * wave, qb = t0 >> 8;
        __syncthreads();
        for (int i = tid; i < 1024; i += 512) { const f32x4 kv = (*(const f32x4*)(km + h * 4096 + 4 * i) + *(const f32x4*)(km + (8 + h) * 4096 + 4 * i)) * (1.0f / 256.0f);
            const int n = i >> 4, d4 = (i & 15) * 4; typedef unsigned u32x2 __attribute__((ext_vector_type(2)));
            *(LAS u32x2*)(kmL + n * 72 + d4) = (u32x2){pk2(kv.x, kv.y), pk2(kv.z, kv.w)}; }
        __syncthreads();
        const bf16* Q = (const bf16*)(ws + WS_QKV) + (size_t)(3 * 8 + h) * SEQ * 64;
        int a0, a1, a2, b0, b1, b2;
        gate_group(kmL, Q, t0, qb, r, hh, a0, a1, a2);
        gate_group(kmL, Q, t0 + 32, qb, r, hh, b0, b1, b2);
        const int nsel = qb < 3 ? qb : 3;
        LAS unsigned* hist = (LAS unsigned*)(lds + 16384); LAS unsigned* baseL = hist + 64;
        if (tid < 64) hist[tid] = 0u;
        __syncthreads();
        const int t = t0 + 32 * hh + r;
        const int j0 = hh ? b0 : a0, j1 = hh ? b1 : a1, j2 = hh ? b2 : a2;
        unsigned s0 = 0, s1 = 0, s2 = 0;
        if (nsel > 0) s0 = __hip_atomic_fetch_add(hist + j0, 1u, __ATOMIC_RELAXED, __HIP_MEMORY_SCOPE_WORKGROUP);
        if (nsel > 1) s1 = __hip_atomic_fetch_add(hist + j1, 1u, __ATOMIC_RELAXED, __HIP_MEMORY_SCOPE_WORKGROUP);
        if (nsel > 2) s2 = __hip_atomic_fetch_add(hist + j2, 1u, __ATOMIC_RELAXED, __HIP_MEMORY_SCOPE_WORKGROUP);
        __syncthreads();
        if (tid < 64) { const unsigned n = hist[tid]; baseL[tid] = n ? atomicAdd(cnt + h * 64 + tid, n) : 0u; }
        __syncthreads();
        if (nsel > 0) list[(size_t)(h * 64 + j0) * SEQ + baseL[j0] + s0] = (unsigned short)(t | (0 << 14));
        if (nsel > 1) list[(size_t)(h * 64 + j1) * SEQ + baseL[j1] + s1] = (unsigned short)(t | (1 << 14));
        if (nsel > 2) list[(size_t)(h * 64 + j2) * SEQ + baseL[j2] + s2] = (unsigned short)(t | (2 << 14));
    }
}
__device__ __forceinline__ void moba_bucket(const Args& a, int L, LAS unsigned char* lds, int tid, int lane, int wave, int G) {
    unsigned char* ws = wsp(a);
    const float nB = attn_negB(inp(a, I_QNM) + L * HD, inp(a, I_KNM) + L * HD, lane);
    const unsigned* cnt = (const unsigned*)(ws + WS_CTL) + CW_CNT + L * 512; const unsigned short* list = (const unsigned short*)(ws + WS_LIST);
    bf16* PO = (bf16*)(ws + WS_PO); float* PS = (float*)(ws + WS_PS);
    LAS int* pre = (LAS int*)(lds + 104 * 1024);
    LAS int* wsum = pre + 520;
    {
        const int n = (int)((__hip_atomic_load(cnt + tid, __ATOMIC_RELAXED, __HIP_MEMORY_SCOPE_AGENT) + 63u) >> 6);
        int inc = n;
#pragma unroll
        for (int o = 1; o < 64; o <<= 1) { const int t = __builtin_amdgcn_ds_bpermute(((lane - o) & 63) << 2, inc); if (lane >= o) inc += t;     }
        if (lane == 63) wsum[wave] = inc;
        __syncthreads();
        int base = 0;
#pragma unroll
        for (int w8 = 0; w8 < 8; ++w8) base += (w8 < wave) ? wsum[w8] : 0;
        pre[tid] = base + inc - n;
        if (tid == 511) pre[512] = base + inc;
        __syncthreads();
    }
    const int T = pre[512];
    LAS bf16* vt = (LAS bf16*)(lds + wave * 12800); LAS bf16* kt = (LAS bf16*)(lds + wave * 12800 + 4096); LAS bf16* ot = (LAS bf16*)(lds + wave * 12800 + 8192);
    const int r = lane & 31, hh = lane >> 5;
    typedef unsigned u32x2 __attribute__((ext_vector_type(2)));
    for (int ti = (int)bidx() * NWAVES + wave; ti < T; ti += G * NWAVES) {
        int lo = 0, hi = 512;
        while (hi - lo > 1) { const int mid = (lo + hi) >> 1; if (pre[mid] <= ti) lo = mid; else hi = mid; }
        const int bkt = lo, tq = ti - pre[bkt], h = bkt >> 6, j = bkt & 63;
        const int n = (int)__hip_atomic_load(cnt + bkt, __ATOMIC_RELAXED, __HIP_MEMORY_SCOPE_AGENT);
        const bf16* Q = (const bf16*)(ws + WS_QKV) + (size_t)(3 * 8 + h) * SEQ * 64; const bf16* K = (const bf16*)(ws + WS_QKV) + (size_t)(4 * 8 + h) * SEQ * 64;
        const bf16* V = (const bf16*)(ws + WS_QKV) + (size_t)(5 * 8 + h) * SEQ * 64;
        bool okr[2]; size_t slot[2]; bf16x8 qf[2][4];
#pragma unroll
        for (int g = 0; g < 2; ++g) {
            okr[g] = (64 * tq + 32 * g + r) < n;
            const unsigned e = okr[g] ? (unsigned)list[(size_t)bkt * SEQ + 64 * tq + 32 * g + r] : 0u;
            const int t = (int)(e & 16383u), ks = (int)(e >> 14);
            slot[g] = ((size_t)t * 8 + h) * 3 + ks;
#pragma unroll
            for (int k = 0; k < 4; ++k) qf[g][k] = *(const bf16x8*)(Q + (size_t)t * 64 + k * 16 + hh * 8);
        }
        AttnAcc2 A; attn_init2(A, nB);
        const int qpd[2] = {0, 0}; const unsigned sk[2] = {0u, (64 * tq + 32 < n) ? 0u : 0xffu}, mk[2] = {0u, 0u};
        attn_run_fast2<0>(A, qf, K, V, qpd, vt, kt, lane, 8, 256 * j, 1, sk, mk);
#pragma unroll
        for (int g = 0; g < 2; ++g) {
            if (g == 1 && !(64 * tq + 32 < n)) break;
            const float lt = xadd32(A.l[g]), sc = 1.0f / lt;
#pragma unroll
            for (int q = 0; q < 4; ++q) { const int db = 8 * q + 4 * hh;
                    *(LAS u32x2*)(ot + r * 68 + db) = (u32x2){cvtpk(A.o0[g][4 * q] * sc, A.o0[g][4 * q + 1] * sc), cvtpk(A.o0[g][4 * q + 2] * sc, A.o0[g][4 * q + 3] * sc)};
                    *(LAS u32x2*)(ot + r * 68 + 32 + db) = (u32x2){cvtpk(A.o1[g][4 * q] * sc, A.o1[g][4 * q + 1] * sc), cvtpk(A.o1[g][4 * q + 2] * sc, A.o1[g][4 * q + 3] * sc)}; }
            if (okr[g] && hh == 0) PS[slot[g]] = lt;
            LDS_WAIT(); asm volatile("" ::: "memory");
#pragma unroll
            for (int k = 0; k < 4; ++k) { const int id = lane + 64 * k, row = id >> 3, oc = id & 7;
                const unsigned slo = (unsigned)__builtin_amdgcn_ds_bpermute(row << 2, (int)(unsigned)slot[g]), shi = (unsigned)__builtin_amdgcn_ds_bpermute(row << 2, (int)(unsigned)(slot[g] >> 32));
                const unsigned long long srow = ((unsigned long long)shi << 32) | slo;
                const int okrow = __builtin_amdgcn_ds_bpermute(row << 2, (int)okr[g]);
                const u32x2 lo2 = *(const LAS u32x2*)(ot + row * 68 + oc * 8), hi2 = *(const LAS u32x2*)(ot + row * 68 + oc * 8 + 4);
                if (okrow) *(v4u*)(PO + (size_t)srow * 64 + oc * 8) = (v4u){lo2.x, lo2.y, hi2.x, hi2.y}; }
            LDS_WAIT(); asm volatile("" ::: "memory");
        }
    }
}
__device__ __forceinline__ void moba_bucket_wg(const Args& a, int L, LAS unsigned char* lds, int tid, int lane, int wave, int G) {
    unsigned char* ws = wsp(a);
    const float nB = attn_negB(inp(a, I_QNM) + L * HD, inp(a, I_KNM) + L * HD, lane);
    const unsigned* cnt = (const unsigned*)(ws + WS_CTL) + CW_CNT + L * 512; const unsigned short* list = (const unsigned short*)(ws + WS_LIST);
    bf16* PO = (bf16*)(ws + WS_PO); float* PS = (float*)(ws + WS_PS);
    LAS int* pre = (LAS int*)(lds + 104 * 1024);
    LAS int* wsum = pre + 520;
    {
        const int n = (int)((((__hip_atomic_load(cnt + tid, __ATOMIC_RELAXED, __HIP_MEMORY_SCOPE_AGENT) + 63u) >> 6) + 7u) >> 3);
        int inc = n;
#pragma unroll
        for (int o = 1; o < 64; o <<= 1) { const int t = __builtin_amdgcn_ds_bpermute(((lane - o) & 63) << 2, inc); if (lane >= o) inc += t;     }
        if (lane == 63) wsum[wave] = inc;
        __syncthreads();
        int base = 0;
#pragma unroll
        for (int w8 = 0; w8 < 8; ++w8) base += (w8 < wave) ? wsum[w8] : 0;
        pre[tid] = base + inc - n;
        if (tid == 511) pre[512] = base + inc;
        __syncthreads();
    }
    const int T = pre[512];
    LAS bf16* ktS = (LAS bf16*)lds; LAS bf16* vtS = (LAS bf16*)(lds + 32768); LAS bf16* ot = (LAS bf16*)(lds + 65536 + wave * 4608);
    const int r = lane & 31, hh = lane >> 5;
    typedef unsigned u32x2 __attribute__((ext_vector_type(2)));
    const int lrow = tid >> 3, loc = tid & 7, lkey = lrow & 31;
    LAS bf16* kw = ktS + (lrow >> 5) * 2048 + lkey * 64 + ((loc ^ ((lkey >> 1) & 7)) * 8); LAS bf16* vw = vtS + (lrow >> 5) * 2048 + lkey * 64 + ((loc ^ (4 * ((lkey >> 1) & 1))) * 8);
    v4u kr[4], vr[4];
    int it = (int)bidx();
    auto find = [&](int item, int& bkt, int& grp) { int lo = 0, hi = 512; while (hi - lo > 1) { const int mid = (lo + hi) >> 1; if (pre[mid] <= item) lo = mid; else hi = mid; }
        bkt = __builtin_amdgcn_readfirstlane(lo); grp = __builtin_amdgcn_readfirstlane(item - pre[lo]); };
    auto fetch = [&](int bkt) { const int h = bkt >> 6, j = bkt & 63;
        const bf16* Kb = (const bf16*)(ws + WS_QKV) + ((size_t)(4 * 8 + h) * SEQ + 256 * j) * 64 + (size_t)lrow * 64 + loc * 8; const bf16* Vb = Kb + (size_t)8 * SEQ * 64;
#pragma unroll
        for (int i = 0; i < 4; ++i) { kr[i] = *(const v4u*)(Kb + (size_t)i * 64 * 64); vr[i] = *(const v4u*)(Vb + (size_t)i * 64 * 64); } };
    int bkt = 0, grp = 0;
    if (it < T) { find(it, bkt, grp); fetch(bkt); }
    while (it < T) {
        __syncthreads();
#pragma unroll
        for (int i = 0; i < 4; ++i) { *(LAS v4u*)(kw + i * 4096) = kr[i]; *(LAS v4u*)(vw + i * 4096) = vr[i]; }
        __syncthreads();
        const int cb = bkt, cg = grp;
        it += G;
        if (it < T) { find(it, bkt, grp); fetch(bkt); }
        const int h = cb >> 6, tq = 8 * cg + wave;
        const int n = (int)__hip_atomic_load(cnt + cb, __ATOMIC_RELAXED, __HIP_MEMORY_SCOPE_AGENT);
        if (64 * tq < n) {
            const bf16* Q = (const bf16*)(ws + WS_QKV) + (size_t)(3 * 8 + h) * SEQ * 64;
            bool okr[2]; size_t slot[2]; bf16x8 qf[2][4];
#pragma unroll
            for (int g = 0; g < 2; ++g) {
                okr[g] = (64 * tq + 32 * g + r) < n;
                const unsigned e = okr[g] ? (unsigned)list[(size_t)cb * SEQ + 64 * tq + 32 * g + r] : 0u;
                const int t = (int)(e & 16383u), ks = (int)(e >> 14);
                slot[g] = ((size_t)t * 8 + h) * 3 + ks;
#pragma unroll
                for (int k = 0; k < 4; ++k) qf[g][k] = *(const bf16x8*)(Q + (size_t)t * 64 + k * 16 + hh * 8);
            }
            AttnAcc2 A; attn_init2(A, nB);
            const unsigned sk[2] = {0u, (64 * tq + 32 < n) ? 0u : 0xffu};
            attn_run_lds2(A, qf, ktS, vtS, lane, 8, sk);
#pragma unroll
            for (int g = 0; g < 2; ++g) {
                if (g == 1 && !(64 * tq + 32 < n)) break;
                const float lt = xadd32(A.l[g]), sc = 1.0f / lt;
#pragma unroll
                for (int q = 0; q < 4; ++q) { const int db = 8 * q + 4 * hh;
                    *(LAS u32x2*)(ot + r * 68 + db) = (u32x2){cvtpk(A.o0[g][4 * q] * sc, A.o0[g][4 * q + 1] * sc), cvtpk(A.o0[g][4 * q + 2] * sc, A.o0[g][4 * q + 3] * sc)};
                    *(LAS u32x2*)(ot + r * 68 + 32 + db) = (u32x2){cvtpk(A.o1[g][4 * q] * sc, A.o1[g][4 * q + 1] * sc), cvtpk(A.o1[g][4 * q + 2] * sc, A.o1[g][4 * q + 3] * sc)}; }
                if (okr[g] && hh == 0) PS[slot[g]] = lt;
                LDS_WAIT(); asm volatile("" ::: "memory");
                {
                    const int sv = (int)((unsigned)slot[g] | (okr[g] ? 0x80000000u : 0u));
                    int sr[4]; u32x2 lo2[4], hi2[4];
#pragma unroll
                    for (int k = 0; k < 4; ++k) { const int id = lane + 64 * k, row = id >> 3, oc = id & 7;
                        sr[k] = __builtin_amdgcn_ds_bpermute(row << 2, sv);
                        lo2[k] = *(const LAS u32x2*)(ot + row * 68 + oc * 8); hi2[k] = *(const LAS u32x2*)(ot + row * 68 + oc * 8 + 4); }
                    asm volatile("" : "+v"(sr[0]), "+v"(sr[1]), "+v"(sr[2]), "+v"(sr[3]), "+v"(lo2[0]), "+v"(lo2[1]), "+v"(lo2[2]), "+v"(lo2[3]), "+v"(hi2[0]), "+v"(hi2[1]), "+v"(hi2[2]), "+v"(hi2[3]));
#pragma unroll
                    for (int k = 0; k < 4; ++k) { const int oc = (lane + 64 * k) & 7;
                        if (sr[k] < 0) *(v4u*)(PO + (size_t)(sr[k] & 0x7fffffff) * 64 + oc * 8) = (v4u){lo2[k].x, lo2[k].y, hi2[k].x, hi2[k].y}; }
                }
                LDS_WAIT(); asm volatile("" ::: "memory");
            }
        }
    }
}
__device__ __forceinline__ void moba_final(const Args& a, int L, LAS unsigned char* lds, int lane, int wave, int G) {
    unsigned char* ws = wsp(a);
    const float nB = attn_negB(inp(a, I_QNM) + L * HD, inp(a, I_KNM) + L * HD, lane);
    const int h = (int)bidx() & 7, slot0 = ((int)bidx() >> 3) * NWAVES + wave, nslots = (G >> 3) * NWAVES;
    const bf16* Q = (const bf16*)(ws + WS_QKV) + (size_t)(3 * 8 + h) * SEQ * 64; const bf16* K = (const bf16*)(ws + WS_QKV) + (size_t)(4 * 8 + h) * SEQ * 64;
    const bf16* V = (const bf16*)(ws + WS_QKV) + (size_t)(5 * 8 + h) * SEQ * 64;
    const bf16* PO = (const bf16*)(ws + WS_PO); const float* PS = (const float*)(ws + WS_PS);
    bf16* mix = (bf16*)(ws + WS_MIX);
    LAS bf16* vt = (LAS bf16*)(lds + wave * 12800); LAS bf16* kt = (LAS bf16*)(lds + wave * 12800 + 4096); LAS bf16* ot = (LAS bf16*)(lds + wave * 12800 + 8192);
    const int r = lane & 31, hh = lane >> 5;
    typedef unsigned u32x2 __attribute__((ext_vector_type(2)));
    for (int uu = slot0; uu < 256; uu += nslots) {
        const int t0 = 64 * uu, qb = t0 >> 8, nsel = qb < 3 ? qb : 3;
        bf16x8 qf[2][4]; int qp[2];
#pragma unroll
        for (int g = 0; g < 2; ++g) { qp[g] = t0 + 32 * g + r;
#pragma unroll
            for (int k = 0; k < 4; ++k) qf[g][k] = *(const bf16x8*)(Q + (size_t)qp[g] * 64 + k * 16 + hh * 8); }
        AttnAcc2 A; attn_init2(A, nB);
        const int ntile = ((t0 & 255) >> 5) + 2;
        const unsigned sk[2] = {1u << (ntile - 1), 0u}, mk[2] = {1u << (ntile - 2), 1u << (ntile - 1)};
        attn_run_fast2<1>(A, qf, K, V, qp, vt, kt, lane, ntile, 256 * qb, 1, sk, mk);
        v4u pn[4]; float wn = 0.f;
        auto req = [&](int g, int k) {
            wn = PS[((size_t)qp[g] * 8 + h) * 3 + k];
#pragma unroll
            for (int kk2 = 0; kk2 < 4; ++kk2) { const int id = lane + 64 * kk2, row = id >> 3, oc = id & 7;
                pn[kk2] = *(const v4u*)(PO + (((size_t)(t0 + 32 * g + row) * 8 + h) * 3 + k) * 64 + oc * 8); } };
        if (nsel > 0) req(0, 0);
#pragma unroll
        for (int g = 0; g < 2; ++g) {
            float lt = xadd32(A.l[g]);
#pragma unroll
            for (int k = 0; k < 3; ++k) {
                if (k < nsel) {
                    const float wk = wn; lt += wk;
#pragma unroll
                    for (int kk2 = 0; kk2 < 4; ++kk2) { const int id = lane + 64 * kk2, row = id >> 3, oc = id & 7;
                        const v4u p4 = pn[kk2];
                        *(LAS u32x2*)(ot + row * 68 + oc * 8) = (u32x2){p4.x, p4.y}; *(LAS u32x2*)(ot + row * 68 + oc * 8 + 4) = (u32x2){p4.z, p4.w}; }
                    if (k + 1 < nsel) req(g, k + 1); else if (g == 0) req(1, 0);
                    LDS_WAIT(); asm volatile("" ::: "memory");
#pragma unroll
                    for (int q = 0; q < 4; ++q) { const int db = 8 * q + 4 * hh; const u32x2 pa = *(const LAS u32x2*)(ot + r * 68 + db), pb = *(const LAS u32x2*)(ot + r * 68 + 32 + db);
                        A.o0[g][4 * q] += wk * bflo(pa.x); A.o0[g][4 * q + 1] += wk * bfhi(pa.x); A.o0[g][4 * q + 2] += wk * bflo(pa.y); A.o0[g][4 * q + 3] += wk * bfhi(pa.y);
                        A.o1[g][4 * q] += wk * bflo(pb.x); A.o1[g][4 * q + 1] += wk * bfhi(pb.x); A.o1[g][4 * q + 2] += wk * bflo(pb.y); A.o1[g][4 * q + 3] += wk * bfhi(pb.y); }
                    LDS_WAIT(); asm volatile("" ::: "memory");
                }
            }
            attn_store_rows2(A.o0[g], A.o1[g], 1.0f / lt, ot, mix + (size_t)(t0 + 32 * g) * MIXW + 1024 + h * 64, (size_t)MIXW, lane);
        }
    }
}
__device__ __forceinline__ void mixer_phase(const Args& a, int L, LAS unsigned char* lds, int tid, int lane, int wave, int G) {
    if (!FLG(a, 16)) ssd_states(wsp(a), (const unsigned char*)outp(a), lane, (int)bidx() * NWAVES + wave, G * NWAVES);
    if (!FLG(a, 1)) moba_gate(a, L, lds, tid, G);
    __syncthreads();
    if (!FLG(a, 32)) swa_pass(a, L, lds, lane, wave, G);
}

#ifdef TSPROBE
#define TSP_LASTBAR 1
#else
#define TSP_LASTBAR 0
#endif
__global__ void __launch_bounds__(NWAVES * 64, 2) mk_fwd(Args args) {
    extern __shared__ __attribute__((aligned(16))) unsigned char lds_raw[];
    LAS unsigned char* lds_k = (LAS unsigned char*)lds_raw;
    volatile LAS unsigned* MISC = (volatile LAS unsigned*)(lds_k + MISC_OFF);
    const int G_k = gridDim.x, wave0 = __builtin_amdgcn_readfirstlane(threadIdx.x >> 6);
    gu32* ctl = (gu32*)(wsp(args) + WS_CTL);
    for (int u = threadIdx.x; u < (LDS_BYTES - LDSCTL_OFF) / 4; u += NWAVES * 64) ((LAS unsigned*)(lds_k + LDSCTL_OFF))[u] = 0u;
    __syncthreads();
    XcdBarrier bar; bar.bar = (unsigned*)(ctl + CW_BAR); bar.x = 0; bar.st = nullptr; bar.wave = 1;
    const bool fused = (args.ph_hi - args.ph_lo) > 1;
    if (fused) bar = xcd_barrier_post((unsigned*)(ctl + CW_BAR), MISC + 8);
    bar.wave = wave0;
    if (threadIdx.x == 0) MISC[10] = bar.x;
    __syncthreads();
#ifdef TSPROBE
    unsigned long long* tsb = (unsigned long long*)(wsp(args) + WS_CTL + 448 * 1024);
    if (bidx() == 0 && threadIdx.x == 0) tsb[63] = __builtin_amdgcn_s_memrealtime();
#define TSTAMP(i) do { if (bidx() == 0 && wave0 == 0 && (int)__builtin_amdgcn_mbcnt_hi(~0u, __builtin_amdgcn_mbcnt_lo(~0u, opq0())) == 0) tsb[i] = __builtin_amdgcn_s_memrealtime(); } while (0)
#else
#define TSTAMP(i) do {} while (0)
#endif
    int ph0 = args.ph_lo;
    if (ph0 == 0) {
        { int lane = (int)__builtin_amdgcn_mbcnt_hi(~0u, __builtin_amdgcn_mbcnt_lo(~0u, opq0())); asm volatile("" : "+v"(lane)); p0_prologue(args, lds_k, wave0 * 64 + lane, lane, wave0, G_k); }
        if (1 < args.ph_hi) { XcdBarrier b2; b2.bar = (unsigned*)((gu32*)(wsp(args) + WS_CTL) + CW_BAR); b2.wave = wave0; asm volatile("" : "+s"(b2.wave)); b2.x = (unsigned)__builtin_amdgcn_readfirstlane((int)*(volatile LAS unsigned*)(lds_k + MISC_OFF + 40)); { int mo_ = MISC_OFF + 32; asm volatile("" : "+s"(mo_)); b2.st = (volatile LAS unsigned*)(lds_k + mo_); } xcd_barrier(b2); }
        TSTAMP(0);
        ph0 = 1;
    }
    if (ph0 == 1 && ph0 < args.ph_hi) {
        { int lane = (int)__builtin_amdgcn_mbcnt_hi(~0u, __builtin_amdgcn_mbcnt_lo(~0u, opq0())); asm volatile("" : "+v"(lane)); p0_weights(args, lds_k, lane, wave0, G_k); }
        if (2 < args.ph_hi) { XcdBarrier b2; b2.bar = (unsigned*)((gu32*)(wsp(args) + WS_CTL) + CW_BAR); b2.wave = wave0; asm volatile("" : "+s"(b2.wave)); b2.x = (unsigned)__builtin_amdgcn_readfirstlane((int)*(volatile LAS unsigned*)(lds_k + MISC_OFF + 40)); { int mo_ = MISC_OFF + 32; asm volatile("" : "+s"(mo_)); b2.st = (volatile LAS unsigned*)(lds_k + mo_); } xcd_barrier(b2); }
        TSTAMP(1);
        ph0 = 2;
    }
#define PHW() ({ int w_ = wave0; asm volatile("" : "+s"(w_)); (volatile LAS int*)(lds_k + MISC_OFF + 64) + w_; })
    *PHW() = ph0;
    for (;;) {
        const int ph = __builtin_amdgcn_readfirstlane(*PHW());
        if (ph >= args.ph_hi || FLG(args, 2)) break;
        LAS unsigned char* lds = lds_k; int G = G_k; asm volatile("" : "+s"(lds), "+s"(G));
        unsigned char* ws = wsp(args);
        bf16* hb = (bf16*)(ws + WS_H);
#define LANE_TID() int lane = (int)__builtin_amdgcn_mbcnt_hi(~0u, __builtin_amdgcn_mbcnt_lo(~0u, opq0())); asm volatile("" : "+v"(lane)); int wave_ = wave0; asm volatile("" : "+s"(wave_)); const int wave = wave_, tid = wave * 64 + lane; (void)tid
#define MD() ((const float*)(wsp(args) + WS_MOD) + L * 6144)
#define CTLF() ((float*)(wsp(args) + WS_CTL))
        {
            const int L = (ph - PH0) / PH_PER_LAYER, k = (ph - PH0) % PH_PER_LAYER;
            if (k == 0) {
                pg8::Gemm g{hb, (const bf16*)(ws + WS_WIN) + (size_t)L * INP_PAD * DM, SEQ, INP_PAD, DM}; pg8::StaticOrder S; S.init(SEQ, INP_PAD, G, (int)bidx());
                LANE_TID(); pg8::EpiIn E{args, L};
                pg8::gemm_phase<pg8::EpiIn, pg8::StaticOrder, true, true, DM>(lds, g, S, E, wave);
            }
            else if (k == 1) { LANE_TID(); prep_phase(args, L, lds, tid, G); }
            else if (k == 2) { LANE_TID(); mixer_phase(args, L, lds, tid, lane, wave, G); }
            else if (k == 3) { LANE_TID(); if (!FLG(args, 1)) ssd_scan(ws, (unsigned char*)outp(args), lds, tid, G); swa_merge(ws, tid, G); moba_bucket_wg(args, L, lds, tid, lane, wave, G); }
            else if (k == 4) { LANE_TID(); if (!FLG(args, 4)) ssd_out(args, L, lds, lane, wave, G); __syncthreads(); if (!FLG(args, 8)) moba_final(args, L, lds, lane, wave, G); }
            else if (k == 5) {
                pg8::Gemm g{(const bf16*)(ws + WS_MIX), (const bf16*)(ws + WS_WOUT) + (size_t)L * DM * MIXW, SEQ, DM, MIXW}; pg8::StaticOrder S; S.init(SEQ, DM, G, (int)bidx());
                LANE_TID(); pg8::EpiRes E{nullptr, MD() + 2048, hb, CTLF() + CW_RSS + (L * 2 + 1) * SEQ};
                pg8::gemm_phase<pg8::EpiRes, pg8::StaticOrder, true, true, MIXW>(lds, g, S, E, wave);
            }
            else if (k == 6) {
                pg8::Gemm g{hb, (const bf16*)(ws + WS_WGU) + (size_t)L * GU * DM, SEQ, GU, DM}; pg8::StaticOrder S; S.init(SEQ, GU, G, (int)bidx());
                LANE_TID(); pg8::EpiSwiglu E{(bf16*)(ws + WS_HID), CTLF() + CW_RSS + (L * 2 + 1) * SEQ, CTLF() + CW_BIAS_GU + L * GU};
                pg8::gemm_phase<pg8::EpiSwiglu, pg8::StaticOrder, true, true, DM>(lds, g, S, E, wave);
            }
            else {
                pg8::Gemm g{(const bf16*)(ws + WS_HID), (const bf16*)(ws + WS_WDN) + (size_t)L * DM * FFN, SEQ, DM, FFN}; pg8::StaticOrder S; S.init(SEQ, DM, G, (int)bidx());
                LANE_TID(); pg8::EpiRes E{(L == DEPTH - 1) ? outp(args) : nullptr, MD() + 5120, hb, (L < DEPTH - 1) ? CTLF() + CW_RSS + ((L + 1) * 2 + 0) * SEQ : nullptr};
                pg8::gemm_phase<pg8::EpiRes, pg8::StaticOrder, true, true, FFN>(lds, g, S, E, wave);
            }
        }
        const int ph2 = __builtin_amdgcn_readfirstlane(*PHW()); *PHW() = ph2 + 1;
        if (ph2 + 1 < args.ph_hi || TSP_LASTBAR) { XcdBarrier b2; b2.bar = (unsigned*)((gu32*)(wsp(args) + WS_CTL) + CW_BAR); b2.wave = wave0; asm volatile("" : "+s"(b2.wave)); b2.x = (unsigned)__builtin_amdgcn_readfirstlane((int)*(volatile LAS unsigned*)(lds_k + MISC_OFF + 40)); { int mo_ = MISC_OFF + 32; asm volatile("" : "+s"(mo_)); b2.st = (volatile LAS unsigned*)(lds_k + mo_); } xcd_barrier(b2); }
        TSTAMP(ph2);
    }
}

#ifdef TSPROBE
__global__ void tsp_emit(Args args) {
    const unsigned long long* tsb = (const unsigned long long*)((const unsigned char*)args.p[N_IN + 1] + WS_CTL + 448 * 1024);
    float T1 = 0.f, T2 = 0.f;
    for (int L = 0; L < DEPTH; ++L) {
        if (TSP_K1 < PH_PER_LAYER) { const int p = PH0 + L * PH_PER_LAYER + TSP_K1; T1 += (float)(tsb[p] - tsb[p - 1]) * 0.01f; }
        if (TSP_K2 < PH_PER_LAYER) { const int p = PH0 + L * PH_PER_LAYER + TSP_K2; T2 += (float)(tsb[p] - tsb[p - 1]) * 0.01f; }
    }
    if (TSP_K1 == 10) T1 = (float)(tsb[1] - tsb[63]) * 0.01f;
    if (TSP_K2 == 10) T2 = (float)(tsb[1] - tsb[63]) * 0.01f;
    if (TSP_K1 == 11) T1 = 100.f;
    if (TSP_K2 == 11) T2 = 100.f;
    float* o = (float*)args.p[N_IN];
    const int gt = bidx() * blockDim.x + threadIdx.x;
    if (gt == 0) o[0] += T1 * 0.005f;
    for (int i = 1 + gt; i <= 262144; i += gridDim.x * blockDim.x) o[64 * i - 1] += floorf(T2 * 0.125f + 0.5f) * 8.0f * TSP_SCALE;
}
#endif
extern "C" void kernel_launch(void* const* d_in, const int* in_sizes, int n_in, void* d_out, int out_size, void* d_ws, size_t ws_size, hipStream_t stream) {
    static int grid = 0;
    if (grid == 0) {
        if (n_in != N_IN || in_sizes[0] != SEQ * DM || out_size != SEQ * DM || ws_size < WS_END) { fprintf(stderr, "kernel_launch: unexpected shapes (n_in %d, in0 %d, out %d, ws %zu < %zu)\n", n_in, n_in > 0 ? in_sizes[0] : -1, out_size, ws_size, (size_t)WS_END); grid = -1; return; }
        int dev = 0, cus = 0, per_cu = 0;
        if (hipGetDevice(&dev) != hipSuccess || hipDeviceGetAttribute(&cus, hipDeviceAttributeMultiprocessorCount, dev) != hipSuccess) { grid = -1; return; }
        if (hipFuncSetAttribute((const void*)mk_fwd, hipFuncAttributeMaxDynamicSharedMemorySize, LDS_BYTES) != hipSuccess) { fprintf(stderr, "kernel_launch: hipFuncSetAttribute failed\n"); grid = -1; return; }
        if (hipOccupancyMaxActiveBlocksPerMultiprocessor(&per_cu, (const void*)mk_fwd, NWAVES * 64, LDS_BYTES) != hipSuccess || per_cu < 1) { fprintf(stderr, "kernel_launch: occupancy query says %d\n", per_cu); per_cu = 1; }
        (void)hipGetLastError();
        grid = cus;
        if (grid != 256) { fprintf(stderr, "kernel_launch: expected 256 CUs, got %d\n", grid); if (grid > 256) grid = 256; if (grid < 64 || (grid & 7)) { grid = -1; return; } }
    }
    if (grid < 0) return;
    if (hipMemsetAsync((char*)d_ws + WS_CTL, 0, CTL_ZERO_BYTES, stream) != hipSuccess) return;
    Args a{};
    for (int i = 0; i < N_IN; ++i) a.p[i] = d_in[i];
    a.p[N_IN] = d_out; a.p[N_IN + 1] = d_ws; a.p[N_IN + 2] = nullptr;
#if MK_ONE_LAUNCH
    a.ph_lo = 0; a.ph_hi = N_PHASES;
    hipLaunchKernelGGL(mk_fwd, dim3(grid), dim3(NWAVES * 64), LDS_BYTES, stream, a);
#ifdef TSPROBE
    hipLaunchKernelGGL(tsp_emit, dim3(64), dim3(256), 0, stream, a);
#endif
#else
    for (int ph = 0; ph < N_PHASES; ++ph) { a.ph_lo = ph; a.ph_hi = ph + 1;
#ifdef PROBE_K
        if ((ph >= PH0 && (ph - PH0) % PH_PER_LAYER == PROBE_K) || (ph < PH0 && PROBE_K == 100)) { a.flags = PROBE_FLAGS; for (int rep = 0; rep < PROBE_N; ++rep) hipLaunchKernelGGL(mk_fwd, dim3(grid), dim3(NWAVES * 64), LDS_BYTES, stream, a); }
#endif
        a.flags = 0; hipLaunchKernelGGL(mk_fwd, dim3(grid), dim3(NWAVES * 64), LDS_BYTES, stream, a);
    }
#endif
}
```

```cpp
#include <hip/hip_runtime.h>
#include <cstdio>
#include <cstdint>
#define MK_ONE_LAUNCH 1
__device__ __forceinline__ unsigned opq0() { unsigned z = 0u; asm volatile("" : "+s"(z)); return z; }
namespace pg8 {
#define PG8_LAS __attribute__((address_space(3)))
typedef unsigned short bf16_t;
typedef short bf16x8 __attribute__((ext_vector_type(8)));
typedef float f32x4 __attribute__((ext_vector_type(4)));
typedef unsigned u32x4 __attribute__((ext_vector_type(4)));
constexpr int BM = 256, BK = 64, HALF = 128, HTB = HALF * BK * 2  , STAGE_BYTES = 8 * HTB, NXCD = 8, WGM = 8;

__host__ __device__ __forceinline__ int lds_byte(int r, int c) { const int st = (r >> 4) * 2 + (c >> 5), rr = r & 15, cc = c & 31, ob = rr * 64 + cc * 2; return st * 1024 + (ob ^ (((ob >> 9) & 1) << 5)); }
__host__ __device__ __forceinline__ void stage_rc(int b, int& R, int& C) { const int st = b / 1024, sb = b % 1024, swz = sb ^ (((sb >> 9) & 1) << 5); R = (st >> 1) * 16 + swz / 64; C = (st & 1) * 32 + (swz % 64) / 2; }
__host__ __device__ __forceinline__ int perm32(int rho) { const int n = rho >> 4, i = rho & 15; return 8 * (i >> 2) + 4 * n + (i & 3); }

struct Unit { int pm, pn; };
struct Gemm { const bf16_t* A; const bf16_t* Bt; int M, N, K; };

struct StaticOrder {
    int nM, nN, nwg, G, c;
    __host__ __device__ void init(int M, int N, int G_, int c_) { nM = M / BM; nN = N / BM; nwg = nM * nN; G = G_; c = c_; }
    __host__ __device__ bool next(int i, Unit& u) const {
        const long L = (long)i * G + c; if (L >= nwg) return false;
        int wgid = (int)L; { const int q = nwg / NXCD, r = nwg % NXCD, xcd = wgid % NXCD, off = wgid / NXCD; wgid = (xcd < r ? xcd * (q + 1) : r * (q + 1) + (xcd - r) * q) + off; }
        const int nig = WGM * nN, gid = wgid / nig, fm = gid * WGM, gsz = (nM - fm) < WGM ? (nM - fm) : WGM;
        u.pm = fm + ((wgid % nig) % gsz); u.pn = (wgid % nig) / gsz; return true;
    }
    __device__ __forceinline__ void a_ready(const Unit&) const {}
    __device__ __forceinline__ void done(const Unit&) const {}
};

__device__ __forceinline__ unsigned cvt_pk_bf16(float lo, float hi) { unsigned r; asm volatile("v_cvt_pk_bf16_f32 %0, %1, %2" : "=v"(r) : "v"(lo), "v"(hi)); return r; }
typedef float f32x2 __attribute__((ext_vector_type(2)));
template <class Epi, class Sched, bool ALIGN_EPI = false, bool SP2 = false, int KC = 0>
__device__ __forceinline__ void gemm_phase(PG8_LAS unsigned char* lds, const Gemm g, const Sched& S, const Epi& E, const int tid_in) {
    int lane_ = (int)__builtin_amdgcn_mbcnt_hi(~0u, __builtin_amdgcn_mbcnt_lo(~0u, opq0())); asm volatile("" : "+v"(lane_));
    const int wid = tid_in, lane = lane_, tid = wid * 64 + lane, wr = wid >> 2, wc = wid & 3;
#define PG8_FRFQ() int l2_ = (int)__builtin_amdgcn_mbcnt_hi(~0u, __builtin_amdgcn_mbcnt_lo(~0u, opq0())); asm volatile("" : "+v"(l2_)); const int fr = l2_ & 15, fq = l2_ >> 4
    const int fr0_ = lane & 15, fq0_ = lane >> 4;
    const int K = KC ? KC : g.K, nt = K / BK;
    unsigned voffA[2], voffB[2];
#pragma unroll
    for (int i = 0; i < 2; ++i) { int R, C; stage_rc(tid * 16 + i * 8192, R, C); const int Rb = Epi::PERM ? ((R & ~31) + perm32(R & 31)) : R;
        voffA[i] = (unsigned)(R * K + C) * 2u; voffB[i] = (unsigned)(Rb * K + C) * 2u; }
    const size_t kstep = (size_t)(BK * 2);
    const size_t hstep = (size_t)HALF * K * 2;
    const size_t tstep = 2 * hstep;
    const unsigned ldsw = (unsigned)wid * 1024u;
    const int aoff = lds_byte(wr * 64 + fr0_, fq0_ * 8), boff = lds_byte(wc * 32 + fr0_, fq0_ * 8);
#define PG8_SA(b, h) (((b) * 2 + (h)) * HTB)
#define PG8_SB(b, h) ((4 + (b) * 2 + (h)) * HTB)
#define PG8_STAGE(bufoff, gbase, voff) do { _Pragma("unroll") for (int _i = 0; _i < 2; ++_i) \
        __builtin_amdgcn_global_load_lds((const unsigned*)((const char*)(gbase) + (voff)[_i]), (PG8_LAS unsigned*)(lds + (bufoff) + ldsw + _i * 8192), 16, 0, 0); } while (0)
#define PG8_LDA(dst, b, h) do { _Pragma("unroll") for (int m = 0; m < 4; ++m) _Pragma("unroll") for (int k = 0; k < 2; ++k) dst[m][k] = *(const PG8_LAS bf16x8*)(lds + PG8_SA(b, h) + aoff + m * 2048 + k * 1024); } while (0)
#define PG8_LDB(dst, b, h) do { _Pragma("unroll") for (int n = 0; n < 2; ++n) _Pragma("unroll") for (int k = 0; k < 2; ++k) dst[n][k] = *(const PG8_LAS bf16x8*)(lds + PG8_SB(b, h) + boff + n * 2048 + k * 1024); } while (0)
#define PG8_MMA(ai, bj, At, Bt) do { __builtin_amdgcn_s_setprio(1); _Pragma("unroll") for (int m = 0; m < 4; ++m) _Pragma("unroll") for (int n = 0; n < 2; ++n) _Pragma("unroll") for (int k = 0; k < 2; ++k) \
        acc[ai][bj][m][n] = __builtin_amdgcn_mfma_f32_16x16x32_bf16(Bt[n][k], At[m][k], acc[ai][bj][m][n], 0, 0, 0); __builtin_amdgcn_s_setprio(0); } while (0)
#define PG8_WAIT_V(n) asm volatile("s_waitcnt vmcnt(" #n ")" ::: "memory")
#define PG8_WAIT_L(n) asm volatile("s_waitcnt lgkmcnt(" #n ")" ::: "memory")
#define PG8_BAR __builtin_amdgcn_s_barrier()
#define PG8_SCHED __builtin_amdgcn_sched_barrier(0)
    Unit cur, nxt; int ui = 0;
    if (!S.next(0, cur)) return;
    f32x4 acc[2][2][4][2];
#pragma unroll
    for (int a = 0; a < 2; ++a)
#pragma unroll
        for (int b = 0; b < 2; ++b)
#pragma unroll
            for (int m = 0; m < 4; ++m)
#pragma unroll
                for (int n = 0; n < 2; ++n) acc[a][b][m][n] = (f32x4){0.f, 0.f, 0.f, 0.f};
    bf16x8 At[4][2], B0[2][2], B1[2][2];
    const char* cA = (const char*)g.A + (size_t)cur.pm * tstep; const char* cB = (const char*)g.Bt + (size_t)cur.pn * tstep;
    S.a_ready(cur);
    if constexpr (SP2) {
        PG8_STAGE(PG8_SB(0, 0), cB, voffB); PG8_STAGE(PG8_SB(0, 1), cB + hstep, voffB); PG8_STAGE(PG8_SA(0, 0), cA, voffA); PG8_STAGE(PG8_SA(0, 1), cA + hstep, voffA);
        if (wr == 1) PG8_BAR;
        PG8_WAIT_V(2); PG8_BAR;
        PG8_STAGE(PG8_SB(1, 0), cB + kstep, voffB); PG8_STAGE(PG8_SA(1, 0), cA + kstep, voffA); PG8_STAGE(PG8_SB(1, 1), cB + hstep + kstep, voffB);
        PG8_WAIT_V(6); PG8_BAR;
    } else {
        PG8_STAGE(PG8_SB(0, 0), cB, voffB); PG8_STAGE(PG8_SA(0, 0), cA, voffA); PG8_STAGE(PG8_SB(0, 1), cB + hstep, voffB); PG8_STAGE(PG8_SA(0, 1), cA + hstep, voffA);
        if (wr == 1) PG8_BAR;
        PG8_WAIT_V(4); PG8_BAR;
        PG8_STAGE(PG8_SB(1, 0), cB + kstep, voffB); PG8_STAGE(PG8_SA(1, 0), cA + kstep, voffA); PG8_STAGE(PG8_SB(1, 1), cB + hstep + kstep, voffB);
        PG8_WAIT_V(6); PG8_BAR;
    }
    for (;;) {
        const bool has_next = S.next(ui + 1, nxt);
        const char* nA = has_next ? (const char*)g.A + (size_t)nxt.pm * tstep : cA; const char* nB = has_next ? (const char*)g.Bt + (size_t)nxt.pn * tstep : cB;
        for (int t = 0; t < nt; t += 2) {
            const bool last = (t == nt - 2);
            const char* a1 = cA + (size_t)(t + 1) * kstep;
            const char* a2 = last ? nA : cA + (size_t)(t + 2) * kstep; const char* b2 = last ? nB : cB + (size_t)(t + 2) * kstep;
            const char* a3 = a2 + kstep; const char* b3 = b2 + kstep;
            if (last && has_next) S.a_ready(nxt);
            if constexpr (SP2) {
            PG8_LDB(B0, 0, 0); PG8_LDB(B1, 0, 1); PG8_SCHED; PG8_LDA(At, 0, 0); PG8_STAGE(PG8_SA(1, 1), a1 + hstep, voffA);
            PG8_WAIT_V(8); PG8_WAIT_L(0); PG8_BAR; PG8_MMA(0, 0, At, B0); PG8_MMA(0, 1, At, B1); PG8_BAR; PG8_SCHED;
            PG8_LDA(At, 0, 1); PG8_STAGE(PG8_SB(0, 0), b2, voffB); PG8_STAGE(PG8_SB(0, 1), b2 + hstep, voffB); PG8_STAGE(PG8_SA(0, 0), a2, voffA);
            PG8_WAIT_V(8); PG8_WAIT_L(0); PG8_BAR; PG8_MMA(1, 0, At, B0); PG8_MMA(1, 1, At, B1); PG8_BAR; PG8_SCHED;
            PG8_LDB(B0, 1, 0); PG8_LDB(B1, 1, 1); PG8_SCHED; PG8_LDA(At, 1, 0); PG8_STAGE(PG8_SA(0, 1), a2 + hstep, voffA);
            PG8_WAIT_V(8); PG8_WAIT_L(0); PG8_BAR; PG8_MMA(0, 0, At, B0); PG8_MMA(0, 1, At, B1); PG8_BAR; PG8_SCHED;
            PG8_LDA(At, 1, 1); PG8_STAGE(PG8_SB(1, 0), b3, voffB); PG8_STAGE(PG8_SB(1, 1), b3 + hstep, voffB); PG8_STAGE(PG8_SA(1, 0), a3, voffA);
            PG8_WAIT_V(8); PG8_WAIT_L(0); PG8_BAR; PG8_MMA(1, 0, At, B0); PG8_MMA(1, 1, At, B1); PG8_BAR; PG8_SCHED;
            } else {
            PG8_LDB(B0, 0, 0); PG8_SCHED; PG8_LDA(At, 0, 0); PG8_STAGE(PG8_SA(1, 1), a1 + hstep, voffA);
            PG8_WAIT_L(8); PG8_BAR; PG8_WAIT_L(0); PG8_MMA(0, 0, At, B0); PG8_BAR; PG8_SCHED;
            PG8_LDB(B1, 0, 1); PG8_STAGE(PG8_SB(0, 0), b2, voffB);
            PG8_BAR; PG8_WAIT_L(0); PG8_MMA(0, 1, At, B1); PG8_BAR;
            PG8_LDA(At, 0, 1); PG8_STAGE(PG8_SA(0, 0), a2, voffA);
            PG8_BAR; PG8_WAIT_L(0); PG8_MMA(1, 0, At, B0); PG8_BAR; PG8_SCHED;
            PG8_STAGE(PG8_SB(0, 1), b2 + hstep, voffB);
            PG8_WAIT_V(6); PG8_BAR; PG8_MMA(1, 1, At, B1); PG8_BAR;
            PG8_LDB(B0, 1, 0); PG8_SCHED; PG8_LDA(At, 1, 0); PG8_STAGE(PG8_SA(0, 1), a2 + hstep, voffA);
            PG8_WAIT_L(8); PG8_BAR; PG8_WAIT_L(0); PG8_MMA(0, 0, At, B0); PG8_BAR; PG8_SCHED;
            PG8_LDB(B1, 1, 1); PG8_STAGE(PG8_SB(1, 0), b3, voffB);
            PG8_BAR; PG8_WAIT_L(0); PG8_MMA(0, 1, At, B1); PG8_BAR;
            PG8_LDA(At, 1, 1); PG8_STAGE(PG8_SA(1, 0), a3, voffA);
            PG8_BAR; PG8_WAIT_L(0); PG8_MMA(1, 0, At, B0); PG8_BAR; PG8_SCHED;
            PG8_STAGE(PG8_SB(1, 1), b3 + hstep, voffB);
            PG8_WAIT_V(6); PG8_BAR; PG8_MMA(1, 1, At, B1); PG8_BAR;
            }
        }
        if constexpr (ALIGN_EPI) { if (wr == 0) PG8_BAR; }
        if constexpr (!Epi::AFTER_DRAIN) { PG8_FRFQ(); E(acc, cur, wr, wc, fr, fq); S.done(cur); }
        if (!has_next) break;
#pragma unroll
        for (int a = 0; a < 2; ++a)
#pragma unroll
            for (int b = 0; b < 2; ++b)
#pragma unroll
                for (int m = 0; m < 4; ++m)
#pragma unroll
                    for (int n = 0; n < 2; ++n) acc[a][b][m][n] = (f32x4){0.f, 0.f, 0.f, 0.f};
        cur = nxt; cA = nA; cB = nB; ++ui;
        if constexpr (ALIGN_EPI) { if (wr == 1) PG8_BAR; }
    }
    PG8_WAIT_V(0);
    if constexpr (!ALIGN_EPI) { if (wr == 0) PG8_BAR; }
    PG8_BAR;
    if constexpr (Epi::AFTER_DRAIN) { PG8_FRFQ(); E.fused(acc, cur, wr, wc, fr, fq, lds, wid, lane); S.done(cur); }
#undef PG8_SA
#undef PG8_SB
#undef PG8_STAGE
#undef PG8_LDA
#undef PG8_LDB
#undef PG8_MMA
#undef PG8_WAIT_V
#undef PG8_WAIT_L
#undef PG8_BAR
#undef PG8_SCHED
}
}
#define GAS __attribute__((address_space(1)))
#define LAS __attribute__((address_space(3)))
typedef unsigned short bf16;
typedef unsigned v4u __attribute__((ext_vector_type(4)));
typedef float f32x4 __attribute__((ext_vector_type(4)));
typedef short bf16x8 __attribute__((ext_vector_type(8)));
typedef GAS unsigned gu32;
typedef GAS unsigned long long gu64;
#define RLX_AGENT __ATOMIC_RELAXED, __HIP_MEMORY_SCOPE_AGENT
#define LDS_WAIT() asm volatile("s_waitcnt lgkmcnt(0)" ::: "memory")
#define VM_WAIT() asm volatile("s_waitcnt vmcnt(0)" ::: "memory")
__device__ __forceinline__ unsigned long long rt() { return __builtin_amdgcn_s_memrealtime(); }
__device__ __forceinline__ unsigned f2bf(float f) { unsigned u = __builtin_bit_cast(unsigned, f); return (u + 0x7fffu + ((u >> 16) & 1u)) >> 16; }
__device__ __forceinline__ unsigned pk2(float lo, float hi) { unsigned r; asm volatile("v_cvt_pk_bf16_f32 %0, %1, %2" : "=v"(r) : "v"(lo), "v"(hi)); return r; }
#define XB_TMO      128
#define XB_XCNT(j)  (256  + 64 * (j))
#define XB_XSUB(j)  (1280 + 64 * (j))
#define XB_XGEN(j)  (2304 + 64 * (j))
#define XB_TOP      3328
#define XB_TOPGEN   3392
#define XCD_BAR_WORDS 3456
#define XB_SPIN_CAP (1u << 18)

__device__ __forceinline__ unsigned xb_ld(unsigned* p)              { return __hip_atomic_load(p, __ATOMIC_RELAXED, __HIP_MEMORY_SCOPE_AGENT); }
__device__ __forceinline__ unsigned xb_add(unsigned* p, unsigned v) { return __hip_atomic_fetch_add(p, v, __ATOMIC_RELAXED, __HIP_MEMORY_SCOPE_AGENT); }
__device__ __forceinline__ unsigned xb_xcc_id() { return (unsigned)__builtin_amdgcn_s_getreg((3 << 11) | 20) & 0xFu; }
#define XB_SPIN(cond, bar) do { unsigned _sp = 0; while (cond) { __builtin_amdgcn_s_sleep(1); \
    if ((++_sp & 255u) == 0u) { if (xb_ld(&(bar)[XB_TMO])) break; if (_sp > XB_SPIN_CAP) { atomicAdd(&(bar)[XB_TMO], 1u); break; } } } } while (0)

struct XcdBarrier {
    unsigned* bar; unsigned x; int wave;
    volatile LAS unsigned* st;
};

__device__ __forceinline__ XcdBarrier xcd_barrier_post(unsigned* bar, volatile LAS unsigned* st) {
    XcdBarrier b; b.bar = bar; b.x = xb_xcc_id(); b.st = st; b.wave = 1;
    if (threadIdx.x == 0) (void)xb_add(&bar[XB_XCNT(b.x)], 1u);
    return b;
}
__device__ __forceinline__ void xcd_barrier_complete(unsigned* bar, unsigned x, unsigned& nloc, unsigned& nx) {
    const unsigned G = gridDim.x * gridDim.y * gridDim.z;
    unsigned sum, cnt, mine, sp = 0u;
    for (;;) {
        sum = 0u; cnt = 0u; mine = 0u;
#pragma unroll
        for (unsigned j = 0; j < 16; ++j) { const unsigned c = xb_ld(&bar[XB_XCNT(j)]); sum += c; cnt += (c > 0u) ? 1u : 0u; mine = (j == x) ? c : mine; }
        if (sum == G) break;
        __builtin_amdgcn_s_sleep(1);
        if ((++sp & 255u) == 0u) { if (xb_ld(&bar[XB_TMO])) break; if (sp > XB_SPIN_CAP) { atomicAdd(&bar[XB_TMO], 1u); break; } }
    }
    nloc = mine > 0u ? mine : 1u; nx = cnt > 0u ? cnt : 1u;
}

__device__ __forceinline__ void xcd_barrier(const XcdBarrier& b) {
    asm volatile("s_waitcnt vmcnt(0)" ::: "memory");
    __syncthreads();
    if (b.wave == 0 && (int)__builtin_amdgcn_mbcnt_hi(~0u, __builtin_amdgcn_mbcnt_lo(~0u, opq0())) == 0) {
        unsigned* bar = b.bar;
        __builtin_amdgcn_s_waitcnt(0);
        unsigned nloc = b.st[0], nx = b.st[1];
        if (nloc == 0u) { xcd_barrier_complete(bar, b.x, nloc, nx); b.st[0] = nloc; b.st[1] = nx; }
        const unsigned old = xb_add(&bar[XB_XSUB(b.x)], 1u);
        const unsigned gen = old / nloc;
        if (old + 1u == (gen + 1u) * nloc) {
            __builtin_amdgcn_fence(__ATOMIC_RELEASE, "agent");
            asm volatile("s_waitcnt vmcnt(0)" ::: "memory");
            const unsigned og = xb_add(&bar[XB_TOP], 1u);
            const unsigned tg = og / nx;
            if (og + 1u == (tg + 1u) * nx) xb_add(&bar[XB_TOPGEN], 1u);
            else XB_SPIN(xb_ld(&bar[XB_TOPGEN]) == tg, bar);
            __builtin_amdgcn_fence(__ATOMIC_ACQUIRE, "agent");
            xb_add(&bar[XB_XGEN(b.x)], 1u);
            asm volatile("s_waitcnt vmcnt(0)" ::: "memory");
        } else {
            XB_SPIN(xb_ld(&bar[XB_XGEN(b.x)]) == gen, bar);
            __builtin_amdgcn_fence(__ATOMIC_ACQUIRE, "agent");
            asm volatile("s_waitcnt vmcnt(0)" ::: "memory");
        }
    }
    __syncthreads();
}
#ifndef QKFUSE
#define QKFUSE 1
#endif
#ifdef PROBE_K
#define FLG(a_, m_) ((a_).flags & (m_))
#else
#define FLG(a_, m_) 0
#endif

constexpr int SEQ = 16384, DM = 1024, DEPTH = 4, NH = 8, HD = 64;
constexpr int INP = 4616, INP_PAD = 4864, MIXW = 1536, FFN = 2816, GU = 2 * FFN;
constexpr int NWAVES = 8;
constexpr float EPS = 1e-6f;
constexpr float C2 = 0.125f * 1.4426950408889634f;
constexpr int PH_PER_LAYER = 8, PH0 = 2, N_PHASES = PH0 + DEPTH * PH_PER_LAYER;
#ifndef MK_ONE_LAUNCH
#define MK_ONE_LAUNCH 1
#endif
enum { I_X = 0, I_C, I_ADAW, I_ADAB, I_NMIX, I_WIN, I_QNS, I_KNS, I_QNM, I_KNM, I_CONVW, I_CONVB, I_DTB, I_ALOG, I_DSKIP, I_SNORM, I_WOUT, I_NFFN, I_WG, I_WU, I_WD, N_IN };
constexpr size_t MiB = 1u << 20;
constexpr size_t WS_CTL = 0, CTL_ZERO_BYTES = 1 * MiB;
constexpr size_t WS_MOD = 1 * MiB;
constexpr size_t WS_GAINS = 1 * MiB + 128 * 1024;
constexpr size_t WS_ROPE = 2 * MiB;
constexpr size_t WS_KMEAN = 3 * MiB;
constexpr size_t WS_DT = 3 * MiB + 512 * 1024;
constexpr size_t WS_WIN = 4 * MiB;
constexpr size_t WS_WOUT = 42 * MiB;
constexpr size_t WS_WGU = 54 * MiB;
constexpr size_t WS_WDN = 98 * MiB;
constexpr size_t WS_H = 120 * MiB;
constexpr size_t WS_QKV = 152 * MiB;
constexpr size_t WS_HID = WS_QKV;
constexpr size_t WS_Z = 248 * MiB;
constexpr size_t WS_XBC = 264 * MiB;
constexpr size_t WS_Y = WS_XBC;
constexpr size_t WS_XC = 296 * MiB;
constexpr size_t WS_MIX = 328 * MiB;
constexpr size_t XT_XDTT = 0, XT_XWT = 16 * MiB, XT_STB = 32 * MiB;
constexpr size_t WS_ST = WS_XBC;
constexpr size_t WS_BT = 376 * MiB;
constexpr size_t WS_CS = 384 * MiB;
constexpr size_t WS_LIST = WS_XBC + 16 * MiB;
constexpr size_t WS_PO = WS_QKV;
constexpr size_t WS_PS = 385 * MiB;
constexpr size_t WS_END = 388 * MiB;
constexpr int CW_CNT = 8192;
constexpr int CW_BIAS_IN = 65536, CW_BIAS_GU = CW_BIAS_IN + DEPTH * INP_PAD;
constexpr int CW_RSS = 131072;
constexpr int CW_BAR = 4096;
constexpr float RSS_Q = 1024.f, RSS_IQ = 1.f / (1024.f * 1024.f)  , BIAS_Q = 16777216.f, BIAS_IQ = 1.f / 16777216.f;
__device__ __forceinline__ float rss_ms(const float* rss, int row) { return (float)((const unsigned*)rss)[row] * RSS_IQ; }
__device__ __forceinline__ f32x4 bias4(const float* p) { typedef int i32x4 __attribute__((ext_vector_type(4))); const i32x4 v = *(const i32x4*)p; return (f32x4){(float)v[0] * BIAS_IQ, (float)v[1] * BIAS_IQ, (float)v[2] * BIAS_IQ, (float)v[3] * BIAS_IQ}; }
constexpr int RING_BYTES = 131072, LDSCTL_OFF = RING_BYTES, MISC_OFF = LDSCTL_OFF + 320, LDS_BYTES = 163840;

__device__ __forceinline__ int bidx() { int v = blockIdx.x; asm volatile("" : "+s"(v)); return v; }
struct Args { const void* p[N_IN + 3]; int ph_lo, ph_hi, flags, pad; };
__device__ __forceinline__ const float* inp(const Args& a, int i) { asm volatile("" : "+s"(i)); return (const float*)a.p[i]; }
__device__ __forceinline__ float* outp(const Args& a) { int i = N_IN; asm volatile("" : "+s"(i)); return (float*)a.p[i]; }
__device__ __forceinline__ unsigned char* wsp(const Args& a) { int i = N_IN + 1; asm volatile("" : "+s"(i)); return (unsigned char*)a.p[i]; }

__device__ __forceinline__ float bflo(unsigned w) { return __builtin_bit_cast(float, w << 16); }
__device__ __forceinline__ float bfhi(unsigned w) { return __builtin_bit_cast(float, w & 0xffff0000u); }
__device__ __forceinline__ float bf2f(bf16 b) { return __builtin_bit_cast(float, (unsigned)b << 16); }
template <int O> __device__ __forceinline__ float shx(float x) { static_assert(O < 32, "use swap32 across the halves"); return __builtin_bit_cast(float, __builtin_amdgcn_ds_swizzle(__builtin_bit_cast(int, x), (O << 10) | 0x1f)); }
__device__ __forceinline__ void swap32(float& a, float& b) { asm volatile("s_nop 1\n\tv_permlane32_swap_b32 %0, %1" : "+v"(a), "+v"(b)); }
__device__ __forceinline__ float xadd32(float x) { float a = x, b = x; swap32(a, b); return a + b; }
__device__ __forceinline__ float wave_sum(float v) {
    v += shx<1>(v); v += shx<2>(v); v += shx<4>(v); v += shx<8>(v); v += shx<16>(v); v = xadd32(v);
    return v;
}
__device__ __forceinline__ float wave_max(float v) {
    v = fmaxf(v, shx<1>(v)); v = fmaxf(v, shx<2>(v)); v = fmaxf(v, shx<4>(v)); v = fmaxf(v, shx<8>(v)); v = fmaxf(v, shx<16>(v)); { float a = v, c = v; swap32(a, c); v = fmaxf(a, c); }
    return v;
}
__device__ __forceinline__ float siluf(float x) { return x * __builtin_amdgcn_rcpf(1.f + __expf(-x)); }
__device__ __forceinline__ void unpack8(const v4u w, float* f) {
    f[0] = bflo(w.x); f[1] = bfhi(w.x); f[2] = bflo(w.y); f[3] = bfhi(w.y); f[4] = bflo(w.z); f[5] = bfhi(w.z); f[6] = bflo(w.w); f[7] = bfhi(w.w);
}
__device__ __forceinline__ void sincos_d(float angf, float& s, float& c) {
    const double a = (double)angf;
    const double k = __builtin_rint(a * 0.63661977236758134308);
    double r = __builtin_fma(-k, 1.57079632679489655800, a);
    r = __builtin_fma(-k, 6.123233995736766036e-17, r);
    const double r2 = r * r;
    double sp = 1.0 / 6227020800.0; sp = sp * r2 - 1.0 / 39916800.0; sp = sp * r2 + 1.0 / 362880.0; sp = sp * r2 - 1.0 / 5040.0; sp = sp * r2 + 1.0 / 120.0; sp = sp * r2 - 1.0 / 6.0; sp = sp * r2 + 1.0;
    const double sr = sp * r;
    double cp = 1.0 / 479001600.0; cp = cp * r2 - 1.0 / 3628800.0; cp = cp * r2 + 1.0 / 40320.0; cp = cp * r2 - 1.0 / 720.0; cp = cp * r2 + 1.0 / 24.0; cp = cp * r2 - 0.5; cp = cp * r2 + 1.0;
    const int q = (int)((long long)k & 3);
    const double ss = (q == 0) ? sr : (q == 1) ? cp : (q == 2) ? -sr : -cp;
    const double cc = (q == 0) ? cp : (q == 1) ? -sr : (q == 2) ? -cp : sr;
    s = (float)ss; c = (float)cc;
}

namespace pg8 {
struct EpiIn {
    static constexpr bool PERM = true, AFTER_DRAIN = false;
    const Args& ar; int L;
    __device__ __forceinline__ void operator()(const f32x4 (&acc)[2][2][4][2], const Unit& u, int wr, int wc, int fr, int fq) const {
        const int colt = u.pn * BM;
        unsigned char* ws = wsp(ar);
        const float* rss = (const float*)(ws + WS_CTL) + CW_RSS + (L * 2 + 0) * SEQ; const float* bias = (const float*)(ws + WS_CTL) + CW_BIAS_IN + L * INP_PAD;
        bf16_t* qkv = (bf16_t*)(ws + WS_QKV); bf16_t* z = (bf16_t*)(ws + WS_Z); bf16_t* xbc = (bf16_t*)(ws + WS_XBC); float* dt = (float*)(ws + WS_DT);
        const float* rope = (const float*)(ws + WS_ROPE); float* kmean2 = (float*)(ws + WS_KMEAN);
        f32x4 bv[2][2];
#pragma unroll
        for (int bj = 0; bj < 2; ++bj)
#pragma unroll
            for (int n = 0; n < 2; ++n) bv[bj][n] = bias4(bias + colt + bj * HALF + wc * 32 + 8 * fq + 4 * n);
        float rms8[2][4];
#pragma unroll
        for (int ai = 0; ai < 2; ++ai)
#pragma unroll
            for (int m = 0; m < 4; ++m) rms8[ai][m] = rss_ms(rss, u.pm * BM + ai * HALF + wr * 64 + m * 16 + fr);
        asm volatile("" : "+v"(rms8[0][0]), "+v"(rms8[0][1]), "+v"(rms8[0][2]), "+v"(rms8[0][3]), "+v"(rms8[1][0]), "+v"(rms8[1][1]), "+v"(rms8[1][2]), "+v"(rms8[1][3]));
        if (QKFUSE && colt < 3072) {
            const int tsel = u.pn >> 1, head = 4 * (u.pn & 1) + wc;
            const bool isv = (tsel == 2 || tsel == 5);
            const float* gain = (const float*)(ws + WS_GAINS) + (L * 4 + ((tsel == 0) ? 0 : (tsel == 1) ? 1 : (tsel == 3) ? 2 : 3)) * 64;
            f32x4 gn[2][2];
            if (!isv) {
#pragma unroll
                for (int bj = 0; bj < 2; ++bj)
#pragma unroll
                    for (int n = 0; n < 2; ++n) gn[bj][n] = *(const f32x4*)(gain + 32 * bj + ((bj == 0 && fq < 2) ? 4 * fq + 8 * n : 8 * fq + 4 * n)) * ((tsel == 0 || tsel == 3) ? 0.125f * 1.4426950408889634f : 1.0f);
            }
            f32x4 ks[2][2];
#pragma unroll
            for (int bj = 0; bj < 2; ++bj)
#pragma unroll
                for (int n = 0; n < 2; ++n) ks[bj][n] = (f32x4){0.f, 0.f, 0.f, 0.f};
            extern __shared__ __attribute__((aligned(16))) unsigned char lds_epi[];
            PG8_LAS float* ropeL = (PG8_LAS float*)((PG8_LAS unsigned char*)lds_epi + 132096);
            if (!isv) {
                const int t_ = (wr * 4 + wc) * 64 + fq * 16 + fr, rr_ = t_ >> 1, hf_ = t_ & 1;
                const f32x4 ra = *(const f32x4*)(rope + (size_t)(u.pm * BM + rr_) * 16 + hf_ * 8), rb = *(const f32x4*)(rope + (size_t)(u.pm * BM + rr_) * 16 + hf_ * 8 + 4);
                *(PG8_LAS f32x4*)(ropeL + rr_ * 28 + hf_ * 4) = (f32x4){ra[0], ra[2], rb[0], rb[2]};
                *(PG8_LAS f32x4*)(ropeL + rr_ * 28 + 8 + hf_ * 4) = (f32x4){ra[1], ra[3], rb[1], rb[3]};
                *(PG8_LAS f32x4*)(ropeL + rr_ * 28 + 16 + hf_ * 4) = (f32x4){-ra[1], -ra[3], -rb[1], -rb[3]};
                if (t_ < 6) *(PG8_LAS f32x4*)(ropeL + 256 * 28 + t_ * 4) = (t_ < 2) ? (f32x4){1.f, 1.f, 1.f, 1.f} : (f32x4){0.f, 0.f, 0.f, 0.f};
                asm volatile("s_waitcnt lgkmcnt(0)" ::: "memory"); __builtin_amdgcn_s_barrier();
            }
            bf16_t* dbase = qkv + (size_t)(tsel * 8 + head) * SEQ * 64 + 8 * fq;
#pragma unroll
            for (int ai = 0; ai < 2; ++ai)
#pragma unroll
                for (int m = 0; m < 4; ++m) {
                    const int row = u.pm * BM + ai * HALF + wr * 64 + m * 16 + fr;
                    const float rstd = __builtin_amdgcn_rsqf(rms8[ai][m] + 1e-6f);
                    f32x4 v[2][2];
#pragma unroll
                    for (int bj = 0; bj < 2; ++bj)
#pragma unroll
                        for (int n = 0; n < 2; ++n) v[bj][n] = acc[ai][bj][m][n] * rstd + bv[bj][n];
                    if (!isv) {
                        float ss = 0.f;
#pragma unroll
                        for (int bj = 0; bj < 2; ++bj)
#pragma unroll
                            for (int n = 0; n < 2; ++n) ss += (v[bj][n][0] * v[bj][n][0] + v[bj][n][1] * v[bj][n][1]) + (v[bj][n][2] * v[bj][n][2] + v[bj][n][3] * v[bj][n][3]);
                        ss += shx<16>(ss); ss = xadd32(ss);
                        const float rh = __builtin_amdgcn_rsqf(ss * (1.0f / 64.0f) + 1e-6f);
#pragma unroll
                        for (int bj = 0; bj < 2; ++bj)
#pragma unroll
                            for (int n = 0; n < 2; ++n) v[bj][n] = v[bj][n] * rh * gn[bj][n];
                        {
                            const int rsel = (fq < 2) ? (ai * HALF + wr * 64 + m * 16 + fr) : 256;
                            const f32x4 cv = *(const PG8_LAS f32x4*)(ropeL + rsel * 28 + 4 * (fq & 1)), sv = *(const PG8_LAS f32x4*)(ropeL + rsel * 28 + 8 + 4 * (fq & 1));
                            const f32x4 x1 = v[0][0], x2 = v[0][1];
                            v[0][0] = x1 * cv - x2 * sv; v[0][1] = x2 * cv + x1 * sv; }
                        if (tsel == 4) {
#pragma unroll
                            for (int bj = 0; bj < 2; ++bj)
#pragma unroll
                                for (int n = 0; n < 2; ++n) ks[bj][n] += v[bj][n];
                        }
                    }
#pragma unroll
                    for (int bj = 0; bj < 2; ++bj) { const f32x4 v0 = v[bj][0], v1 = v[bj][1];
                        u32x4 w; w.x = cvt_pk_bf16(v0[0], v0[1]); w.y = cvt_pk_bf16(v0[2], v0[3]); w.z = cvt_pk_bf16(v1[0], v1[1]); w.w = cvt_pk_bf16(v1[2], v1[3]);
                        if (bj == 0 && !isv) {
                            typedef unsigned u32x2e __attribute__((ext_vector_type(2)));
                            const int o0 = (fq < 2) ? 4 * fq : 8 * fq, o1 = (fq < 2) ? 4 * fq + 8 : 8 * fq + 4;
                            bf16_t* d0 = dbase - 8 * fq + (size_t)row * 64;
                            *(u32x2e*)(d0 + o0) = (u32x2e){w.x, w.y}; *(u32x2e*)(d0 + o1) = (u32x2e){w.z, w.w};
                        } else *(u32x4*)(dbase + (size_t)row * 64 + 32 * bj) = w; }
                }
            if (tsel == 4) {
#pragma unroll
                for (int bj = 0; bj < 2; ++bj)
#pragma unroll
                    for (int n = 0; n < 2; ++n)
#pragma unroll
                        for (int j = 0; j < 4; ++j) { float s = ks[bj][n][j]; s += shx<1>(s); s += shx<2>(s); s += shx<4>(s); s += shx<8>(s); ks[bj][n][j] = s; }
                if (fr == 0) {
                    float* kd = kmean2 + ((size_t)(wr * 8 + head) * 64 + u.pm) * 64 + 8 * fq;
                    { const int o0 = (fq < 2) ? 4 * fq : 8 * fq, o1 = (fq < 2) ? 4 * fq + 8 : 8 * fq + 4;
                      *(f32x4*)(kd - 8 * fq + o0) = ks[0][0]; *(f32x4*)(kd - 8 * fq + o1) = ks[0][1]; *(f32x4*)(kd + 32) = ks[1][0]; *(f32x4*)(kd + 32 + 4) = ks[1][1]; }
                }
            }
            return;
        }
#pragma unroll
        for (int ai = 0; ai < 2; ++ai)
#pragma unroll
            for (int m = 0; m < 4; ++m) {
                const int row = u.pm * BM + ai * HALF + wr * 64 + m * 16 + fr;
                const float rstd = __builtin_amdgcn_rsqf(rms8[ai][m] + 1e-6f);
#pragma unroll
                for (int bj = 0; bj < 2; ++bj) {
                    const int c = colt + bj * HALF + wc * 32 + 8 * fq;
                    const f32x4 v0 = acc[ai][bj][m][0] * rstd + bv[bj][0], v1 = acc[ai][bj][m][1] * rstd + bv[bj][1];
                    if (colt < 4608) {
                        u32x4 w; w.x = cvt_pk_bf16(v0[0], v0[1]); w.y = cvt_pk_bf16(v0[2], v0[3]); w.z = cvt_pk_bf16(v1[0], v1[1]); w.w = cvt_pk_bf16(v1[2], v1[3]);
                        bf16_t* dst;
                        if (colt < 3072) dst = qkv + ((size_t)(c >> 6) * SEQ + row) * 64 + (c & 63);
                        else if (colt < 3584) dst = z + (size_t)row * 512 + (c - 3072);
                        else dst = xbc + (size_t)row * 1024 + (c - 3584);
                        *(u32x4*)dst = w;
                    } else if (c == 4608) {
                        *(f32x4*)(dt + (size_t)row * 8) = v0; *(f32x4*)(dt + (size_t)row * 8 + 4) = v1;
                    }
                }
            }
    }
};
struct EpiRes {
    static constexpr bool PERM = true, AFTER_DRAIN = false;
    float* out; const float* gate; bf16_t* xb; float* rss;
    __device__ __forceinline__ void operator()(const f32x4 (&acc)[2][2][4][2], const Unit& u, int wr, int wc, int fr, int fq) const {
        typedef unsigned u32x4 __attribute__((ext_vector_type(4)));
        const int col0 = u.pn * BM + wc * 32 + 8 * fq;
        f32x4 gv[2][2];
#pragma unroll
        for (int bj = 0; bj < 2; ++bj)
#pragma unroll
            for (int n = 0; n < 2; ++n) gv[bj][n] = *(const f32x4*)(gate + col0 + bj * HALF + n * 4);
        u32x4 bb[2][4][2];
        const size_t off0 = (size_t)(u.pm * BM + wr * 64 + fr) * DM + col0;
#pragma unroll
        for (int ai = 0; ai < 2; ++ai)
#pragma unroll
            for (int m = 0; m < 4; ++m)
#pragma unroll
                for (int bj = 0; bj < 2; ++bj) bb[ai][m][bj] = *(const u32x4*)(xb + off0 + (size_t)(ai * HALF + m * 16) * DM + bj * HALF);
#pragma unroll
        for (int ai = 0; ai < 2; ++ai)
#pragma unroll
            for (int m = 0; m < 4; ++m) {
                const int row = u.pm * BM + ai * HALF + wr * 64 + m * 16 + fr;
                const size_t off = off0 + (size_t)(ai * HALF + m * 16) * DM;
                float ss = 0.f;
#pragma unroll
                for (int bj = 0; bj < 2; ++bj) {
                    const u32x4 b_ = bb[ai][m][bj];
                    const f32x4 b0 = {__uint_as_float(b_[0] << 16), __uint_as_float(b_[0] & 0xffff0000u), __uint_as_float(b_[1] << 16), __uint_as_float(b_[1] & 0xffff0000u)};
                    const f32x4 b1 = {__uint_as_float(b_[2] << 16), __uint_as_float(b_[2] & 0xffff0000u), __uint_as_float(b_[3] << 16), __uint_as_float(b_[3] & 0xffff0000u)};
                    const f32x4 o0 = b0 + gv[bj][0] * acc[ai][bj][m][0], o1 = b1 + gv[bj][1] * acc[ai][bj][m][1];
                    if (out) { *(f32x4*)(out + off + bj * HALF) = o0; *(f32x4*)(out + off + bj * HALF + 4) = o1; }
                    *(u32x4*)(xb + off + bj * HALF) = (u32x4){cvt_pk_bf16(o0[0], o0[1]), cvt_pk_bf16(o0[2], o0[3]), cvt_pk_bf16(o1[0], o1[1]), cvt_pk_bf16(o1[2], o1[3])};
                    ss += ((o0[0] * o0[0] + o0[1] * o0[1]) + (o0[2] * o0[2] + o0[3] * o0[3])) + ((o1[0] * o1[0] + o1[1] * o1[1]) + (o1[2] * o1[2] + o1[3] * o1[3]));
                }
                ss += shx<16>(ss); ss = xadd32(ss);
                if (rss && fq == 0) atomicAdd((unsigned*)rss + row, (unsigned)__float2uint_rn(ss * RSS_Q));
            }
    }
};
struct EpiSwiglu {
    static constexpr bool PERM = true, AFTER_DRAIN = false;
    bf16_t* hid; const float* rss; const float* bias;
    __device__ __forceinline__ void operator()(const f32x4 (&acc)[2][2][4][2], const Unit& u, int wr, int wc, int fr, int fq) const {
        const int col0 = u.pn * HALF + wc * 32 + 8 * fq, bc0 = u.pn * BM + wc * 32 + 8 * fq;
        f32x4 bv[2][2];
#pragma unroll
        for (int bj = 0; bj < 2; ++bj)
#pragma unroll
            for (int n = 0; n < 2; ++n) bv[bj][n] = bias4(bias + bc0 + bj * HALF + 4 * n);
        float rms8[2][4];
#pragma unroll
        for (int ai = 0; ai < 2; ++ai)
#pragma unroll
            for (int m = 0; m < 4; ++m) rms8[ai][m] = rss_ms(rss, u.pm * BM + ai * HALF + wr * 64 + m * 16 + fr);
        asm volatile("" : "+v"(rms8[0][0]), "+v"(rms8[0][1]), "+v"(rms8[0][2]), "+v"(rms8[0][3]), "+v"(rms8[1][0]), "+v"(rms8[1][1]), "+v"(rms8[1][2]), "+v"(rms8[1][3]));
#pragma unroll
        for (int ai = 0; ai < 2; ++ai)
#pragma unroll
            for (int m = 0; m < 4; ++m) {
                const int row = u.pm * BM + ai * HALF + wr * 64 + m * 16 + fr;
                const float rstd = __builtin_amdgcn_rsqf(rms8[ai][m] + 1e-6f);
                float o[8];
#pragma unroll
                for (int n = 0; n < 2; ++n)
#pragma unroll
                    for (int j = 0; j < 4; ++j) { const float g = acc[ai][0][m][n][j] * rstd + bv[0][n][j], up = acc[ai][1][m][n][j] * rstd + bv[1][n][j]; o[4 * n + j] = g * __builtin_amdgcn_rcpf(1.f + __expf(-g)) * up; }
                u32x4 w; w.x = cvt_pk_bf16(o[0], o[1]); w.y = cvt_pk_bf16(o[2], o[3]); w.z = cvt_pk_bf16(o[4], o[5]); w.w = cvt_pk_bf16(o[6], o[7]);
                *(u32x4*)(hid + (size_t)row * FFN + col0) = w;
            }
    }
};
}

template <bool FOLD>
__device__ __forceinline__ void xpose_item(const float* W, int K, int N, bf16* WT, int k0, int n0, int drow0, LAS float* scr, int lane, const float* nw, const float* scale, const float* shift, float* bias, int qkswz = 0) {
    const int c4 = lane & 7, kk0 = lane >> 3; const bool ok = (n0 + 4 * c4) < N;
    f32x4 w[8];
#pragma unroll
    for (int i = 0; i < 8; ++i) w[i] = ok ? *(const f32x4*)(W + (size_t)(k0 + kk0 + 8 * i) * N + n0 + 4 * c4) : (f32x4){0.f, 0.f, 0.f, 0.f};
    f32x4 bsum = (f32x4){0.f, 0.f, 0.f, 0.f};
#pragma unroll
    for (int i = 0; i < 8; ++i) { const int kk = kk0 + 8 * i;
        if (FOLD) { bsum += w[i] * shift[k0 + kk]; w[i] *= nw[k0 + kk] * (1.0f + scale[k0 + kk]); }
        scr[kk * 33 + 4 * c4] = w[i].x; scr[kk * 33 + 4 * c4 + 1] = w[i].y; scr[kk * 33 + 4 * c4 + 2] = w[i].z; scr[kk * 33 + 4 * c4 + 3] = w[i].w; }
    if (FOLD) {
#pragma unroll
        for (int e = 0; e < 4; ++e) { float s = bsum[e]; s += shx<8>(s); s += shx<16>(s); s = xadd32(s); bsum[e] = s; }
        if (lane < 8 && ok) {
            { const int pc4 = (qkswz && (c4 == 1 || c4 == 2)) ? 3 - c4 : c4;
#pragma unroll
              for (int e = 0; e < 4; ++e) atomicAdd((int*)bias + drow0 + 4 * pc4 + e, __float2int_rn(bsum[e] * BIAS_Q)); } }
    }
    LDS_WAIT(); asm volatile("" ::: "memory");
    const int c = lane & 7;
#pragma unroll
    for (int j = 0; j < 4; ++j) { const int n = (lane >> 3) + 8 * j; const LAS float* s = scr + (8 * c) * 33 + n;
        v4u o; o.x = pk2(s[0 * 33], s[1 * 33]); o.y = pk2(s[2 * 33], s[3 * 33]); o.z = pk2(s[4 * 33], s[5 * 33]); o.w = pk2(s[6 * 33], s[7 * 33]);
        const int pn = (qkswz && n < 16 && ((n >> 2) == 1 || (n >> 2) == 2)) ? (n ^ 12) : n;
        *(GAS v4u*)(WT + (size_t)(drow0 + pn) * K + k0 + 8 * c) = o; }
    LDS_WAIT(); asm volatile("" ::: "memory");
}
__device__ __forceinline__ void p0_prologue(const Args& a, LAS unsigned char* lds, int tid, int lane, int wave, int G) {
    unsigned char* ws = wsp(a);
    {
        LAS float* cact = (LAS float*)lds; LAS float* red = (LAS float*)(lds + 4096);
        for (int i = tid; i < DM; i += 512) cact[i] = siluf(inp(a, I_C)[i]);
        __syncthreads();
        float* mod = (float*)(ws + WS_MOD);
        for (int item = bidx(); item < DEPTH * 96; item += G) {
            const int l = item / 96, j0 = (item % 96) * 64;
            const float* w = inp(a, I_ADAW) + ((size_t)l * DM + wave * 128) * 6144 + j0 + lane;
            float s = 0.f;
#pragma unroll 16
            for (int k = 0; k < 128; ++k) s += cact[wave * 128 + k] * w[(size_t)k * 6144];
            red[wave * 64 + lane] = s;
            __syncthreads();
            if (wave == 0) { float t = inp(a, I_ADAB)[l * 6144 + j0 + lane];
#pragma unroll
                for (int w8 = 0; w8 < 8; ++w8) t += red[w8 * 64 + lane];
                mod[l * 6144 + j0 + lane] = t; }
            __syncthreads();
        }
    }
    {
        typedef float f32x2 __attribute__((ext_vector_type(2)));
        f32x2* rope = (f32x2*)(ws + WS_ROPE);
        for (int idx = bidx() * 512 + tid; idx < SEQ * 8; idx += G * 512) {
            const int pos = idx >> 3, i = idx & 7;
            const float inv = (i == 0) ? 1.0f : (i == 1) ? 0.1939227432012558f : (i == 2) ? 0.03760603070259094f : (i == 3) ? 0.007292664609849453f : (i == 4) ? 0.0014142135623842478f
                            : (i == 5) ? 0.00027424818836152554f : (i == 6) ? 5.318296098266728e-05f : 1.0313386155758053e-05f;
            float s, c; sincos_d((float)pos * inv, s, c);
            rope[idx] = (f32x2){c, s};
        }
    }
    if (bidx() == 0) { float* gt = (float*)(ws + WS_GAINS);
        for (int i = tid; i < DEPTH * 4 * 64; i += 512) { const int l = i >> 8, t4 = (i >> 6) & 3, dd = i & 63; gt[i] = ((t4 == 0) ? inp(a, I_QNS) : (t4 == 1) ? inp(a, I_KNS) : (t4 == 2) ? inp(a, I_QNM) : inp(a, I_KNM))[l * HD + dd]; } }
    {
        bf16* win = (bf16*)(ws + WS_WIN);
        constexpr int PADCH = 224 * DM / 8;
        for (int i = bidx() * 512 + tid; i < DEPTH * PADCH; i += G * 512) { const int l = i / PADCH, r = i % PADCH;
            *(GAS v4u*)(win + (size_t)l * INP_PAD * DM + (size_t)4640 * DM + (size_t)r * 8) = (v4u){0u, 0u, 0u, 0u}; }
    }
    {
        const float* x = inp(a, I_X); bf16* hb = (bf16*)(ws + WS_H); float* rss = (float*)(ws + WS_CTL) + CW_RSS;
        for (int row = bidx() * NWAVES + wave; row < SEQ; row += G * NWAVES) {
            const f32x4* xr = (const f32x4*)(x + (size_t)row * DM) + lane; float s = 0.f;
            unsigned long long* o8 = (unsigned long long*)(hb + (size_t)row * DM) + lane;
#pragma unroll
            for (int j = 0; j < 4; ++j) { const f32x4 v = xr[64 * j]; s += (v.x * v.x + v.y * v.y) + (v.z * v.z + v.w * v.w); o8[64 * j] = (unsigned long long)pk2(v.x, v.y) | ((unsigned long long)pk2(v.z, v.w) << 32); }
            s = wave_sum(s);
            if (lane == 0) ((unsigned*)rss)[row] = (unsigned)__float2uint_rn(s * RSS_Q);
        }
    }
}
__device__ __forceinline__ void p0_weights(const Args& a, LAS unsigned char* lds, int lane, int wave, int G) {
    unsigned char* ws = wsp(a);
    {
        LAS float* scr = (LAS float*)(lds + wave * 16384);
        const int gw = bidx() * NWAVES + wave, NGW = G * NWAVES;
        constexpr int I_IN = 16 * 145, I_OUT = 24 * 32, I_G = 16 * 88, I_DN = 44 * 32, I_LAYER = I_IN + I_OUT + 2 * I_G + I_DN;
        bf16* win = (bf16*)(ws + WS_WIN); bf16* wout = (bf16*)(ws + WS_WOUT); bf16* wgu = (bf16*)(ws + WS_WGU); bf16* wdn = (bf16*)(ws + WS_WDN);
        const float* mod = (const float*)(ws + WS_MOD); float* ctlf = (float*)(ws + WS_CTL);
        for (int it = gw; it < DEPTH * I_LAYER; it += NGW) {
            const int l = it / I_LAYER; int r = it % I_LAYER; const float* md = mod + l * 6144;
            if (r < I_IN) { const int kb = r / 145, nb = r % 145, n0 = nb * 32;
                const int drow = (QKFUSE && n0 < 3072) ? (n0 & ~255) + 128 * ((n0 >> 5) & 1) + 32 * ((n0 >> 6) & 3) : n0;
                xpose_item<true>(inp(a, I_WIN) + (size_t)l * DM * INP, DM, INP, win + (size_t)l * INP_PAD * DM, kb * 64, n0, drow, scr, lane, inp(a, I_NMIX) + l * DM, md + 1024, md, ctlf + CW_BIAS_IN + l * INP_PAD, (QKFUSE && n0 < 3072 && ((n0 >> 9) % 3) != 2 && ((n0 >> 5) & 1) == 0) ? 1 : 0); continue; }
            r -= I_IN;
            if (r < I_OUT) { const int kb = r / 32, nb = r % 32; xpose_item<false>(inp(a, I_WOUT) + (size_t)l * MIXW * DM, MIXW, DM, wout + (size_t)l * DM * MIXW, kb * 64, nb * 32, nb * 32, scr, lane, nullptr, nullptr, nullptr, nullptr); continue; }
            r -= I_OUT;
            if (r < I_G) { const int kb = r / 88, n0 = (r % 88) * 32; xpose_item<true>(inp(a, I_WG) + (size_t)l * DM * FFN, DM, FFN, wgu + (size_t)l * GU * DM, kb * 64, n0, 256 * (n0 >> 7) + (n0 & 127), scr, lane, inp(a, I_NFFN) + l * DM, md + 4096, md + 3072, ctlf + CW_BIAS_GU + l * GU); continue; }
            r -= I_G;
            if (r < I_G) { const int kb = r / 88, n0 = (r % 88) * 32; xpose_item<true>(inp(a, I_WU) + (size_t)l * DM * FFN, DM, FFN, wgu + (size_t)l * GU * DM, kb * 64, n0, 256 * (n0 >> 7) + 128 + (n0 & 127), scr, lane, inp(a, I_NFFN) + l * DM, md + 4096, md + 3072, ctlf + CW_BIAS_GU + l * GU); continue; }
            r -= I_G;
            { const int kb = r / 32, nb = r % 32; xpose_item<false>(inp(a, I_WD) + (size_t)l * FFN * DM, FFN, DM, wdn + (size_t)l * DM * FFN, kb * 64, nb * 32, nb * 32, scr, lane, nullptr, nullptr, nullptr, nullptr); }
        }
    }
}

__device__ __forceinline__ void prep_phase(const Args& a, int L, LAS unsigned char* lds, int tid, int G) {
    unsigned char* ws = wsp(a);
    bf16* qkv = (bf16*)(ws + WS_QKV);
    typedef float f32x2 __attribute__((ext_vector_type(2)));
    const f32x2* rope = (const f32x2*)(ws + WS_ROPE);
    float* kmean = (float*)(ws + WS_KMEAN);
#if !QKFUSE
    for (int item = (a.flags & 1) ? 4 * NH * 64 : (int)blockIdx.x; item < 4 * NH * 64; item += G) {
        const int ts = item >> 9, h = (item >> 6) & 7, blk = item & 63;
        const int tsel = (ts < 2) ? ts : ts + 1;
        const float* gain = ((ts == 0) ? inp(a, I_QNS) : (ts == 1) ? inp(a, I_KNS) : (ts == 2) ? inp(a, I_QNM) : inp(a, I_KNM)) + L * HD;
        const int r = tid >> 1, hf = tid & 1, pos = blk * 256 + r;
        bf16* p = qkv + ((size_t)(tsel * 8 + h) * SEQ + pos) * 64 + hf * 32;
        float v[32];
#pragma unroll
        for (int i = 0; i < 4; ++i) unpack8(*(const v4u*)(p + 8 * i), v + 8 * i);
        float ss = 0.f;
#pragma unroll
        for (int i = 0; i < 32; ++i) ss += v[i] * v[i];
        ss += __shfl_xor(ss, 1);
        const float rstd = 1.0f / sqrtf(ss * (1.f / 64.f) + EPS);
        const float qs = (ts == 0 || ts == 2) ? C2 : 1.0f;
#pragma unroll
        for (int i = 0; i < 32; ++i) v[i] = v[i] * rstd * gain[hf * 32 + i] * qs;
        if (hf == 0) {
#pragma unroll
            for (int i = 0; i < 8; ++i) { const f32x2 cs = rope[pos * 8 + i]; const float x1 = v[i], x2 = v[i + 8]; v[i] = x1 * cs.x - x2 * cs.y; v[i + 8] = x2 * cs.x + x1 * cs.y; }
        }
#pragma unroll
        for (int i = 0; i < 4; ++i) { v4u w; w.x = pk2(v[8 * i], v[8 * i + 1]); w.y = pk2(v[8 * i + 2], v[8 * i + 3]); w.z = pk2(v[8 * i + 4], v[8 * i + 5]); w.w = pk2(v[8 * i + 6], v[8 * i + 7]); *(v4u*)(p + 8 * i) = w; }
        if (ts == 3) {
            LAS float* S = (LAS float*)lds;
#pragma unroll
            for (int i = 0; i < 32; ++i) S[r * 65 + hf * 32 + i] = v[i];
            __syncthreads();
            { const int col = tid & 63, part = tid >> 6; float s = 0.f;
#pragma unroll 8
                for (int rr = 0; rr < 32; ++rr) s += S[(part * 32 + rr) * 65 + col];
                __syncthreads();
                S[part * 65 + col] = s;
                __syncthreads();
                if (tid < 64) { float t = 0.f;
#pragma unroll
                    for (int pp = 0; pp < 8; ++pp) t += S[pp * 65 + tid];
                    kmean[(h * 64 + blk) * 64 + tid] = t; kmean[((8 + h) * 64 + blk) * 64 + tid] = 0.f; } }
            __syncthreads();
        }
    }
#endif
    {
        const bf16* xbc = (const bf16*)(ws + WS_XBC); bf16* xc = (bf16*)(ws + WS_XC);
        const float* cw = inp(a, I_CONVW) + (size_t)L * 4 * 1024; const float* cb = inp(a, I_CONVB) + (size_t)L * 1024;
        const float* dtraw = (const float*)(ws + WS_DT); float* csg = (float*)(ws + WS_CS);
        bf16* xdtT = (bf16*)((unsigned char*)outp(a) + XT_XDTT); bf16* xwT = (bf16*)((unsigned char*)outp(a) + XT_XWT); bf16* BT = (bf16*)(ws + WS_BT);
        const int lane = tid & 63, wave = tid >> 6;
        v4u praw[8], ph[3];
        auto issue = [&](int item_) { const int c_ = item_ / 12, q_ = item_ % 12, l0_ = c_ * 256;
            const int chb_ = (q_ < 8) ? q_ * 64 : (q_ < 10) ? 512 + (q_ - 8) * 128 : 768 + (q_ - 10) * 128;
            const int oc_ = (q_ < 8) ? (tid & 7) : (tid & 15), rg_ = (q_ < 8) ? (tid >> 3) : (tid >> 4), nrow_ = (q_ < 8) ? 4 : 8, ch_ = chb_ + oc_ * 8, lb_ = rg_ * nrow_, p0_ = l0_ + lb_ - 3;
#pragma unroll
            for (int i = 0; i < 3; ++i) { const int pp = (p0_ + i < 0) ? 0 : p0_ + i; ph[i] = *(const v4u*)(xbc + (size_t)pp * 1024 + ch_); }
#pragma unroll
            for (int rr = 0; rr < 8; ++rr) if (rr < nrow_) praw[rr] = *(const v4u*)(xbc + (size_t)(l0_ + lb_ + rr) * 1024 + ch_); };
        if ((int)bidx() < 64 * 12) issue((int)bidx());
        for (int item = bidx(); item < 64 * 12; item += G) {
            const int c = item / 12, q = item % 12, l0 = c * 256;
            const int chbase = (q < 8) ? q * 64 : (q < 10) ? 512 + (q - 8) * 128 : 768 + (q - 10) * 128;
            const int noct = (q < 8) ? 8 : 16;
            LAS float* xt = (LAS float*)lds;
            LAS bf16* bt = (LAS bf16*)lds;
            LAS float* csL = (LAS float*)(lds + 96 * 1024); LAS float* dtL = csL + 256;
            if (q < 8 && wave == 0) {
                const float av = -__expf(inp(a, I_ALOG)[L * 8 + q]), db = inp(a, I_DTB)[L * 8 + q];
                float dv[4], pc[4]; float run = 0.f;
#pragma unroll
                for (int i = 0; i < 4; ++i) { const float x = dtraw[(size_t)(l0 + 4 * lane + i) * 8 + q] + db; dv[i] = fmaxf(x, 0.f) + log1pf(__expf(-fabsf(x))); run += av * dv[i]; pc[i] = run; }
                float inc = run;
#pragma unroll
                for (int o = 1; o < 64; o <<= 1) { const float t = __builtin_bit_cast(float, __builtin_amdgcn_ds_bpermute(((lane - o) & 63) << 2, __builtin_bit_cast(int, inc))); if (lane >= o) inc += t; }
                const float ex = inc - run;
#pragma unroll
                for (int i = 0; i < 4; ++i) { csL[4 * lane + i] = ex + pc[i]; dtL[4 * lane + i] = dv[i]; }
                *(f32x4*)(csg + (size_t)(c * 8 + q) * 256 + 4 * lane) = (f32x4){ex + pc[0], ex + pc[1], ex + pc[2], ex + pc[3]};
            }
            {
                const int oc = (q < 8) ? (tid & 7) : (tid & 15), rg = (q < 8) ? (tid >> 3) : (tid >> 4), nrow = (q < 8) ? 4 : 8, ch = chbase + oc * 8, lb = rg * nrow;
                float wj[4][8], bs[8];
#pragma unroll
                for (int jj = 0; jj < 4; ++jj) { const f32x4 u = *(const f32x4*)(cw + jj * 1024 + ch), v = *(const f32x4*)(cw + jj * 1024 + ch + 4); wj[jj][0] = u.x; wj[jj][1] = u.y; wj[jj][2] = u.z; wj[jj][3] = u.w; wj[jj][4] = v.x; wj[jj][5] = v.y; wj[jj][6] = v.z; wj[jj][7] = v.w; }
                { const f32x4 u = *(const f32x4*)(cb + ch), v = *(const f32x4*)(cb + ch + 4); bs[0] = u.x; bs[1] = u.y; bs[2] = u.z; bs[3] = u.w; bs[4] = v.x; bs[5] = v.y; bs[6] = v.z; bs[7] = v.w; }
                float x0[8], x1[8], x2[8], x3[8];
                { const int p0 = l0 + lb - 3;
                  if (p0 >= 0) unpack8(ph[0], x0); else {
#pragma unroll
                      for (int i = 0; i < 8; ++i) x0[i] = 0.f; }
                  if (p0 + 1 >= 0) unpack8(ph[1], x1); else {
#pragma unroll
                      for (int i = 0; i < 8; ++i) x1[i] = 0.f; }
                  if (p0 + 2 >= 0) unpack8(ph[2], x2); else {
#pragma unroll
                      for (int i = 0; i < 8; ++i) x2[i] = 0.f; } }
                v4u raw[8];
#pragma unroll
                for (int rr = 0; rr < 8; ++rr) if (rr < nrow) raw[rr] = praw[rr];
#pragma unroll
                for (int rr = 0; rr < 8; ++rr) {
                    if (rr < nrow) {
                    const int l = lb + rr, pos = l0 + l;
                    unpack8(raw[rr], x3);
                    float acc[8];
#pragma unroll
                    for (int i = 0; i < 8; ++i) acc[i] = siluf(bs[i] + wj[0][i] * x0[i] + wj[1][i] * x1[i] + wj[2][i] * x2[i] + wj[3][i] * x3[i]);
#pragma unroll
                    for (int i = 0; i < 8; ++i) { x0[i] = x1[i]; x1[i] = x2[i]; x2[i] = x3[i]; }
                    v4u w; w.x = pk2(acc[0], acc[1]); w.y = pk2(acc[2], acc[3]); w.z = pk2(acc[4], acc[5]); w.w = pk2(acc[6], acc[7]);
                    *(v4u*)(xc + (size_t)pos * 1024 + ch) = w;
                    if (q < 8) {
#pragma unroll
                        for (int i = 0; i < 8; ++i) xt[l * 65 + oc * 8 + i] = acc[i];
                    } else if (q < 10) { *(LAS v4u*)(bt + l * 136 + oc * 8) = w; }
                    }
                }
            }
            if (item + G < 64 * 12) issue(item + G);
            __syncthreads();
            if (q < 8) {
                const int p = tid & 63; const float cend = csL[255];
#pragma unroll
                for (int k = 0; k < 4; ++k) { const int lo = (tid >> 6) + 8 * k, lb = 8 * lo; float xd[8], xw[8];
#pragma unroll
                    for (int e = 0; e < 8; ++e) { const float x = xt[(lb + e) * 65 + p]; xd[e] = x * dtL[lb + e]; xw[e] = xd[e] * __expf(cend - csL[lb + e]); }
                    v4u w1, w2; w1.x = pk2(xd[0], xd[1]); w1.y = pk2(xd[2], xd[3]); w1.z = pk2(xd[4], xd[5]); w1.w = pk2(xd[6], xd[7]);
                    w2.x = pk2(xw[0], xw[1]); w2.y = pk2(xw[2], xw[3]); w2.z = pk2(xw[4], xw[5]); w2.w = pk2(xw[6], xw[7]);
                    const size_t o = ((size_t)(c * 8 + q) * 64 + p) * 256 + lb;
                    *(v4u*)(xdtT + o) = w1; *(v4u*)(xwT + o) = w2; }
            } else if (q < 10) {
                const int n = tid & 127;
#pragma unroll
                for (int k = 0; k < 8; ++k) { const int lo = (tid >> 7) + 4 * k, lb = 8 * lo; unsigned short e[8];
#pragma unroll
                    for (int i = 0; i < 8; ++i) e[i] = bt[(lb + i) * 136 + n];
                    v4u w; w.x = e[0] | ((unsigned)e[1] << 16); w.y = e[2] | ((unsigned)e[3] << 16); w.z = e[4] | ((unsigned)e[5] << 16); w.w = e[6] | ((unsigned)e[7] << 16);
                    *(v4u*)(BT + ((size_t)(c * 2 + (q - 8)) * 128 + n) * 256 + lb) = w; }
            }
            __syncthreads();
        }
    }
}

__device__ __forceinline__ float dot64(const float* q, const bf16* krow) {
    float s0 = 0.f, s1 = 0.f;
#pragma unroll
    for (int i = 0; i < 8; ++i) { const v4u w = *(const v4u*)(krow + 8 * i);
        s0 += q[8 * i] * bflo(w.x); s1 += q[8 * i + 1] * bfhi(w.x); s0 += q[8 * i + 2] * bflo(w.y); s1 += q[8 * i + 3] * bfhi(w.y);
        s0 += q[8 * i + 4] * bflo(w.z); s1 += q[8 * i + 5] * bfhi(w.z); s0 += q[8 * i + 6] * bflo(w.w); s1 += q[8 * i + 7] * bfhi(w.w); }
    return s0 + s1;
}
__device__ __forceinline__ void load_q64(const bf16* qrow, float* q) {
#pragma unroll
    for (int i = 0; i < 8; ++i) unpack8(*(const v4u*)(qrow + 8 * i), q + 8 * i);
}
typedef float f32x16 __attribute__((ext_vector_type(16)));
__device__ __forceinline__ int pi32(int r) { return (r & ~12) | ((r & 4) << 1) | ((r & 8) >> 1); }
__device__ __forceinline__ unsigned cvtpk(float lo, float hi) { unsigned r; asm volatile("v_cvt_pk_bf16_f32 %0, %1, %2" : "=v"(r) : "v"(lo), "v"(hi)); return r; }
__device__ __forceinline__ float dot2ones(unsigned w, float acc) { typedef __bf16 bf2_t __attribute__((ext_vector_type(2))); return __builtin_amdgcn_fdot2_f32_bf16(__builtin_bit_cast(bf2_t, w), __builtin_bit_cast(bf2_t, 0x3f803f80u), acc, false); }
__device__ __forceinline__ v4u pack8w(const f32x16& x, int b0) { v4u w; w.x = cvtpk(x[b0], x[b0 + 1]); w.y = cvtpk(x[b0 + 2], x[b0 + 3]); w.z = cvtpk(x[b0 + 4], x[b0 + 5]); w.w = cvtpk(x[b0 + 6], x[b0 + 7]); return w; }
__device__ __forceinline__ bf16x8 pack8(const f32x16& x, int b0) { v4u w; w.x = cvtpk(x[b0], x[b0 + 1]); w.y = cvtpk(x[b0 + 2], x[b0 + 3]); w.z = cvtpk(x[b0 + 4], x[b0 + 5]); w.w = cvtpk(x[b0 + 6], x[b0 + 7]); return __builtin_bit_cast(bf16x8, w); }
__device__ __forceinline__ bf16x8 cvt8(const float* p) { const f32x4 u = *(const f32x4*)p, v = *(const f32x4*)(p + 4); v4u w; w.x = cvtpk(u.x, u.y); w.y = cvtpk(u.z, u.w); w.z = cvtpk(v.x, v.y); w.w = cvtpk(v.z, v.w); return __builtin_bit_cast(bf16x8, w); }
__device__ __forceinline__ void ssd_states(unsigned char* ws, const unsigned char* xt, int lane, int gw, int NGW) {
    const bf16* xwT = (const bf16*)(xt + XT_XWT); const bf16* BT = (const bf16*)(ws + WS_BT); float* ST = (float*)(ws + WS_ST);
    const int r = lane & 31, hh = lane >> 5;
    for (int u = gw; u < 2048; u += NGW) {
        const int c = u >> 5, h = (u >> 2) & 7, j = u & 3, g = h >> 2;
        const bf16* A = xwT + (size_t)(c * 8 + h) * 64 * 256 + (size_t)r * 256 + hh * 8; const bf16* Bm = BT + (size_t)(c * 2 + g) * 128 * 256 + (size_t)(j * 32 + r) * 256 + hh * 8;
        f32x16 acc0 = f32x16{}, acc1 = f32x16{};
#pragma unroll
        for (int half = 0; half < 2; ++half) {
            bf16x8 a0[8], a1[8], bb[8];
#pragma unroll
            for (int k8 = 0; k8 < 8; ++k8) { const int ks = 8 * half + k8; a0[k8] = *(const bf16x8*)(A + ks * 16); a1[k8] = *(const bf16x8*)(A + 32 * 256 + ks * 16); bb[k8] = *(const bf16x8*)(Bm + ks * 16); }
            asm volatile("" : "+v"(a0[0]), "+v"(a0[1]), "+v"(a0[2]), "+v"(a0[3]), "+v"(a0[4]), "+v"(a0[5]), "+v"(a0[6]), "+v"(a0[7]), "+v"(a1[0]), "+v"(a1[1]), "+v"(a1[2]), "+v"(a1[3]), "+v"(a1[4]), "+v"(a1[5]), "+v"(a1[6]), "+v"(a1[7]),
                         "+v"(bb[0]), "+v"(bb[1]), "+v"(bb[2]), "+v"(bb[3]), "+v"(bb[4]), "+v"(bb[5]), "+v"(bb[6]), "+v"(bb[7]));
#pragma unroll
            for (int k8 = 0; k8 < 8; ++k8) { acc0 = __builtin_amdgcn_mfma_f32_32x32x16_bf16(a0[k8], bb[k8], acc0, 0, 0, 0); acc1 = __builtin_amdgcn_mfma_f32_32x32x16_bf16(a1[k8], bb[k8], acc1, 0, 0, 0); }
        }
        float* S = ST + (size_t)(c * 8 + h) * 64 * 128 + j * 32 + r;
#pragma unroll
        for (int reg = 0; reg < 16; ++reg) { const int p = (reg & 3) + 8 * (reg >> 2) + 4 * hh; S[(size_t)p * 128] = acc0[reg]; S[(size_t)(32 + p) * 128] = acc1[reg]; }
    }
}
__device__ __forceinline__ void ssd_scan(unsigned char* ws, unsigned char* xt, LAS unsigned char* lds, int tid, int G) {
    const float* ST = (const float*)(ws + WS_ST); bf16* STB = (bf16*)(xt + XT_STB); const float* csg = (const float*)(ws + WS_CS);
    LAS float* decL = (LAS float*)lds;
    for (int base = bidx() * 256; base < 8 * 8192; base += G * 256) {
        const int h = base >> 13, pn = (base & 8191) + (tid & 255);
        __syncthreads();
        if (tid < 64) decL[tid] = __expf(csg[(size_t)(tid * 8 + h) * 256 + 255]);
        __syncthreads();
        if (tid < 256) {
            float s[64];
#pragma unroll
            for (int c = 0; c < 64; ++c) s[c] = ST[(size_t)(c * 8 + h) * 8192 + pn];
            float hin = 0.f;
#pragma unroll
            for (int c = 0; c < 64; ++c) { STB[(size_t)(c * 8 + h) * 8192 + pn] = (bf16)f2bf(hin); hin = hin * decL[c] + s[c]; }
        }
    }
}
__device__ __forceinline__ void ssd_xt_tile(f32x16& acc0, f32x16& acc1, bf16x8 (&bfr)[8], const bf16x8 (&cf)[8], const bf16* At, const bf16* bnext, bool has_next, int st, const LAS float* csW, float csl, int lrel, int r, int hh) {
    f32x16 X = f32x16{};
#pragma unroll
    for (int k = 0; k < 8; ++k) X = __builtin_amdgcn_mfma_f32_32x32x16_bf16(bfr[k], cf[k], X, 0, 0, 0);
    const bf16x8 a00 = *(const bf16x8*)(At + (size_t)r * 256 + st * 32), a01 = *(const bf16x8*)(At + (size_t)r * 256 + st * 32 + 16);
    const bf16x8 a10 = *(const bf16x8*)(At + (size_t)(32 + r) * 256 + st * 32), a11 = *(const bf16x8*)(At + (size_t)(32 + r) * 256 + st * 32 + 16);
    if (has_next) {
#pragma unroll
        for (int k = 0; k < 8; ++k) bfr[k] = *(const bf16x8*)(bnext + k * 16); }
    f32x4 cw[4];
#pragma unroll
    for (int q4 = 0; q4 < 4; ++q4) cw[q4] = *(const LAS f32x4*)(csW + st * 32 + pi32(8 * q4 + 4 * hh));
    asm volatile("" : "+v"(cw[0]), "+v"(cw[1]), "+v"(cw[2]), "+v"(cw[3]));
#pragma unroll
    for (int q4 = 0; q4 < 4; ++q4) {
        const int s0 = st * 32 + pi32(8 * q4 + 4 * hh);
#pragma unroll
        for (int i = 0; i < 4; ++i) { const int reg = 4 * q4 + i; const float e = __expf(fminf(csl - cw[q4][i], 0.f)); X[reg] = (s0 + i <= lrel) ? X[reg] * e : 0.f; }
    }
    const bf16x8 m0 = pack8(X, 0), m1 = pack8(X, 8);
    acc0 = __builtin_amdgcn_mfma_f32_32x32x16_bf16(a00, m0, acc0, 0, 0, 0); acc0 = __builtin_amdgcn_mfma_f32_32x32x16_bf16(a01, m1, acc0, 0, 0, 0);
    acc1 = __builtin_amdgcn_mfma_f32_32x32x16_bf16(a10, m0, acc1, 0, 0, 0); acc1 = __builtin_amdgcn_mfma_f32_32x32x16_bf16(a11, m1, acc1, 0, 0, 0);
}
__device__ __forceinline__ void ssd_xt_tile_l(f32x16& acc0, f32x16& acc1, const LAS bf16* Bl, const bf16x8 (&cf)[8], const bf16* At, bf16x8 (&af)[4], bool has_next, int st, const LAS float* csW, float csl, int lrel, int r, int hh) {
    f32x16 X = f32x16{};
    const LAS bf16* br = Bl + (st * 32 + pi32(r)) * 136 + hh * 8;
    bf16x8 bk[8];
#pragma unroll
    for (int k = 0; k < 8; ++k) bk[k] = *(const LAS bf16x8*)(br + k * 16);
    asm volatile("" : "+v"(bk[0]), "+v"(bk[1]), "+v"(bk[2]), "+v"(bk[3]), "+v"(bk[4]), "+v"(bk[5]), "+v"(bk[6]), "+v"(bk[7]));
#pragma unroll
    for (int k = 0; k < 8; ++k) X = __builtin_amdgcn_mfma_f32_32x32x16_bf16(bk[k], cf[k], X, 0, 0, 0);
    const bf16x8 a00 = af[0], a01 = af[1], a10 = af[2], a11 = af[3];
    if (has_next) { af[0] = *(const bf16x8*)(At + (size_t)r * 256 + (st + 1) * 32); af[1] = *(const bf16x8*)(At + (size_t)r * 256 + (st + 1) * 32 + 16);
                    af[2] = *(const bf16x8*)(At + (size_t)(32 + r) * 256 + (st + 1) * 32); af[3] = *(const bf16x8*)(At + (size_t)(32 + r) * 256 + (st + 1) * 32 + 16); }
    f32x4 cw[4];
#pragma unroll
    for (int q4 = 0; q4 < 4; ++q4) cw[q4] = *(const LAS f32x4*)(csW + st * 32 + pi32(8 * q4 + 4 * hh));
    asm volatile("" : "+v"(cw[0]), "+v"(cw[1]), "+v"(cw[2]), "+v"(cw[3]));
#pragma unroll
    for (int q4 = 0; q4 < 4; ++q4) {
        const int s0 = st * 32 + pi32(8 * q4 + 4 * hh);
#pragma unroll
        for (int i = 0; i < 4; ++i) { const int reg = 4 * q4 + i; const float e = __expf(fminf(csl - cw[q4][i], 0.f)); X[reg] = (s0 + i <= lrel) ? X[reg] * e : 0.f; }
    }
    const bf16x8 m0 = pack8(X, 0), m1 = pack8(X, 8);
    acc0 = __builtin_amdgcn_mfma_f32_32x32x16_bf16(a00, m0, acc0, 0, 0, 0); acc0 = __builtin_amdgcn_mfma_f32_32x32x16_bf16(a01, m1, acc0, 0, 0, 0);
    acc1 = __builtin_amdgcn_mfma_f32_32x32x16_bf16(a10, m0, acc1, 0, 0, 0); acc1 = __builtin_amdgcn_mfma_f32_32x32x16_bf16(a11, m1, acc1, 0, 0, 0);
}
__device__ __forceinline__ void ssd_out(const Args& a, int L, LAS unsigned char* lds, int lane_in, int wave, int G) {
    unsigned char* ws = wsp(a);
    const bf16* xc = (const bf16*)(ws + WS_XC); const bf16* xdtT = (const bf16*)((const unsigned char*)outp(a) + XT_XDTT); const bf16* STB = (const bf16*)((const unsigned char*)outp(a) + XT_STB); const float* csg = (const float*)(ws + WS_CS);
    const bf16* Z = (const bf16*)(ws + WS_Z); bf16* mix = (bf16*)(ws + WS_MIX);
    LAS bf16* Bl = (LAS bf16*)lds;
    LAS unsigned char* wl = lds + ((wave < 6) ? 69632 + wave * 10240 : 132096 + (wave - 6) * 10240);
    LAS float* csW = (LAS float*)wl;
    LAS bf16* xt = (LAS bf16*)(wl + 1024);
    LAS bf16* zt = (LAS bf16*)(wl + 1024 + 4352);
    LAS float* nwL = (LAS float*)(wl + 1024 + 2 * 4352);
    LAS float* ssx = (LAS float*)(lds + 152576);
    typedef unsigned u32x2 __attribute__((ext_vector_type(2)));
    for (int unit = bidx(); unit < 256; unit += G) {
        int lane = lane_in; asm volatile("" : "+v"(lane));
        const int r = lane & 31, hh = lane >> 5;
        const int c = unit >> 2, g = (unit >> 1) & 1, hd = wave & 3, tpi = wave >> 2, tp = 2 * (unit & 1) + tpi, h = 4 * g + hd;
        {
            const int tid_ = wave * 64 + lane;
            v4u bt[8];
#pragma unroll
            for (int i = 0; i < 8; ++i) { const int id = tid_ + 512 * i; bt[i] = *(const v4u*)(xc + (size_t)(c * 256 + (id >> 4)) * 1024 + 512 + g * 128 + (id & 15) * 8); }
#pragma unroll
            for (int i = 0; i < 8; ++i) { const int id = tid_ + 512 * i; *(LAS v4u*)(Bl + (id >> 4) * 136 + (id & 15) * 8) = bt[i]; }
        }
        *(LAS f32x4*)(csW + 4 * lane) = *(const f32x4*)(csg + (size_t)(c * 8 + h) * 256 + 4 * lane);
        if (lane < 16) *(LAS f32x4*)(nwL + 4 * lane) = *(const f32x4*)(inp(a, I_SNORM) + L * 512 + h * 64 + 4 * lane);
        const float Dk = inp(a, I_DSKIP)[L * 8 + h];
        const bf16* At = xdtT + (size_t)(c * 8 + h) * 64 * 256 + hh * 8;
        const bf16* Hin = STB + (size_t)(c * 8 + h) * 8192 + hh * 8;
        LDS_WAIT(); asm volatile("" ::: "memory");
        __syncthreads();
        for (int ti = 0; ti < 2; ++ti) {
            const int w = ti ? 7 - tp : tp, l0 = 32 * w, posl = c * 256 + l0 + r;
            bf16x8 cf[8];
#pragma unroll
            for (int k = 0; k < 8; ++k) cf[k] = *(const bf16x8*)(xc + (size_t)posl * 1024 + 768 + g * 128 + k * 16 + hh * 8);
            bf16x8 af[4];
            af[0] = *(const bf16x8*)(At + (size_t)r * 256); af[1] = *(const bf16x8*)(At + (size_t)r * 256 + 16); af[2] = *(const bf16x8*)(At + (size_t)(32 + r) * 256); af[3] = *(const bf16x8*)(At + (size_t)(32 + r) * 256 + 16);
            f32x16 acc0 = f32x16{}, acc1 = f32x16{};
            if (!FLG(a, 64)) {
            bf16x8 h0[8], h1[8];
#pragma unroll
            for (int k = 0; k < 8; ++k) { h0[k] = *(const bf16x8*)(Hin + (size_t)r * 128 + k * 16); h1[k] = *(const bf16x8*)(Hin + (size_t)(32 + r) * 128 + k * 16); }
            asm volatile("" : "+v"(h0[0]), "+v"(h0[1]), "+v"(h0[2]), "+v"(h0[3]), "+v"(h0[4]), "+v"(h0[5]), "+v"(h0[6]), "+v"(h0[7]), "+v"(h1[0]), "+v"(h1[1]), "+v"(h1[2]), "+v"(h1[3]), "+v"(h1[4]), "+v"(h1[5]), "+v"(h1[6]), "+v"(h1[7]));
#pragma unroll
            for (int k = 0; k < 8; ++k) { acc0 = __builtin_amdgcn_mfma_f32_32x32x16_bf16(h0[k], cf[k], acc0, 0, 0, 0); acc1 = __builtin_amdgcn_mfma_f32_32x32x16_bf16(h1[k], cf[k], acc1, 0, 0, 0); } }
            const float csl = csW[l0 + r], el = __expf(csl);
#pragma unroll
            for (int i = 0; i < 16; ++i) { acc0[i] *= el; acc1[i] *= el; }
            v4u xvr[4], zvr[4];
#pragma unroll
            for (int k = 0; k < 4; ++k) { const int id = lane + 64 * k, row = id >> 3, oc = id & 7; const size_t pos = (size_t)(c * 256 + l0 + row);
                xvr[k] = *(const v4u*)(xc + pos * 1024 + h * 64 + oc * 8); zvr[k] = *(const v4u*)(Z + pos * 512 + h * 64 + oc * 8); }
            if (!FLG(a, 128)) for (int st = 0; st <= w; ++st) ssd_xt_tile_l(acc0, acc1, Bl, cf, At, af, st < w, st, csW, csl, l0 + r, r, hh);
            float ss = 0.f;
#pragma unroll
            for (int k = 0; k < 4; ++k) { const int id = lane + 64 * k, row = id >> 3, oc = id & 7;
                const v4u xv = xvr[k], zv = zvr[k];
                *(LAS u32x2*)(xt + row * 68 + oc * 8) = (u32x2){xv.x, xv.y}; *(LAS u32x2*)(xt + row * 68 + oc * 8 + 4) = (u32x2){xv.z, xv.w};
                *(LAS u32x2*)(zt + row * 68 + oc * 8) = (u32x2){zv.x, zv.y}; *(LAS u32x2*)(zt + row * 68 + oc * 8 + 4) = (u32x2){zv.z, zv.w}; }
            LDS_WAIT(); asm volatile("" ::: "memory");
            if (!FLG(a, 256))
#pragma unroll
            for (int q = 0; q < 4; ++q) { const int pb = 8 * q + 4 * hh;
                const u32x2 xa = *(const LAS u32x2*)(xt + r * 68 + pb), za = *(const LAS u32x2*)(zt + r * 68 + pb), xb = *(const LAS u32x2*)(xt + r * 68 + 32 + pb), zb = *(const LAS u32x2*)(zt + r * 68 + 32 + pb);
                const float x0[4] = {bflo(xa.x), bfhi(xa.x), bflo(xa.y), bfhi(xa.y)}, z0[4] = {bflo(za.x), bfhi(za.x), bflo(za.y), bfhi(za.y)};
                const float x1[4] = {bflo(xb.x), bfhi(xb.x), bflo(xb.y), bfhi(xb.y)}, z1[4] = {bflo(zb.x), bfhi(zb.x), bflo(zb.y), bfhi(zb.y)};
#pragma unroll
                for (int i = 0; i < 4; ++i) { const int reg = 4 * q + i;
                    { const float gv = (acc0[reg] + Dk * x0[i]) * siluf(z0[i]); acc0[reg] = gv; ss += gv * gv; }
                    { const float gv = (acc1[reg] + Dk * x1[i]) * siluf(z1[i]); acc1[reg] = gv; ss += gv * gv; } } }
            LDS_WAIT(); asm volatile("" ::: "memory");
            ss = xadd32(ss);
            if (lane < 32) ssx[(tpi * 4 + hd) * 32 + r] = ss;
            __syncthreads();
            const LAS float* sp = ssx + tpi * 128 + r;
            const float sst = (sp[0] + sp[32]) + (sp[64] + sp[96]);
            const float rstd = __builtin_amdgcn_rsqf(sst * (1.f / 256.f) + EPS);
#pragma unroll
            for (int q = 0; q < 4; ++q) { const int pb = 8 * q + 4 * hh; const f32x4 n0 = *(const LAS f32x4*)(nwL + pb), n1 = *(const LAS f32x4*)(nwL + 32 + pb);
                *(LAS u32x2*)(xt + r * 68 + pb) = (u32x2){cvtpk(acc0[4 * q] * rstd * n0[0], acc0[4 * q + 1] * rstd * n0[1]), cvtpk(acc0[4 * q + 2] * rstd * n0[2], acc0[4 * q + 3] * rstd * n0[3])};
                *(LAS u32x2*)(xt + r * 68 + 32 + pb) = (u32x2){cvtpk(acc1[4 * q] * rstd * n1[0], acc1[4 * q + 1] * rstd * n1[1]), cvtpk(acc1[4 * q + 2] * rstd * n1[2], acc1[4 * q + 3] * rstd * n1[3])}; }
            LDS_WAIT(); asm volatile("" ::: "memory");
            u32x2 lo[4], hi[4];
#pragma unroll
            for (int k = 0; k < 4; ++k) { const int id = lane + 64 * k, row = id >> 3, oc = id & 7; lo[k] = *(const LAS u32x2*)(xt + row * 68 + oc * 8); hi[k] = *(const LAS u32x2*)(xt + row * 68 + oc * 8 + 4); }
            asm volatile("" : "+v"(lo[0]), "+v"(lo[1]), "+v"(lo[2]), "+v"(lo[3]), "+v"(hi[0]), "+v"(hi[1]), "+v"(hi[2]), "+v"(hi[3]));
#pragma unroll
            for (int k = 0; k < 4; ++k) { const int id = lane + 64 * k, row = id >> 3, oc = id & 7; const size_t pos = (size_t)(c * 256 + l0 + row);
                *(v4u*)(mix + pos * MIXW + 512 + h * 64 + oc * 8) = (v4u){lo[k].x, lo[k].y, hi[k].x, hi[k].y}; }
            LDS_WAIT(); asm volatile("" ::: "memory");
            __syncthreads();
        }
    }
}
struct AttnAcc { f32x16 o0, o1, negm; float l; };
typedef short v4i16_t __attribute__((ext_vector_type(4)));
__device__ __forceinline__ v4i16_t vtr(const LAS bf16* p) { return __builtin_amdgcn_ds_read_tr16_b64_v4i16((LAS v4i16_t*)p); }
struct TileD { int koff, kstride; bool on, mask; };
struct TileR { bf16x8 kf[4]; v4u vv[4]; };
__device__ __forceinline__ void attn_load(TileR& R, const TileD& d, const bf16* Kh, const bf16* Vh, int lane) {
    const int r = lane & 31, hh = lane >> 5;
    int kpa = d.koff + d.kstride * pi32(r); kpa = kpa < 0 ? 0 : (kpa > SEQ - 1 ? SEQ - 1 : kpa);
#pragma unroll
    for (int k = 0; k < 4; ++k) R.kf[k] = *(const bf16x8*)(Kh + (size_t)kpa * 64 + k * 16 + hh * 8);
#pragma unroll
    for (int k = 0; k < 4; ++k) { const int id = lane + 64 * k, key = id >> 3, oc = id & 7; int kp = d.koff + d.kstride * key; kp = kp < 0 ? 0 : (kp > SEQ - 1 ? SEQ - 1 : kp);
        R.vv[k] = *(const v4u*)(Vh + (size_t)kp * 64 + oc * 8); }
}
template <int MASK>
__device__ __forceinline__ void attn_compute(AttnAcc& A, const bf16x8 (&qf)[4], const TileR& R, const TileD& d, int qp, LAS bf16* vt, int lane) {
    const int r = lane & 31, hh = lane >> 5; (void)r;
    const int koff = d.koff, kstride = d.kstride;
#pragma unroll
    for (int k = 0; k < 4; ++k) { const int id = lane + 64 * k, key = id >> 3, oc = id & 7; *(LAS v4u*)(vt + key * 64 + oc * 8) = R.vv[k]; }
    f32x16 X = __builtin_amdgcn_mfma_f32_32x32x16_bf16(R.kf[0], qf[0], A.negm, 0, 0, 0);
#pragma unroll
    for (int k = 1; k < 4; ++k) X = __builtin_amdgcn_mfma_f32_32x32x16_bf16(R.kf[k], qf[k], X, 0, 0, 0);
    if (MASK != 0 && d.mask) {
        const int dq0 = qp - koff; const unsigned lim = (MASK == 1) ? 0x7fffffffu : (unsigned)(128 * kstride);
        if (koff >= 0) {
#pragma unroll
            for (int reg = 0; reg < 16; ++reg) { const int c = pi32((reg & 3) + 8 * (reg >> 2)) ; const unsigned dq = (unsigned)(dq0 - kstride * (c + 8 * hh)); X[reg] = (dq <= lim) ? X[reg] : -INFINITY; }
        } else {
#pragma unroll
            for (int reg = 0; reg < 16; ++reg) { const int c = pi32((reg & 3) + 8 * (reg >> 2)); const int kq = kstride * (c + 8 * hh); const unsigned dq = (unsigned)(dq0 - kq); X[reg] = (dq <= lim && koff + kq >= 0) ? X[reg] : -INFINITY; }
        }
    }
    float ls = 0.f;
#pragma unroll
    for (int reg = 0; reg < 16; ++reg) { X[reg] = __builtin_amdgcn_exp2f(X[reg]); ls += X[reg]; }
    A.l += ls;
    const bf16x8 p0 = pack8(X, 0), p1 = pack8(X, 8);
    LDS_WAIT(); asm volatile("" ::: "memory");
    const LAS bf16* vb = vt + (8 * hh + ((lane & 15) >> 2)) * 64 + 16 * ((lane >> 4) & 1) + 4 * (lane & 3);
#pragma unroll
    for (int dt = 0; dt < 2; ++dt) {
        const v4i16_t a0 = vtr(vb + dt * 32), a1 = vtr(vb + dt * 32 + 4 * 64), a2 = vtr(vb + dt * 32 + 16 * 64), a3 = vtr(vb + dt * 32 + 20 * 64);
        const bf16x8 f0 = (bf16x8){a0[0], a0[1], a0[2], a0[3], a1[0], a1[1], a1[2], a1[3]}, f1 = (bf16x8){a2[0], a2[1], a2[2], a2[3], a3[0], a3[1], a3[2], a3[3]};
        if (dt == 0) { A.o0 = __builtin_amdgcn_mfma_f32_32x32x16_bf16(f0, p0, A.o0, 0, 0, 0); A.o0 = __builtin_amdgcn_mfma_f32_32x32x16_bf16(f1, p1, A.o0, 0, 0, 0); }
        else { A.o1 = __builtin_amdgcn_mfma_f32_32x32x16_bf16(f0, p0, A.o1, 0, 0, 0); A.o1 = __builtin_amdgcn_mfma_f32_32x32x16_bf16(f1, p1, A.o1, 0, 0, 0); }
    }
    LDS_WAIT(); asm volatile("" ::: "memory");
}
template <int MASK, class TF>
__device__ __forceinline__ void attn_run(AttnAcc& A, const bf16x8 (&qf)[4], const bf16* Kh, const bf16* Vh, int qp, LAS bf16* vt, int lane, int ntiles, const TF& tf) {
    TileD d0 = tf(0), d1; TileR R0, R1;
    if (d0.on) attn_load(R0, d0, Kh, Vh, lane);
    for (int n = 0; n < ntiles; n += 2) {
        d1 = (n + 1 < ntiles) ? tf(n + 1) : TileD{0, 1, false, false};
        if (d1.on) attn_load(R1, d1, Kh, Vh, lane);
        if (d0.on) attn_compute<MASK>(A, qf, R0, d0, qp, vt, lane);
        d0 = (n + 2 < ntiles) ? tf(n + 2) : TileD{0, 1, false, false};
        if (d0.on) attn_load(R0, d0, Kh, Vh, lane);
        if (d1.on) attn_compute<MASK>(A, qf, R1, d1, qp, vt, lane);
    }
}
template <int MASK>
__device__ __forceinline__ void attn_run_fast(AttnAcc& A, const bf16x8 (&qf)[4], const bf16* Kh, const bf16* Vh, int qp, LAS bf16* vt, LAS bf16* kt, int lane, int ntiles, int koff0, int kstride, unsigned maskbits) {
    const int r = lane & 31, hh = lane >> 5;
    const size_t rowoff = (size_t)(koff0 + kstride * (lane >> 3)) * 64 + (lane & 7) * 8;
    const bf16* kp = Kh + rowoff; const bf16* vp = Vh + rowoff;
    const int tstep = 32 * kstride * 64, vstep = 8 * kstride * 64;
    v4u kk[4], vv[4];
#pragma unroll
    for (int k = 0; k < 4; ++k) { kk[k] = *(const v4u*)(kp + (size_t)k * vstep); vv[k] = *(const v4u*)(vp + (size_t)k * vstep); }
    const int wrow = lane >> 3, woc = lane & 7;
    const int rho = pi32(r);
    int koff = koff0;
#pragma unroll 1
    for (int n = 0; n < ntiles; ++n) {
        const bool more = (n + 1 < ntiles);
        kp += tstep; vp += tstep;
#pragma unroll
        for (int k = 0; k < 4; ++k) { const int key = wrow + 8 * k; *(LAS v4u*)(kt + key * 64 + ((woc ^ (key & 7)) * 8)) = kk[k]; *(LAS v4u*)(vt + key * 64 + woc * 8) = vv[k]; }
        if (more) {
#pragma unroll
            for (int k = 0; k < 4; ++k) { kk[k] = *(const v4u*)(kp + (size_t)k * vstep); vv[k] = *(const v4u*)(vp + (size_t)k * vstep); } }
        bf16x8 kf[4];
#pragma unroll
        for (int k = 0; k < 4; ++k) kf[k] = *(const LAS bf16x8*)(kt + rho * 64 + (((2 * k + hh) ^ (rho & 7)) * 8));
        f32x16 X = __builtin_amdgcn_mfma_f32_32x32x16_bf16(kf[0], qf[0], A.negm, 0, 0, 0);
#pragma unroll
        for (int k = 1; k < 4; ++k) X = __builtin_amdgcn_mfma_f32_32x32x16_bf16(kf[k], qf[k], X, 0, 0, 0);
        if (MASK != 0 && ((maskbits >> n) & 1u)) {
            const int dq0 = qp - koff; const unsigned lim = (MASK == 1) ? 0x7fffffffu : (unsigned)(128 * kstride);
#pragma unroll
            for (int reg = 0; reg < 16; ++reg) { const int c = pi32((reg & 3) + 8 * (reg >> 2)); const unsigned dq = (unsigned)(dq0 - kstride * (c + 8 * hh)); X[reg] = (dq <= lim) ? X[reg] : -INFINITY; }
        }
        float ls = 0.f;
#pragma unroll
        for (int reg = 0; reg < 16; ++reg) { X[reg] = __builtin_amdgcn_exp2f(X[reg]); ls += X[reg]; }
        A.l += ls;
        const bf16x8 p0 = pack8(X, 0), p1 = pack8(X, 8);
        const LAS bf16* vb = vt + (8 * hh + ((lane & 15) >> 2)) * 64 + 16 * ((lane >> 4) & 1) + 4 * (lane & 3);
#pragma unroll
        for (int dt = 0; dt < 2; ++dt) {
            const v4i16_t a0 = vtr(vb + dt * 32), a1 = vtr(vb + dt * 32 + 4 * 64), a2 = vtr(vb + dt * 32 + 16 * 64), a3 = vtr(vb + dt * 32 + 20 * 64);
            const bf16x8 f0 = (bf16x8){a0[0], a0[1], a0[2], a0[3], a1[0], a1[1], a1[2], a1[3]}, f1 = (bf16x8){a2[0], a2[1], a2[2], a2[3], a3[0], a3[1], a3[2], a3[3]};
            if (dt == 0) { A.o0 = __builtin_amdgcn_mfma_f32_32x32x16_bf16(f0, p0, A.o0, 0, 0, 0); A.o0 = __builtin_amdgcn_mfma_f32_32x32x16_bf16(f1, p1, A.o0, 0, 0, 0); }
            else { A.o1 = __builtin_amdgcn_mfma_f32_32x32x16_bf16(f0, p0, A.o1, 0, 0, 0); A.o1 = __builtin_amdgcn_mfma_f32_32x32x16_bf16(f1, p1, A.o1, 0, 0, 0); }
        }
        koff += 32 * kstride;
    }
}
struct AttnAcc2 { f32x16 o0[2], o1[2]; float l[2], nB; };
template <int MASK>
__device__ __forceinline__ void attn_run_fast2(AttnAcc2& A, const bf16x8 (&qf)[2][4], const bf16* Kh, const bf16* Vh, const int (&qp)[2], LAS bf16* vt, LAS bf16* kt, int lane, int ntiles, int koff0, int kstride,
                                               const unsigned (&skip)[2], const unsigned (&maskb)[2], int n_start = 0) {
    const int r = lane & 31, hh = lane >> 5;
    const size_t rowoff = (size_t)(koff0 + kstride * (32 * n_start + (lane >> 3))) * 64 + (lane & 7) * 8;
    const bf16* kp = Kh + rowoff; const bf16* vp = Vh + rowoff;
    const int tstep = 32 * kstride * 64, vstep = 8 * kstride * 64;
    v4u kk[4], vv[4];
#pragma unroll
    for (int k = 0; k < 4; ++k) { kk[k] = *(const v4u*)(kp + (size_t)k * vstep); vv[k] = *(const v4u*)(vp + (size_t)k * vstep); }
    const int wrow = lane >> 3, woc = lane & 7, rho = pi32(r);
    int koff = koff0 + 32 * kstride * n_start;
#pragma unroll 1
    for (int n = n_start; n < ntiles; ++n) {
        const bool more = (n + 1 < ntiles);
        kp += tstep; vp += tstep;
#pragma unroll
        for (int k = 0; k < 4; ++k) { const int key = wrow + 8 * k; *(LAS v4u*)(kt + key * 64 + ((woc ^ ((key >> 1) & 7)) * 8)) = kk[k]; *(LAS v4u*)(vt + key * 64 + ((woc ^ (4 * ((key >> 1) & 1))) * 8)) = vv[k]; }
        if (more) {
#pragma unroll
            for (int k = 0; k < 4; ++k) { kk[k] = *(const v4u*)(kp + (size_t)k * vstep); vv[k] = *(const v4u*)(vp + (size_t)k * vstep); } }
        bf16x8 kf[4];
#pragma unroll
        for (int k = 0; k < 4; ++k) kf[k] = *(const LAS bf16x8*)(kt + rho * 64 + (((2 * k + hh) ^ ((rho >> 1) & 7)) * 8));
        const LAS bf16* vb = vt + (8 * hh + ((lane & 15) >> 2)) * 64 + ((16 * ((lane >> 4) & 1) + 4 * (lane & 3)) ^ (32 * ((lane >> 3) & 1)));
        bf16x8 vf[2][2];
#pragma unroll
        for (int dt = 0; dt < 2; ++dt) {
            const LAS bf16* vd = dt ? (const LAS bf16*)((unsigned)(size_t)vb ^ 64u) : vb;
            const v4i16_t a0 = vtr(vd), a1 = vtr(vd + 4 * 64), a2 = vtr(vd + 16 * 64), a3 = vtr(vd + 20 * 64);
            vf[dt][0] = (bf16x8){a0[0], a0[1], a0[2], a0[3], a1[0], a1[1], a1[2], a1[3]}; vf[dt][1] = (bf16x8){a2[0], a2[1], a2[2], a2[3], a3[0], a3[1], a3[2], a3[3]};
        }
#pragma unroll
        for (int g = 0; g < 2; ++g) {
            if ((skip[g] >> n) & 1u) continue;
            f32x16 X = __builtin_amdgcn_mfma_f32_32x32x16_bf16(kf[0], qf[g][0], f32x16{}, 0, 0, 0);
#pragma unroll
            for (int k = 1; k < 4; ++k) X = __builtin_amdgcn_mfma_f32_32x32x16_bf16(kf[k], qf[g][k], X, 0, 0, 0);
            if (MASK != 0 && ((maskb[g] >> n) & 1u)) {
                const int dq0 = qp[g] - koff; const unsigned lim = (MASK == 1) ? 0x7fffffffu : (unsigned)(128 * kstride);
#pragma unroll
                for (int reg = 0; reg < 16; ++reg) { const int c = pi32((reg & 3) + 8 * (reg >> 2)); const unsigned dq = (unsigned)(dq0 - kstride * (c + 8 * hh)); X[reg] = (dq <= lim) ? X[reg] : -INFINITY; }
            }
            float ls = 0.f;
#pragma unroll
            for (int reg = 0; reg < 16; ++reg) { X[reg] = __builtin_amdgcn_exp2f(X[reg] + A.nB); ls += X[reg]; }
            A.l[g] += ls;
            const bf16x8 p0 = pack8(X, 0), p1 = pack8(X, 8);
            A.o0[g] = __builtin_amdgcn_mfma_f32_32x32x16_bf16(vf[0][0], p0, A.o0[g], 0, 0, 0); A.o0[g] = __builtin_amdgcn_mfma_f32_32x32x16_bf16(vf[0][1], p1, A.o0[g], 0, 0, 0);
            A.o1[g] = __builtin_amdgcn_mfma_f32_32x32x16_bf16(vf[1][0], p0, A.o1[g], 0, 0, 0); A.o1[g] = __builtin_amdgcn_mfma_f32_32x32x16_bf16(vf[1][1], p1, A.o1[g], 0, 0, 0);
        }
        koff += 32 * kstride;
    }
}
__device__ __forceinline__ void attn_run_lds2(AttnAcc2& A, const bf16x8 (&qf)[2][4], const LAS bf16* ktS, const LAS bf16* vtS, int lane, int ntiles, const unsigned (&skip)[2]) {
    const int r = lane & 31, hh = lane >> 5, rho = pi32(r);
    const LAS bf16* kb = ktS + rho * 64;
    const LAS bf16* vb = vtS + (8 * hh + ((lane & 15) >> 2)) * 64 + ((16 * ((lane >> 4) & 1) + 4 * (lane & 3)) ^ (32 * ((lane >> 3) & 1)));
    f32x16 NB16;
#pragma unroll
    for (int i = 0; i < 16; ++i) NB16[i] = A.nB;
    asm volatile("" : "+v"(NB16));
    const bool both = (skip[1] == 0u);
    auto frags = [&](bf16x8 (&kf)[4], bf16x8 (&vf)[2][2]) {
#pragma unroll
        for (int k = 0; k < 4; ++k) kf[k] = *(const LAS bf16x8*)(kb + (((2 * k + hh) ^ ((rho >> 1) & 7)) * 8));
#pragma unroll
        for (int dt = 0; dt < 2; ++dt) {
            const LAS bf16* vd = dt ? (const LAS bf16*)((unsigned)(size_t)vb ^ 64u) : vb;
            const v4i16_t a0 = vtr(vd), a1 = vtr(vd + 4 * 64), a2 = vtr(vd + 16 * 64), a3 = vtr(vd + 20 * 64);
            vf[dt][0] = (bf16x8){a0[0], a0[1], a0[2], a0[3], a1[0], a1[1], a1[2], a1[3]}; vf[dt][1] = (bf16x8){a2[0], a2[1], a2[2], a2[3], a3[0], a3[1], a3[2], a3[3]};
        }
        kb += 2048; vb += 2048; };
    auto qk = [&](int g, const bf16x8 (&kf)[4]) { f32x16 X = __builtin_amdgcn_mfma_f32_32x32x16_bf16(kf[0], qf[g][0], NB16, 0, 0, 0);
#pragma unroll
        for (int k = 1; k < 4; ++k) X = __builtin_amdgcn_mfma_f32_32x32x16_bf16(kf[k], qf[g][k], X, 0, 0, 0);
        return X; };
    auto soft_pv = [&](int g, f32x16 X, const bf16x8 (&vf)[2][2]) {
#pragma unroll
        for (int reg = 0; reg < 16; ++reg) X[reg] = __builtin_amdgcn_exp2f(X[reg]);
        const v4u w0 = pack8w(X, 0), w1 = pack8w(X, 8);
        float la = A.l[g], lb = 0.f;
        la = dot2ones(w0.x, la); lb = dot2ones(w0.y, lb); la = dot2ones(w0.z, la); lb = dot2ones(w0.w, lb);
        la = dot2ones(w1.x, la); lb = dot2ones(w1.y, lb); la = dot2ones(w1.z, la); lb = dot2ones(w1.w, lb);
        A.l[g] = la + lb;
        bf16x8 p0, p1; __builtin_memcpy(&p0, &w0, 16); __builtin_memcpy(&p1, &w1, 16);
        A.o0[g] = __builtin_amdgcn_mfma_f32_32x32x16_bf16(vf[0][0], p0, A.o0[g], 0, 0, 0); A.o0[g] = __builtin_amdgcn_mfma_f32_32x32x16_bf16(vf[0][1], p1, A.o0[g], 0, 0, 0);
        A.o1[g] = __builtin_amdgcn_mfma_f32_32x32x16_bf16(vf[1][0], p0, A.o1[g], 0, 0, 0); A.o1[g] = __builtin_amdgcn_mfma_f32_32x32x16_bf16(vf[1][1], p1, A.o1[g], 0, 0, 0); };
    if (both) {
#pragma unroll 1
        for (int n = 0; n < ntiles; ++n) {
            bf16x8 kf[4], vf[2][2]; frags(kf, vf);
            const f32x16 X0 = qk(0, kf), X1 = qk(1, kf);
            soft_pv(0, X0, vf); soft_pv(1, X1, vf);
        }
    } else {
#pragma unroll 1
        for (int n = 0; n < ntiles; ++n) {
            bf16x8 kf[4], vf[2][2]; frags(kf, vf);
            if ((skip[0] >> n) & 1u) continue;
            soft_pv(0, qk(0, kf), vf);
        }
    }
}
__device__ __forceinline__ void attn_init2(AttnAcc2& A, float nB) {
#pragma unroll
    for (int g = 0; g < 2; ++g) { A.o0[g] = f32x16{}; A.o1[g] = f32x16{}; A.l[g] = 0.f; }
    A.nB = nB;
}
__device__ __forceinline__ void attn_init(AttnAcc& A, float nB) { A.o0 = f32x16{}; A.o1 = f32x16{};
#pragma unroll
    for (int i = 0; i < 16; ++i) A.negm[i] = nB;
    A.l = 0.f; }
__device__ __forceinline__ float attn_negB(const float* gq, const float* gk, int lane) { return __builtin_bit_cast(float, __builtin_amdgcn_readfirstlane(__builtin_bit_cast(int, -64.0f * C2 * wave_max(fabsf(gq[lane])) * wave_max(fabsf(gk[lane]))))); }
__device__ __forceinline__ void attn_store_rows2(const f32x16& o0, const f32x16& o1, float sc, LAS bf16* ot, bf16* dst0, size_t row_stride, int lane) {
    const int r = lane & 31, hh = lane >> 5;
    typedef unsigned u32x2 __attribute__((ext_vector_type(2)));
#pragma unroll
    for (int q = 0; q < 4; ++q) { const int db = 8 * q + 4 * hh;
        *(LAS u32x2*)(ot + r * 68 + db) = (u32x2){cvtpk(o0[4 * q] * sc, o0[4 * q + 1] * sc), cvtpk(o0[4 * q + 2] * sc, o0[4 * q + 3] * sc)};
        *(LAS u32x2*)(ot + r * 68 + 32 + db) = (u32x2){cvtpk(o1[4 * q] * sc, o1[4 * q + 1] * sc), cvtpk(o1[4 * q + 2] * sc, o1[4 * q + 3] * sc)}; }
    LDS_WAIT(); asm volatile("" ::: "memory");
    u32x2 lo[4], hi[4];
#pragma unroll
    for (int k = 0; k < 4; ++k) { const int id = lane + 64 * k, row = id >> 3, oc = id & 7; lo[k] = *(const LAS u32x2*)(ot + row * 68 + oc * 8); hi[k] = *(const LAS u32x2*)(ot + row * 68 + oc * 8 + 4); }
    asm volatile("" : "+v"(lo[0]), "+v"(lo[1]), "+v"(lo[2]), "+v"(lo[3]), "+v"(hi[0]), "+v"(hi[1]), "+v"(hi[2]), "+v"(hi[3]));
#pragma unroll
    for (int k = 0; k < 4; ++k) { const int id = lane + 64 * k, row = id >> 3, oc = id & 7;
        *(v4u*)(dst0 + (size_t)row * row_stride + oc * 8) = (v4u){lo[k].x, lo[k].y, hi[k].x, hi[k].y}; }
    LDS_WAIT(); asm volatile("" ::: "memory");
}
__device__ __forceinline__ void attn_store_rows(const AttnAcc& A, float sc, LAS bf16* ot, bf16* dst0, size_t row_stride, int lane) { attn_store_rows2(A.o0, A.o1, sc, ot, dst0, row_stride, lane); }
__device__ __forceinline__ void swa_pass(const Args& a, int L, LAS unsigned char* lds, int lane, int wave, int G) {
    unsigned char* ws = wsp(a);
    const float nB = attn_negB(inp(a, I_QNS) + L * HD, inp(a, I_KNS) + L * HD, lane);
    const int h = (int)bidx() & 7, slot = ((int)bidx() >> 3) * NWAVES + wave, nslots = (G >> 3) * NWAVES;
    const bf16* Q = (const bf16*)(ws + WS_QKV) + (size_t)(0 * 8 + h) * SEQ * 64; const bf16* K = (const bf16*)(ws + WS_QKV) + (size_t)(1 * 8 + h) * SEQ * 64;
    const bf16* V = (const bf16*)(ws + WS_QKV) + (size_t)(2 * 8 + h) * SEQ * 64;
    bf16* mix = (bf16*)(ws + WS_MIX); float* SL = (float*)(ws + WS_PS) + (size_t)SEQ * 8 * 3;
    LAS bf16* vt = (LAS bf16*)(lds + wave * 12800); LAS bf16* kt = (LAS bf16*)(lds + wave * 12800 + 4096); LAS bf16* ot = (LAS bf16*)(lds + wave * 12800 + 8192);
    const int r = lane & 31, hh = lane >> 5;
    bf16x8 qn[2][4];
    auto qload = [&](int uu_) { const int br_ = uu_ >> 8, tt_ = uu_ & 255, dsh_ = 2 * br_, d_ = 1 << dsh_, rr_ = tt_ & (d_ - 1), u0_ = 64 * (tt_ >> dsh_);
#pragma unroll
        for (int g = 0; g < 2; ++g) { const int qp_ = rr_ + d_ * (u0_ + 32 * g + r);
#pragma unroll
            for (int k = 0; k < 4; ++k) qn[g][k] = *(const bf16x8*)(Q + (size_t)qp_ * 64 + k * 16 + hh * 8); } };
    if (slot < 768) qload(slot);
    for (int uu = slot; uu < 768; uu += nslots) {
        const int br = uu >> 8, tt = uu & 255, dsh = 2 * br, d = 1 << dsh, rr = tt & (d - 1), u0 = 64 * (tt >> dsh);
        bf16x8 qf[2][4]; int qp[2];
#pragma unroll
        for (int g = 0; g < 2; ++g) { qp[g] = rr + d * (u0 + 32 * g + r);
#pragma unroll
            for (int k = 0; k < 4; ++k) qf[g][k] = qn[g][k]; }
        AttnAcc2 A; attn_init2(A, nB);
        const unsigned sk[2] = {0x20u, 0x01u}, mk[2] = {0x11u, 0x22u};
        const int nst = (u0 >= 128) ? 0 : (128 - u0) >> 5;
        attn_run_fast2<2>(A, qf, K, V, qp, vt, kt, lane, 6, rr + d * (u0 - 128), d, sk, mk, nst);
        if (uu + nslots < 768) qload(uu + nslots);
        asm volatile("" ::: "memory");
#pragma unroll
        for (int g = 0; g < 2; ++g) {
            const float lt = xadd32(A.l[g]);
            if (hh == 0) SL[((size_t)qp[g] * 8 + h) * 3 + br] = lt;
            { int lane2 = lane; asm volatile("" : "+v"(lane2));
              attn_store_rows2(A.o0[g], A.o1[g], 1.0f, ot, mix + (size_t)(rr + d * (u0 + 32 * g)) * MIXW + br * 512 + h * 64, (size_t)d * MIXW, lane2); }
        }
    }
}
__device__ __forceinline__ void swa_merge(unsigned char* ws, int tid, int G) {
    bf16* mix = (bf16*)(ws + WS_MIX); const float* SL = (const float*)(ws + WS_PS) + (size_t)SEQ * 8 * 3;
    for (int idx = bidx() * 512 + tid; idx < SEQ * 64; idx += G * 512) {
        const int q = idx >> 6, h = (idx >> 3) & 7, oc = idx & 7;
        bf16* p = mix + (size_t)q * MIXW + h * 64 + oc * 8;
        float o0[8], o1[8], o2[8]; unpack8(*(const v4u*)p, o0); unpack8(*(const v4u*)(p + 512), o1); unpack8(*(const v4u*)(p + 1024), o2);
        const float* sl = SL + ((size_t)q * 8 + h) * 3; const float inv = 1.0f / (sl[0] + sl[1] + sl[2]);
        float o[8];
#pragma unroll
        for (int i = 0; i < 8; ++i) o[i] = ((o0[i] + o1[i]) + o2[i]) * inv;
        v4u w; w.x = pk2(o[0], o[1]); w.y = pk2(o[2], o[3]); w.z = pk2(o[4], o[5]); w.w = pk2(o[6], o[7]);
        *(v4u*)p = w;
    }
}
__device__ __forceinline__ void top3_insert(float g, int n, float& v0, float& v1, float& v2, int& i0, int& i1, int& i2) {
    const bool c0 = g > v0, c1 = g > v1, c2 = g > v2;
    const float nv2 = c1 ? v1 : (c2 ? g : v2); const int ni2 = c1 ? i1 : (c2 ? n : i2);
    const float nv1 = c0 ? v0 : (c1 ? g : v1); const int ni1 = c0 ? i0 : (c1 ? n : i1);
    v0 = c0 ? g : v0; i0 = c0 ? n : i0; v1 = nv1; i1 = ni1; v2 = nv2; i2 = ni2;
}
__device__ __forceinline__ void gate_group(const LAS bf16* kmL, const bf16* Q, int tq, int qb, int r, int hh, int& o0, int& o1, int& o2) {
    bf16x8 qf[4];
#pragma unroll
    for (int k = 0; k < 4; ++k) qf[k] = *(const bf16x8*)(Q + (size_t)(tq + r) * 64 + k * 16 + hh * 8);
    float v0 = -INFINITY, v1 = -INFINITY, v2 = -INFINITY; int i0 = 0, i1 = 0, i2 = 0;
#pragma unroll
    for (int nt = 0; nt < 2; ++nt) {
        f32x16 X = f32x16{};
#pragma unroll
        for (int k = 0; k < 4; ++k) X = __builtin_amdgcn_mfma_f32_32x32x16_bf16(*(const LAS bf16x8*)(kmL + (nt * 32 + r) * 72 + k * 16 + hh * 8), qf[k], X, 0, 0, 0);
#pragma unroll
        for (int reg = 0; reg < 16; ++reg) { const int n = nt * 32 + (reg & 3) + 8 * (reg >> 2) + 4 * hh; top3_insert((n < qb) ? X[reg] : -INFINITY, n, v0, v1, v2, i0, i1, i2); }
    }
    float pa = v0, pb = v0, qa = v1, qb2 = v1, ra = v2, rb = v2; swap32(pa, pb); swap32(qa, qb2); swap32(ra, rb);
    float ia = __builtin_bit_cast(float, i0), ib = ia, ja = __builtin_bit_cast(float, i1), jb = ja, ka = __builtin_bit_cast(float, i2), kb = ka; swap32(ia, ib); swap32(ja, jb); swap32(ka, kb);
    const float ov0 = hh ? pa : pb, ov1 = hh ? qa : qb2, ov2 = hh ? ra : rb;
    const int oi0 = __builtin_bit_cast(int, hh ? ia : ib), oi1 = __builtin_bit_cast(int, hh ? ja : jb), oi2 = __builtin_bit_cast(int, hh ? ka : kb);
    top3_insert(ov0, oi0, v0, v1, v2, i0, i1, i2); top3_insert(ov1, oi1, v0, v1, v2, i0, i1, i2); top3_insert(ov2, oi2, v0, v1, v2, i0, i1, i2);
    o0 = i0; o1 = i1; o2 = i2;
}
__device__ __forceinline__ void moba_gate(const Args& a, int L, LAS unsigned char* lds, int tid, int G) {
    unsigned char* ws = wsp(a);
    const float* km = (const float*)(ws + WS_KMEAN); unsigned short* list = (unsigned short*)(ws + WS_LIST);
    unsigned* cnt = (unsigned*)(ws + WS_CTL) + CW_CNT + L * 512;
    LAS bf16* kmL = (LAS bf16*)lds;
    const int lane = tid & 63, wave = tid >> 6, r = lane & 31, hh = lane >> 5;
    for (int unit = bidx(); unit < 256; unit += G) {
        const int h = unit & 7, qc = unit >> 3, t0 = 512 * qc + 64 * wave, qb = t0 >> 8;
        __syncthreads();
        for (int i = tid; i < 1024; i += 512) { const f32x4 kv = (*(const f32x4*)(km + h * 4096 + 4 * i) + *(const f32x4*)(km + (8 + h) * 4096 + 4 * i)) * (1.0f / 256.0f);
            const int n = i >> 4, d4 = (i & 15) * 4; typedef unsigned u32x2 __attribute__((ext_vector_type(2)));
            *(LAS u32x2*)(kmL + n * 72 + d4) = (u32x2){pk2(kv.x, kv.y), pk2(kv.z, kv.w)}; }
        __syncthreads();
        const bf16* Q = (const bf16*)(ws + WS_QKV) + (size_t)(3 * 8 + h) * SEQ * 64;
        int a0, a1, a2, b0, b1, b2;
        gate_group(kmL, Q, t0, qb, r, hh, a0, a1, a2);
        gate_group(kmL, Q, t0 + 32, qb, r, hh, b0, b1, b2);
        const int nsel = qb < 3 ? qb : 3;
        LAS unsigned* hist = (LAS unsigned*)(lds + 16384); LAS unsigned* baseL = hist + 64;
        if (tid < 64) hist[tid] = 0u;
        __syncthreads();
        const int t = t0 + 32 * hh + r;
        const int j0 = hh ? b0 : a0, j1 = hh ? b1 : a1, j2 = hh ? b2 : a2;
        unsigned s0 = 0, s1 = 0, s2 = 0;
        if (nsel > 0) s0 = __hip_atomic_fetch_add(hist + j0, 1u, __ATOMIC_RELAXED, __HIP_MEMORY_SCOPE_WORKGROUP);
        if (nsel > 1) s1 = __hip_atomic_fetch_add(hist + j1, 1u, __ATOMIC_RELAXED, __HIP_MEMORY_SCOPE_WORKGROUP);
        if (nsel > 2) s2 = __hip_atomic_fetch_add(hist + j2, 1u, __ATOMIC_RELAXED, __HIP_MEMORY_SCOPE_WORKGROUP);
        __syncthreads();
        if (tid < 64) { const unsigned n = hist[tid]; baseL[tid] = n ? atomicAdd(cnt + h * 64 + tid, n) : 0u; }
        __syncthreads();
        if (nsel > 0) list[(size_t)(h * 64 + j0) * SEQ + baseL[j0] + s0] = (unsigned short)(t | (0 << 14));
        if (nsel > 1) list[(size_t)(h * 64 + j1) * SEQ + baseL[j1] + s1] = (unsigned short)(t | (1 << 14));
        if (nsel > 2) list[(size_t)(h * 64 + j2) * SEQ + baseL[j2] + s2] = (unsigned short)(t | (2 << 14));
    }
}
__device__ __forceinline__ void moba_bucket(const Args& a, int L, LAS unsigned char* lds, int tid, int lane, int wave, int G) {
    unsigned char* ws = wsp(a);
    const float nB = attn_negB(inp(a, I_QNM) + L * HD, inp(a, I_KNM) + L * HD, lane);
    const unsigned* cnt = (const unsigned*)(ws + WS_CTL) + CW_CNT + L * 512; const unsigned short* list = (const unsigned short*)(ws + WS_LIST);
    bf16* PO = (bf16*)(ws + WS_PO); float* PS = (float*)(ws + WS_PS);
    LAS int* pre = (LAS int*)(lds + 104 * 1024);
    LAS int* wsum = pre + 520;
    {
        const int n = (int)((__hip_atomic_load(cnt + tid, __ATOMIC_RELAXED, __HIP_MEMORY_SCOPE_AGENT) + 63u) >> 6);
        int inc = n;
#pragma unroll
        for (int o = 1; o < 64; o <<= 1) { const int t = __builtin_amdgcn_ds_bpermute(((lane - o) & 63) << 2, inc); if (lane >= o) inc += t;     }
        if (lane == 63) wsum[wave] = inc;
        __syncthreads();
        int base = 0;
#pragma unroll
        for (int w8 = 0; w8 < 8; ++w8) base += (w8 < wave) ? wsum[w8] : 0;
        pre[tid] = base + inc - n;
        if (tid == 511) pre[512] = base + inc;
        __syncthreads();
    }
    const int T = pre[512];
    LAS bf16* vt = (LAS bf16*)(lds + wave * 12800); LAS bf16* kt = (LAS bf16*)(lds + wave * 12800 + 4096); LAS bf16* ot = (LAS bf16*)(lds + wave * 12800 + 8192);
    const int r = lane & 31, hh = lane >> 5;
    typedef unsigned u32x2 __attribute__((ext_vector_type(2)));
    for (int ti = (int)bidx() * NWAVES + wave; ti < T; ti += G * NWAVES) {
        int lo = 0, hi = 512;
        while (hi - lo > 1) { const int mid = (lo + hi) >> 1; if (pre[mid] <= ti) lo = mid; else hi = mid; }
        const int bkt = lo, tq = ti - pre[bkt], h = bkt >> 6, j = bkt & 63;
        const int n = (int)__hip_atomic_load(cnt + bkt, __ATOMIC_RELAXED, __HIP_MEMORY_SCOPE_AGENT);
        const bf16* Q = (const bf16*)(ws + WS_QKV) + (size_t)(3 * 8 + h) * SEQ * 64; const bf16* K = (const bf16*)(ws + WS_QKV) + (size_t)(4 * 8 + h) * SEQ * 64;
        const bf16* V = (const bf16*)(ws + WS_QKV) + (size_t)(5 * 8 + h) * SEQ * 64;
        bool okr[2]; size_t slot[2]; bf16x8 qf[2][4];
#pragma unroll
        for (int g = 0; g < 2; ++g) {
            okr[g] = (64 * tq + 32 * g + r) < n;
            const unsigned e = okr[g] ? (unsigned)list[(size_t)bkt * SEQ + 64 * tq + 32 * g + r] : 0u;
            const int t = (int)(e & 16383u), ks = (int)(e >> 14);
            slot[g] = ((size_t)t * 8 + h) * 3 + ks;
#pragma unroll
            for (int k = 0; k < 4; ++k) qf[g][k] = *(const bf16x8*)(Q + (size_t)t * 64 + k * 16 + hh * 8);
        }
        AttnAcc2 A; attn_init2(A, nB);
        const int qpd[2] = {0, 0}; const unsigned sk[2] = {0u, (64 * tq + 32 < n) ? 0u : 0xffu}, mk[2] = {0u, 0u};
        attn_run_fast2<0>(A, qf, K, V, qpd, vt, kt, lane, 8, 256 * j, 1, sk, mk);
#pragma unroll
        for (int g = 0; g < 2; ++g) {
            if (g == 1 && !(64 * tq + 32 < n)) break;
            const float lt = xadd32(A.l[g]), sc = 1.0f / lt;
#pragma unroll
            for (int q = 0; q < 4; ++q) { const int db = 8 * q + 4 * hh;
                    *(LAS u32x2*)(ot + r * 68 + db) = (u32x2){cvtpk(A.o0[g][4 * q] * sc, A.o0[g][4 * q + 1] * sc), cvtpk(A.o0[g][4 * q + 2] * sc, A.o0[g][4 * q + 3] * sc)};
                    *(LAS u32x2*)(ot + r * 68 + 32 + db) = (u32x2){cvtpk(A.o1[g][4 * q] * sc, A.o1[g][4 * q + 1] * sc), cvtpk(A.o1[g][4 * q + 2] * sc, A.o1[g][4 * q + 3] * sc)}; }
            if (okr[g] && hh == 0) PS[slot[g]] = lt;
            LDS_WAIT(); asm volatile("" ::: "memory");
#pragma unroll
            for (int k = 0; k < 4; ++k) { const int id = lane + 64 * k, row = id >> 3, oc = id & 7;
                const unsigned slo = (unsigned)__builtin_amdgcn_ds_bpermute(row << 2, (int)(unsigned)slot[g]), shi = (unsigned)__builtin_amdgcn_ds_bpermute(row << 2, (int)(unsigned)(slot[g] >> 32));
                const unsigned long long srow = ((unsigned long long)shi << 32) | slo;
                const int okrow = __builtin_amdgcn_ds_bpermute(row << 2, (int)okr[g]);
                const u32x2 lo2 = *(const LAS u32x2*)(ot + row * 68 + oc * 8), hi2 = *(const LAS u32x2*)(ot + row * 68 + oc * 8 + 4);
                if (okrow) *(v4u*)(PO + (size_t)srow * 64 + oc * 8) = (v4u){lo2.x, lo2.y, hi2.x, hi2.y}; }
            LDS_WAIT(); asm volatile("" ::: "memory");
        }
    }
}
__device__ __forceinline__ void moba_bucket_wg(const Args& a, int L, LAS unsigned char* lds, int tid, int lane, int wave, int G) {
    unsigned char* ws = wsp(a);
    const float nB = attn_negB(inp(a, I_QNM) + L * HD, inp(a, I_KNM) + L * HD, lane);
    const unsigned* cnt = (const unsigned*)(ws + WS_CTL) + CW_CNT + L * 512; const unsigned short* list = (const unsigned short*)(ws + WS_LIST);
    bf16* PO = (bf16*)(ws + WS_PO); float* PS = (float*)(ws + WS_PS);
    LAS int* pre = (LAS int*)(lds + 104 * 1024);
    LAS int* wsum = pre + 520;
    {
        const int n = (int)((((__hip_atomic_load(cnt + tid, __ATOMIC_RELAXED, __HIP_MEMORY_SCOPE_AGENT) + 63u) >> 6) + 7u) >> 3);
        int inc = n;
#pragma unroll
        for (int o = 1; o < 64; o <<= 1) { const int t = __builtin_amdgcn_ds_bpermute(((lane - o) & 63) << 2, inc); if (lane >= o) inc += t;     }
        if (lane == 63) wsum[wave] = inc;
        __syncthreads();
        int base = 0;
#pragma unroll
        for (int w8 = 0; w8 < 8; ++w8) base += (w8 < wave) ? wsum[w8] : 0;
        pre[tid] = base + inc - n;
        if (tid == 511) pre[512] = base + inc;
        __syncthreads();
    }
    const int T = pre[512];
    LAS bf16* ktS = (LAS bf16*)lds; LAS bf16* vtS = (LAS bf16*)(lds + 32768); LAS bf16* ot = (LAS bf16*)(lds + 65536 + wave * 4608);
    const int r = lane & 31, hh = lane >> 5;
    typedef unsigned u32x2 __attribute__((ext_vector_type(2)));
    const int lrow = tid >> 3, loc = tid & 7, lkey = lrow & 31;
    LAS bf16* kw = ktS + (lrow >> 5) * 2048 + lkey * 64 + ((loc ^ ((lkey >> 1) & 7)) * 8); LAS bf16* vw = vtS + (lrow >> 5) * 2048 + lkey * 64 + ((loc ^ (4 * ((lkey >> 1) & 1))) * 8);
    v4u kr[4], vr[4];
    int it = (int)bidx();
    auto find = [&](int item, int& bkt, int& grp) { int lo = 0, hi = 512; while (hi - lo > 1) { const int mid = (lo + hi) >> 1; if (pre[mid] <= item) lo = mid; else hi = mid; }
        bkt = __builtin_amdgcn_readfirstlane(lo); grp = __builtin_amdgcn_readfirstlane(item - pre[lo]); };
    auto fetch = [&](int bkt) { const int h = bkt >> 6, j = bkt & 63;
        const bf16* Kb = (const bf16*)(ws + WS_QKV) + ((size_t)(4 * 8 + h) * SEQ + 256 * j) * 64 + (size_t)lrow * 64 + loc * 8; const bf16* Vb = Kb + (size_t)8 * SEQ * 64;
#pragma unroll
        for (int i = 0; i < 4; ++i) { kr[i] = *(const v4u*)(Kb + (size_t)i * 64 * 64); vr[i] = *(const v4u*)(Vb + (size_t)i * 64 * 64); } };
    int bkt = 0, grp = 0;
    if (it < T) { find(it, bkt, grp); fetch(bkt); }
    while (it < T) {
        __syncthreads();
#pragma unroll
        for (int i = 0; i < 4; ++i) { *(LAS v4u*)(kw + i * 4096) = kr[i]; *(LAS v4u*)(vw + i * 4096) = vr[i]; }
        __syncthreads();
        const int cb = bkt, cg = grp;
        it += G;
        if (it < T) { find(it, bkt, grp); fetch(bkt); }
        const int h = cb >> 6, tq = 8 * cg + wave;
        const int n = (int)__hip_atomic_load(cnt + cb, __ATOMIC_RELAXED, __HIP_MEMORY_SCOPE_AGENT);
        if (64 * tq < n) {
            const bf16* Q = (const bf16*)(ws + WS_QKV) + (size_t)(3 * 8 + h) * SEQ * 64;
            bool okr[2]; size_t slot[2]; bf16x8 qf[2][4];
#pragma unroll
            for (int g = 0; g < 2; ++g) {
                okr[g] = (64 * tq + 32 * g + r) < n;
                const unsigned e = okr[g] ? (unsigned)list[(size_t)cb * SEQ + 64 * tq + 32 * g + r] : 0u;
                const int t = (int)(e & 16383u), ks = (int)(e >> 14);
                slot[g] = ((size_t)t * 8 + h) * 3 + ks;
#pragma unroll
                for (int k = 0; k < 4; ++k) qf[g][k] = *(const bf16x8*)(Q + (size_t)t * 64 + k * 16 + hh * 8);
            }
            AttnAcc2 A; attn_init2(A, nB);
            const unsigned sk[2] = {0u, (64 * tq + 32 < n) ? 0u : 0xffu};
            attn_run_lds2(A, qf, ktS, vtS, lane, 8, sk);
#pragma unroll
            for (int g = 0; g < 2; ++g) {
                if (g == 1 && !(64 * tq + 32 < n)) break;
                const float lt = xadd32(A.l[g]), sc = 1.0f / lt;
#pragma unroll
                for (int q = 0; q < 4; ++q) { const int db = 8 * q + 4 * hh;
                    *(LAS u32x2*)(ot + r * 68 + db) = (u32x2){cvtpk(A.o0[g][4 * q] * sc, A.o0[g][4 * q + 1] * sc), cvtpk(A.o0[g][4 * q + 2] * sc, A.o0[g][4 * q + 3] * sc)};
                    *(LAS u32x2*)(ot + r * 68 + 32 + db) = (u32x2){cvtpk(A.o1[g][4 * q] * sc, A.o1[g][4 * q + 1] * sc), cvtpk(A.o1[g][4 * q + 2] * sc, A.o1[g][4 * q + 3] * sc)}; }
                if (okr[g] && hh == 0) PS[slot[g]] = lt;
                LDS_WAIT(); asm volatile("" ::: "memory");
                {
                    const int sv = (int)((unsigned)slot[g] | (okr[g] ? 0x80000000u : 0u));
                    int sr[4]; u32x2 lo2[4], hi2[4];
#pragma unroll
                    for (int k = 0; k < 4; ++k) { const int id = lane + 64 * k, row = id >> 3, oc = id & 7;
                        sr[k] = __builtin_amdgcn_ds_bpermute(row << 2, sv);
                        lo2[k] = *(const LAS u32x2*)(ot + row * 68 + oc * 8); hi2[k] = *(const LAS u32x2*)(ot + row * 68 + oc * 8 + 4); }
                    asm volatile("" : "+v"(sr[0]), "+v"(sr[1]), "+v"(sr[2]), "+v"(sr[3]), "+v"(lo2[0]), "+v"(lo2[1]), "+v"(lo2[2]), "+v"(lo2[3]), "+v"(hi2[0]), "+v"(hi2[1]), "+v"(hi2[2]), "+v"(hi2[3]));
#pragma unroll
                    for (int k = 0; k < 4; ++k) { const int oc = (lane + 64 * k) & 7;
                        if (sr[k] < 0) *(v4u*)(PO + (size_t)(sr[k] & 0x7fffffff) * 64 + oc * 8) = (v4u){lo2[k].x, lo2[k].y, hi2[k].x, hi2[k].y}; }
                }
                LDS_WAIT(); asm volatile("" ::: "memory");
            }
        }
    }
}
__device__ __forceinline__ void moba_final(const Args& a, int L, LAS unsigned char* lds, int lane, int wave, int G) {
    unsigned char* ws = wsp(a);
    const float nB = attn_negB(inp(a, I_QNM) + L * HD, inp(a, I_KNM) + L * HD, lane);
    const int h = (int)bidx() & 7, slot0 = ((int)bidx() >> 3) * NWAVES + wave, nslots = (G >> 3) * NWAVES;
    const bf16* Q = (const bf16*)(ws + WS_QKV) + (size_t)(3 * 8 + h) * SEQ * 64; const bf16* K = (const bf16*)(ws + WS_QKV) + (size_t)(4 * 8 + h) * SEQ * 64;
    const bf16* V = (const bf16*)(ws + WS_QKV) + (size_t)(5 * 8 + h) * SEQ * 64;
    const bf16* PO = (const bf16*)(ws + WS_PO); const float* PS = (const float*)(ws + WS_PS);
    bf16* mix = (bf16*)(ws + WS_MIX);
    LAS bf16* vt = (LAS bf16*)(lds + wave * 12800); LAS bf16* kt = (LAS bf16*)(lds + wave * 12800 + 4096); LAS bf16* ot = (LAS bf16*)(lds + wave * 12800 + 8192);
    const int r = lane & 31, hh = lane >> 5;
    typedef unsigned u32x2 __attribute__((ext_vector_type(2)));
    for (int uu = slot0; uu < 256; uu += nslots) {
        const int t0 = 64 * uu, qb = t0 >> 8, nsel = qb < 3 ? qb : 3;
        bf16x8 qf[2][4]; int qp[2];
#pragma unroll
        for (int g = 0; g < 2; ++g) { qp[g] = t0 + 32 * g + r;
#pragma unroll
            for (int k = 0; k < 4; ++k) qf[g][k] = *(const bf16x8*)(Q + (size_t)qp[g] * 64 + k * 16 + hh * 8); }
        AttnAcc2 A; attn_init2(A, nB);
        const int ntile = ((t0 & 255) >> 5) + 2;
        const unsigned sk[2] = {1u << (ntile - 1), 0u}, mk[2] = {1u << (ntile - 2), 1u << (ntile - 1)};
        attn_run_fast2<1>(A, qf, K, V, qp, vt, kt, lane, ntile, 256 * qb, 1, sk, mk);
        v4u pn[4]; float wn = 0.f;
        auto req = [&](int g, int k) {
            wn = PS[((size_t)qp[g] * 8 + h) * 3 + k];
#pragma unroll
            for (int kk2 = 0; kk2 < 4; ++kk2) { const int id = lane + 64 * kk2, row = id >> 3, oc = id & 7;
                pn[kk2] = *(const v4u*)(PO + (((size_t)(t0 + 32 * g + row) * 8 + h) * 3 + k) * 64 + oc * 8); } };
        if (nsel > 0) req(0, 0);
#pragma unroll
        for (int g = 0; g < 2; ++g) {
            float lt = xadd32(A.l[g]);
#pragma unroll
            for (int k = 0; k < 3; ++k) {
                if (k < nsel) {
                    const float wk = wn; lt += wk;
#pragma unroll
                    for (int kk2 = 0; kk2 < 4; ++kk2) { const int id = lane + 64 * kk2, row = id >> 3, oc = id & 7;
                        const v4u p4 = pn[kk2];
                        *(LAS u32x2*)(ot + row * 68 + oc * 8) = (u32x2){p4.x, p4.y}; *(LAS u32x2*)(ot + row * 68 + oc * 8 + 4) = (u32x2){p4.z, p4.w}; }
                    if (k + 1 < nsel) req(g, k + 1); else if (g == 0) req(1, 0);
                    LDS_WAIT(); asm volatile("" ::: "memory");
#pragma unroll
                    for (int q = 0; q < 4; ++q) { const int db = 8 * q + 4 * hh; const u32x2 pa = *(const LAS u32x2*)(ot + r * 68 + db), pb = *(const LAS u32x2*)(ot + r * 68 + 32 + db);
                        A.o0[g][4 * q] += wk * bflo(pa.x); A.o0[g][4 * q + 1] += wk * bfhi(pa.x); A.o0[g][4 * q + 2] += wk * bflo(pa.y); A.o0[g][4 * q + 3] += wk * bfhi(pa.y);
                        A.o1[g][4 * q] += wk * bflo(pb.x); A.o1[g][4 * q + 1] += wk * bfhi(pb.x); A.o1[g][4 * q + 2] += wk * bflo(pb.y); A.o1[g][4 * q + 3] += wk * bfhi(pb.y); }
                    LDS_WAIT(); asm volatile("" ::: "memory");
                }
            }
            attn_store_rows2(A.o0[g], A.o1[g], 1.0f / lt, ot, mix + (size_t)(t0 + 32 * g) * MIXW + 1024 + h * 64, (size_t)MIXW, lane);
        }
    }
}
__device__ __forceinline__ void mixer_phase(const Args& a, int L, LAS unsigned char* lds, int tid, int lane, int wave, int G) {
    if (!FLG(a, 16)) ssd_states(wsp(a), (const unsigned char*)outp(a), lane, (int)bidx() * NWAVES + wave, G * NWAVES);
    if (!FLG(a, 1)) moba_gate(a, L, lds, tid, G);
    __syncthreads();
    if (!FLG(a, 32)) swa_pass(a, L, lds, lane, wave, G);
}

#ifdef TSPROBE
#define TSP_LASTBAR 1
#else
#define TSP_LASTBAR 0
#endif
__global__ void __launch_bounds__(NWAVES * 64, 2) mk_fwd(Args args) {
    extern __shared__ __attribute__((aligned(16))) unsigned char lds_raw[];
    LAS unsigned char* lds_k = (LAS unsigned char*)lds_raw;
    volatile LAS unsigned* MISC = (volatile LAS unsigned*)(lds_k + MISC_OFF);
    const int G_k = gridDim.x, wave0 = __builtin_amdgcn_readfirstlane(threadIdx.x >> 6);
    gu32* ctl = (gu32*)(wsp(args) + WS_CTL);
    for (int u = threadIdx.x; u < (LDS_BYTES - LDSCTL_OFF) / 4; u += NWAVES * 64) ((LAS unsigned*)(lds_k + LDSCTL_OFF))[u] = 0u;
    __syncthreads();
    XcdBarrier bar; bar.bar = (unsigned*)(ctl + CW_BAR); bar.x = 0; bar.st = nullptr; bar.wave = 1;
    const bool fused = (args.ph_hi - args.ph_lo) > 1;
    if (fused) bar = xcd_barrier_post((unsigned*)(ctl + CW_BAR), MISC + 8);
    bar.wave = wave0;
    if (threadIdx.x == 0) MISC[10] = bar.x;
    __syncthreads();
#ifdef TSPROBE
    unsigned long long* tsb = (unsigned long long*)(wsp(args) + WS_CTL + 448 * 1024);
    if (bidx() == 0 && threadIdx.x == 0) tsb[63] = __builtin_amdgcn_s_memrealtime();
#define TSTAMP(i) do { if (bidx() == 0 && wave0 == 0 && (int)__builtin_amdgcn_mbcnt_hi(~0u, __builtin_amdgcn_mbcnt_lo(~0u, opq0())) == 0) tsb[i] = __builtin_amdgcn_s_memrealtime(); } while (0)
#else
#define TSTAMP(i) do {} while (0)
#endif
    int ph0 = args.ph_lo;
    if (ph0 == 0) {
        { int lane = (int)__builtin_amdgcn_mbcnt_hi(~0u, __builtin_amdgcn_mbcnt_lo(~0u, opq0())); asm volatile("" : "+v"(lane)); p0_prologue(args, lds_k, wave0 * 64 + lane, lane, wave0, G_k); }
        if (1 < args.ph_hi) { XcdBarrier b2; b2.bar = (unsigned*)((gu32*)(wsp(args) + WS_CTL) + CW_BAR); b2.wave = wave0; asm volatile("" : "+s"(b2.wave)); b2.x = (unsigned)__builtin_amdgcn_readfirstlane((int)*(volatile LAS unsigned*)(lds_k + MISC_OFF + 40)); { int mo_ = MISC_OFF + 32; asm volatile("" : "+s"(mo_)); b2.st = (volatile LAS unsigned*)(lds_k + mo_); } xcd_barrier(b2); }
        TSTAMP(0);
        ph0 = 1;
    }
    if (ph0 == 1 && ph0 < args.ph_hi) {
        { int lane = (int)__builtin_amdgcn_mbcnt_hi(~0u, __builtin_amdgcn_mbcnt_lo(~0u, opq0())); asm volatile("" : "+v"(lane)); p0_weights(args, lds_k, lane, wave0, G_k); }
        if (2 < args.ph_hi) { XcdBarrier b2; b2.bar = (unsigned*)((gu32*)(wsp(args) + WS_CTL) + CW_BAR); b2.wave = wave0; asm volatile("" : "+s"(b2.wave)); b2.x = (unsigned)__builtin_amdgcn_readfirstlane((int)*(volatile LAS unsigned*)(lds_k + MISC_OFF + 40)); { int mo_ = MISC_OFF + 32; asm volatile("" : "+s"(mo_)); b2.st = (volatile LAS unsigned*)(lds_k + mo_); } xcd_barrier(b2); }
        TSTAMP(1);
        ph0 = 2;
    }
#define PHW() ({ int w_ = wave0; asm volatile("" : "+s"(w_)); (volatile LAS int*)(lds_k + MISC_OFF + 64) + w_; })
    *PHW() = ph0;
    for (;;) {
        const int ph = __builtin_amdgcn_readfirstlane(*PHW());
        if (ph >= args.ph_hi || FLG(args, 2)) break;
        LAS unsigned char* lds = lds_k; int G = G_k; asm volatile("" : "+s"(lds), "+s"(G));
        unsigned char* ws = wsp(args);
        bf16* hb = (bf16*)(ws + WS_H);
#define LANE_TID() int lane = (int)__builtin_amdgcn_mbcnt_hi(~0u, __builtin_amdgcn_mbcnt_lo(~0u, opq0())); asm volatile("" : "+v"(lane)); int wave_ = wave0; asm volatile("" : "+s"(wave_)); const int wave = wave_, tid = wave * 64 + lane; (void)tid
#define MD() ((const float*)(wsp(args) + WS_MOD) + L * 6144)
#define CTLF() ((float*)(wsp(args) + WS_CTL))
        {
            const int L = (ph - PH0) / PH_PER_LAYER, k = (ph - PH0) % PH_PER_LAYER;
            if (k == 0) {
                pg8::Gemm g{hb, (const bf16*)(ws + WS_WIN) + (size_t)L * INP_PAD * DM, SEQ, INP_PAD, DM}; pg8::StaticOrder S; S.init(SEQ, INP_PAD, G, (int)bidx());
                LANE_TID(); pg8::EpiIn E{args, L};
                pg8::gemm_phase<pg8::EpiIn, pg8::StaticOrder, true, true, DM>(lds, g, S, E, wave);
            }
            else if (k == 1) { LANE_TID(); prep_phase(args, L, lds, tid, G); }
            else if (k == 2) { LANE_TID(); mixer_phase(args, L, lds, tid, lane, wave, G); }
            else if (k == 3) { LANE_TID(); if (!FLG(args, 1)) ssd_scan(ws, (unsigned char*)outp(args), lds, tid, G); swa_merge(ws, tid, G); moba_bucket_wg(args, L, lds, tid, lane, wave, G); }
            else if (k == 4) { LANE_TID(); if (!FLG(args, 4)) ssd_out(args, L, lds, lane, wave, G); __syncthreads(); if (!FLG(args, 8)) moba_final(args, L, lds, lane, wave, G); }
            else if (k == 5) {
                pg8::Gemm g{(const bf16*)(ws + WS_MIX), (const bf16*)(ws + WS_WOUT) + (size_t)L * DM * MIXW, SEQ, DM, MIXW}; pg8::StaticOrder S; S.init(SEQ, DM, G, (int)bidx());
                LANE_TID(); pg8::EpiRes E{nullptr, MD() + 2048, hb, CTLF() + CW_RSS + (L * 2 + 1) * SEQ};
                pg8::gemm_phase<pg8::EpiRes, pg8::StaticOrder, true, true, MIXW>(lds, g, S, E, wave);
            }
            else if (k == 6) {
                pg8::Gemm g{hb, (const bf16*)(ws + WS_WGU) + (size_t)L * GU * DM, SEQ, GU, DM}; pg8::StaticOrder S; S.init(SEQ, GU, G, (int)bidx());
                LANE_TID(); pg8::EpiSwiglu E{(bf16*)(ws + WS_HID), CTLF() + CW_RSS + (L * 2 + 1) * SEQ, CTLF() + CW_BIAS_GU + L * GU};
                pg8::gemm_phase<pg8::EpiSwiglu, pg8::StaticOrder, true, true, DM>(lds, g, S, E, wave);
            }
            else {
                pg8::Gemm g{(const bf16*)(ws + WS_HID), (const bf16*)(ws + WS_WDN) + (size_t)L * DM * FFN, SEQ, DM, FFN}; pg8::StaticOrder S; S.init(SEQ, DM, G, (int)bidx());
                LANE_TID(); pg8::EpiRes E{(L == DEPTH - 1) ? outp(args) : nullptr, MD() + 5120, hb, (L < DEPTH - 1) ? CTLF() + CW_RSS + ((L + 1) * 2 + 0) * SEQ : nullptr};
                pg8::gemm_phase<pg8::EpiRes, pg8::StaticOrder, true, true, FFN>(lds, g, S, E, wave);
            }
        }
        const int ph2 = __builtin_amdgcn_readfirstlane(*PHW()); *PHW() = ph2 + 1;
        if (ph2 + 1 < args.ph_hi || TSP_LASTBAR) { XcdBarrier b2; b2.bar = (unsigned*)((gu32*)(wsp(args) + WS_CTL) + CW_BAR); b2.wave = wave0; asm volatile("" : "+s"(b2.wave)); b2.x = (unsigned)__builtin_amdgcn_readfirstlane((int)*(volatile LAS unsigned*)(lds_k + MISC_OFF + 40)); { int mo_ = MISC_OFF + 32; asm volatile("" : "+s"(mo_)); b2.st = (volatile LAS unsigned*)(lds_k + mo_); } xcd_barrier(b2); }
        TSTAMP(ph2);
    }
}

#ifdef TSPROBE
__global__ void tsp_emit(Args args) {
    const unsigned long long* tsb = (const unsigned long long*)((const unsigned char*)args.p[N_IN + 1] + WS_CTL + 448 * 1024);
    float T1 = 0.f, T2 = 0.f;
    for (int L = 0; L < DEPTH; ++L) {
        if (TSP_K1 < PH_PER_LAYER) { const int p = PH0 + L * PH_PER_LAYER + TSP_K1; T1 += (float)(tsb[p] - tsb[p - 1]) * 0.01f; }
        if (TSP_K2 < PH_PER_LAYER) { const int p = PH0 + L * PH_PER_LAYER + TSP_K2; T2 += (float)(tsb[p] - tsb[p - 1]) * 0.01f; }
    }
    if (TSP_K1 == 10) T1 = (float)(tsb[1] - tsb[63]) * 0.01f;
    if (TSP_K2 == 10) T2 = (float)(tsb[1] - tsb[63]) * 0.01f;
    if (TSP_K1 == 11) T1 = 100.f;
    if (TSP_K2 == 11) T2 = 100.f;
    float* o = (float*)args.p[N_IN];
    const int gt = bidx() * blockDim.x + threadIdx.x;
    if (gt == 0) o[0] += T1 * 0.005f;
    for (int i = 1 + gt; i <= 262144; i += gridDim.x * blockDim.x) o[64 * i - 1] += floorf(T2 * 0.125f + 0.5f) * 8.0f * TSP_SCALE;
}
#endif
extern "C" void kernel_launch(void* const* d_in, const int* in_sizes, int n_in, void* d_out, int out_size, void* d_ws, size_t ws_size, hipStream_t stream) {
    static int grid = 0;
    if (grid == 0) {
        if (n_in != N_IN || in_sizes[0] != SEQ * DM || out_size != SEQ * DM || ws_size < WS_END) { fprintf(stderr, "kernel_launch: unexpected shapes (n_in %d, in0 %d, out %d, ws %zu < %zu)\n", n_in, n_in > 0 ? in_sizes[0] : -1, out_size, ws_size, (size_t)WS_END); grid = -1; return; }
        int dev = 0, cus = 0, per_cu = 0;
        if (hipGetDevice(&dev) != hipSuccess || hipDeviceGetAttribute(&cus, hipDeviceAttributeMultiprocessorCount, dev) != hipSuccess) { grid = -1; return; }
        if (hipFuncSetAttribute((const void*)mk_fwd, hipFuncAttributeMaxDynamicSharedMemorySize, LDS_BYTES) != hipSuccess) { fprintf(stderr, "kernel_launch: hipFuncSetAttribute failed\n"); grid = -1; return; }
        if (hipOccupancyMaxActiveBlocksPerMultiprocessor(&per_cu, (const void*)mk_fwd, NWAVES * 64, LDS_BYTES) != hipSuccess || per_cu < 1) { fprintf(stderr, "kernel_launch: occupancy query says %d\n", per_cu); per_cu = 1; }
        (void)hipGetLastError();
        grid = cus;
        if (grid != 256) { fprintf(stderr, "kernel_launch: expected 256 CUs, got %d\n", grid); if (grid > 256) grid = 256; if (grid < 64 || (grid & 7)) { grid = -1; return; } }
    }
    if (grid < 0) return;
    if (hipMemsetAsync((char*)d_ws + WS_CTL, 0, CTL_ZERO_BYTES, stream) != hipSuccess) return;
    Args a{};
    for (int i = 0; i < N_IN; ++i) a.p[i] = d_in[i];
    a.p[N_IN] = d_out; a.p[N_IN + 1] = d_ws; a.p[N_IN + 2] = nullptr;
#if MK_ONE_LAUNCH
    a.ph_lo = 0; a.ph_hi = N_PHASES;
    hipLaunchKernelGGL(mk_fwd, dim3(grid), dim3(NWAVES * 64), LDS_BYTES, stream, a);
#ifdef TSPROBE
    hipLaunchKernelGGL(tsp_emit, dim3(64), dim3(256), 0, stream, a);
#endif
#else
    for (int ph = 0; ph < N_PHASES; ++ph) { a.ph_lo = ph; a.ph_hi = ph + 1;
#ifdef PROBE_K
        if ((ph >= PH0 && (ph - PH0) % PH_PER_LAYER == PROBE_K) || (ph < PH0 && PROBE_K == 100)) { a.flags = PROBE_FLAGS; for (int rep = 0; rep < PROBE_N; ++rep) hipLaunchKernelGGL(mk_fwd, dim3(grid), dim3(NWAVES * 64), LDS_BYTES, stream, a); }
#endif
        a.flags = 0; hipLaunchKernelGGL(mk_fwd, dim3(grid), dim3(NWAVES * 64), LDS_BYTES, stream, a);
    }
#endif
}
```

```cpp
#include <hip/hip_runtime.h>
#include <cstdio>
#include <cstdint>
#define MK_ONE_LAUNCH 1
__device__ __forceinline__ unsigned opq0() { unsigned z = 0u; asm volatile("" : "+s"(z)); return z; }
namespace pg8 {
#define PG8_LAS __attribute__((address_space(3)))
typedef unsigned short bf16_t;
typedef short bf16x8 __attribute__((ext_vector_type(8)));
typedef float f32x4 __attribute__((ext_vector_type(4)));
typedef unsigned u32x4 __attribute__((ext_vector_type(4)));
constexpr int BM = 256, BK = 64, HALF = 128, HTB = HALF * BK * 2  , STAGE_BYTES = 8 * HTB, NXCD = 8, WGM = 8;

__host__ __device__ __forceinline__ int lds_byte(int r, int c) { const int st = (r >> 4) * 2 + (c >> 5), rr = r & 15, cc = c & 31, ob = rr * 64 + cc * 2; return st * 1024 + (ob ^ (((ob >> 9) & 1) << 5)); }
__host__ __device__ __forceinline__ void stage_rc(int b, int& R, int& C) { const int st = b / 1024, sb = b % 1024, swz = sb ^ (((sb >> 9) & 1) << 5); R = (st >> 1) * 16 + swz / 64; C = (st & 1) * 32 + (swz % 64) / 2; }
__host__ __device__ __forceinline__ int perm32(int rho) { const int n = rho >> 4, i = rho & 15; return 8 * (i >> 2) + 4 * n + (i & 3); }

struct Unit { int pm, pn; };
struct Gemm { const bf16_t* A; const bf16_t* Bt; int M, N, K; };

struct StaticOrder {
    int nM, nN, nwg, G, c;
    __host__ __device__ void init(int M, int N, int G_, int c_) { nM = M / BM; nN = N / BM; nwg = nM * nN; G = G_; c = c_; }
    __host__ __device__ bool next(int i, Unit& u) const {
        const long L = (long)i * G + c; if (L >= nwg) return false;
        int wgid = (int)L; { const int q = nwg / NXCD, r = nwg % NXCD, xcd = wgid % NXCD, off = wgid / NXCD; wgid = (xcd < r ? xcd * (q + 1) : r * (q + 1) + (xcd - r) * q) + off; }
        const int nig = WGM * nN, gid = wgid / nig, fm = gid * WGM, gsz = (nM - fm) < WGM ? (nM - fm) : WGM;
        u.pm = fm + ((wgid % nig) % gsz); u.pn = (wgid % nig) / gsz; return true;
    }
    __device__ __forceinline__ void a_ready(const Unit&) const {}
    __device__ __forceinline__ void done(const Unit&) const {}
};

__device__ __forceinline__ unsigned cvt_pk_bf16(float lo, float hi) { unsigned r; asm volatile("v_cvt_pk_bf16_f32 %0, %1, %2" : "=v"(r) : "v"(lo), "v"(hi)); return r; }
typedef float f32x2 __attribute__((ext_vector_type(2)));
template <class Epi, class Sched, bool ALIGN_EPI = false, bool SP2 = false, int KC = 0>
__device__ __forceinline__ void gemm_phase(PG8_LAS unsigned char* lds, const Gemm g, const Sched& S, const Epi& E, const int tid_in) {
    int lane_ = (int)__builtin_amdgcn_mbcnt_hi(~0u, __builtin_amdgcn_mbcnt_lo(~0u, opq0())); asm volatile("" : "+v"(lane_));
    const int wid = tid_in, lane = lane_, tid = wid * 64 + lane, wr = wid >> 2, wc = wid & 3;
#define PG8_FRFQ() int l2_ = (int)__builtin_amdgcn_mbcnt_hi(~0u, __builtin_amdgcn_mbcnt_lo(~0u, opq0())); asm volatile("" : "+v"(l2_)); const int fr = l2_ & 15, fq = l2_ >> 4
    const int fr0_ = lane & 15, fq0_ = lane >> 4;
    const int K = KC ? KC : g.K, nt = K / BK;
    unsigned voffA[2], voffB[2];
#pragma unroll
    for (int i = 0; i < 2; ++i) { int R, C; stage_rc(tid * 16 + i * 8192, R, C); const int Rb = Epi::PERM ? ((R & ~31) + perm32(R & 31)) : R;
        voffA[i] = (unsigned)(R * K + C) * 2u; voffB[i] = (unsigned)(Rb * K + C) * 2u; }
    const size_t kstep = (size_t)(BK * 2);
    const size_t hstep = (size_t)HALF * K * 2;
    const size_t tstep = 2 * hstep;
    const unsigned ldsw = (unsigned)wid * 1024u;
    const int aoff = lds_byte(wr * 64 + fr0_, fq0_ * 8), boff = lds_byte(wc * 32 + fr0_, fq0_ * 8);
#define PG8_SA(b, h) (((b) * 2 + (h)) * HTB)
#define PG8_SB(b, h) ((4 + (b) * 2 + (h)) * HTB)
#define PG8_STAGE(bufoff, gbase, voff) do { _Pragma("unroll") for (int _i = 0; _i < 2; ++_i) \
        __builtin_amdgcn_global_load_lds((const unsigned*)((const char*)(gbase) + (voff)[_i]), (PG8_LAS unsigned*)(lds + (bufoff) + ldsw + _i * 8192), 16, 0, 0); } while (0)
#define PG8_LDA(dst, b, h) do { _Pragma("unroll") for (int m = 0; m < 4; ++m) _Pragma("unroll") for (int k = 0; k < 2; ++k) dst[m][k] = *(const PG8_LAS bf16x8*)(lds + PG8_SA(b, h) + aoff + m * 2048 + k * 1024); } while (0)
#define PG8_LDB(dst, b, h) do { _Pragma("unroll") for (int n = 0; n < 2; ++n) _Pragma("unroll") for (int k = 0; k < 2; ++k) dst[n][k] = *(const PG8_LAS bf16x8*)(lds + PG8_SB(b, h) + boff + n * 2048 + k * 1024); } while (0)
#define PG8_MMA(ai, bj, At, Bt) do { __builtin_amdgcn_s_setprio(1); _Pragma("unroll") for (int m = 0; m < 4; ++m) _Pragma("unroll") for (int n = 0; n < 2; ++n) _Pragma("unroll") for (int k = 0; k < 2; ++k) \
        acc[ai][bj][m][n] = __builtin_amdgcn_mfma_f32_16x16x32_bf16(Bt[n][k], At[m][k], acc[ai][bj][m][n], 0, 0, 0); __builtin_amdgcn_s_setprio(0); } while (0)
#define PG8_WAIT_V(n) asm volatile("s_waitcnt vmcnt(" #n ")" ::: "memory")
#define PG8_WAIT_L(n) asm volatile("s_waitcnt lgkmcnt(" #n ")" ::: "memory")
#define PG8_BAR __builtin_amdgcn_s_barrier()
#define PG8_SCHED __builtin_amdgcn_sched_barrier(0)
    Unit cur, nxt; int ui = 0;
    if (!S.next(0, cur)) return;
    f32x4 acc[2][2][4][2];
#pragma unroll
    for (int a = 0; a < 2; ++a)
#pragma unroll
        for (int b = 0; b < 2; ++b)
#pragma unroll
            for (int m = 0; m < 4; ++m)
#pragma unroll
                for (int n = 0; n < 2; ++n) acc[a][b][m][n] = (f32x4){0.f, 0.f, 0.f, 0.f};
    bf16x8 At[4][2], B0[2][2], B1[2][2];
    const char* cA = (const char*)g.A + (size_t)cur.pm * tstep; const char* cB = (const char*)g.Bt + (size_t)cur.pn * tstep;
    S.a_ready(cur);
    if constexpr (SP2) {
        PG8_STAGE(PG8_SB(0, 0), cB, voffB); PG8_STAGE(PG8_SB(0, 1), cB + hstep, voffB); PG8_STAGE(PG8_SA(0, 0), cA, voffA); PG8_STAGE(PG8_SA(0, 1), cA + hstep, voffA);
        if (wr == 1) PG8_BAR;
        PG8_WAIT_V(2); PG8_BAR;
        PG8_STAGE(PG8_SB(1, 0), cB + kstep, voffB); PG8_STAGE(PG8_SA(1, 0), cA + kstep, voffA); PG8_STAGE(PG8_SB(1, 1), cB + hstep + kstep, voffB);
        PG8_WAIT_V(6); PG8_BAR;
    } else {
        PG8_STAGE(PG8_SB(0, 0), cB, voffB); PG8_STAGE(PG8_SA(0, 0), cA, voffA); PG8_STAGE(PG8_SB(0, 1), cB + hstep, voffB); PG8_STAGE(PG8_SA(0, 1), cA + hstep, voffA);
        if (wr == 1) PG8_BAR;
        PG8_WAIT_V(4); PG8_BAR;
        PG8_STAGE(PG8_SB(1, 0), cB + kstep, voffB); PG8_STAGE(PG8_SA(1, 0), cA + kstep, voffA); PG8_STAGE(PG8_SB(1, 1), cB + hstep + kstep, voffB);
        PG8_WAIT_V(6); PG8_BAR;
    }
    for (;;) {
        const bool has_next = S.next(ui + 1, nxt);
        const char* nA = has_next ? (const char*)g.A + (size_t)nxt.pm * tstep : cA; const char* nB = has_next ? (const char*)g.Bt + (size_t)nxt.pn * tstep : cB;
        for (int t = 0; t < nt; t += 2) {
            const bool last = (t == nt - 2);
            const char* a1 = cA + (size_t)(t + 1) * kstep;
            const char* a2 = last ? nA : cA + (size_t)(t + 2) * kstep; const char* b2 = last ? nB : cB + (size_t)(t + 2) * kstep;
            const char* a3 = a2 + kstep; const char* b3 = b2 + kstep;
            if (last && has_next) S.a_ready(nxt);
            if constexpr (SP2) {
            PG8_LDB(B0, 0, 0); PG8_LDB(B1, 0, 1); PG8_SCHED; PG8_LDA(At, 0, 0); PG8_STAGE(PG8_SA(1, 1), a1 + hstep, voffA);
            PG8_WAIT_V(8); PG8_WAIT_L(0); PG8_BAR; PG8_MMA(0, 0, At, B0); PG8_MMA(0, 1, At, B1); PG8_BAR; PG8_SCHED;
            PG8_LDA(At, 0, 1); PG8_STAGE(PG8_SB(0, 0), b2, voffB); PG8_STAGE(PG8_SB(0, 1), b2 + hstep, voffB); PG8_STAGE(PG8_SA(0, 0), a2, voffA);
            PG8_WAIT_V(8); PG8_WAIT_L(0); PG8_BAR; PG8_MMA(1, 0, At, B0); PG8_MMA(1, 1, At, B1); PG8_BAR; PG8_SCHED;
            PG8_LDB(B0, 1, 0); PG8_LDB(B1, 1, 1); PG8_SCHED; PG8_LDA(At, 1, 0); PG8_STAGE(PG8_SA(0, 1), a2 + hstep, voffA);
            PG8_WAIT_V(8); PG8_WAIT_L(0); PG8_BAR; PG8_MMA(0, 0, At, B0); PG8_MMA(0, 1, At, B1); PG8_BAR; PG8_SCHED;
            PG8_LDA(At, 1, 1); PG8_STAGE(PG8_SB(1, 0), b3, voffB); PG8_STAGE(PG8_SB(1, 1), b3 + hstep, voffB); PG8_STAGE(PG8_SA(1, 0), a3, voffA);
            PG8_WAIT_V(8); PG8_WAIT_L(0); PG8_BAR; PG8_MMA(1, 0, At, B0); PG8_MMA(1, 1, At, B1); PG8_BAR; PG8_SCHED;
            } else {
            PG8_LDB(B0, 0, 0); PG8_SCHED; PG8_LDA(At, 0, 0); PG8_STAGE(PG8_SA(1, 1), a1 + hstep, voffA);
            PG8_WAIT_L(8); PG8_BAR; PG8_WAIT_L(0); PG8_MMA(0, 0, At, B0); PG8_BAR; PG8_SCHED;
            PG8_LDB(B1, 0, 1); PG8_STAGE(PG8_SB(0, 0), b2, voffB);
            PG8_BAR; PG8_WAIT_L(0); PG8_MMA(0, 1, At, B1); PG8_BAR;
            PG8_LDA(At, 0, 1); PG8_STAGE(PG8_SA(0, 0), a2, voffA);
            PG8_BAR; PG8_WAIT_L(0); PG8_MMA(1, 0, At, B0); PG8_BAR; PG8_SCHED;
            PG8_STAGE(PG8_SB(0, 1), b2 + hstep, voffB);
            PG8_WAIT_V(6); PG8_BAR; PG8_MMA(1, 1, At, B1); PG8_BAR;
            PG8_LDB(B0, 1, 0); PG8_SCHED; PG8_LDA(At, 1, 0); PG8_STAGE(PG8_SA(0, 1), a2 + hstep, voffA);
            PG8_WAIT_L(8); PG8_BAR; PG8_WAIT_L(0); PG8_MMA(0, 0, At, B0); PG8_BAR; PG8_SCHED;
            PG8_LDB(B1, 1, 1); PG8_STAGE(PG8_SB(1, 0), b3, voffB);
            PG8_BAR; PG8_WAIT_L(0); PG8_MMA(0, 1, At, B1); PG8_BAR;
            PG8_LDA(At, 1, 1); PG8_STAGE(PG8_SA(1, 0), a3, voffA);
            PG8_BAR; PG8_WAIT_L(0); PG8_MMA(1, 0, At, B0); PG8_BAR; PG8_SCHED;
            PG8_STAGE(PG8_SB(1, 1), b3 + hstep, voffB);
            PG8_WAIT_V(6); PG8_BAR; PG8_MMA(1, 1, At, B1); PG8_BAR;
            }
        }
        if constexpr (ALIGN_EPI) { if (wr == 0) PG8_BAR; }
        if constexpr (!Epi::AFTER_DRAIN) { PG8_FRFQ(); E(acc, cur, wr, wc, fr, fq); S.done(cur); }
        if (!has_next) break;
#pragma unroll
        for (int a = 0; a < 2; ++a)
#pragma unroll
            for (int b = 0; b < 2; ++b)
#pragma unroll
                for (int m = 0; m < 4; ++m)
#pragma unroll
                    for (int n = 0; n < 2; ++n) acc[a][b][m][n] = (f32x4){0.f, 0.f, 0.f, 0.f};
        cur = nxt; cA = nA; cB = nB; ++ui;
        if constexpr (ALIGN_EPI) { if (wr == 1) PG8_BAR; }
    }
    PG8_WAIT_V(0);
    if constexpr (!ALIGN_EPI) { if (wr == 0) PG8_BAR; }
    PG8_BAR;
    if constexpr (Epi::AFTER_DRAIN) { PG8_FRFQ(); E.fused(acc, cur, wr, wc, fr, fq, lds, wid, lane); S.done(cur); }
#undef PG8_SA
#undef PG8_SB
#undef PG8_STAGE
#undef PG8_LDA
#undef PG8_LDB
#undef PG8_MMA
#undef PG8_WAIT_V
#undef PG8_WAIT_L
#undef PG8_BAR
#undef PG8_SCHED
}
}
#define GAS __attribute__((address_space(1)))
#define LAS __attribute__((address_space(3)))
typedef unsigned short bf16;
typedef unsigned v4u __attribute__((ext_vector_type(4)));
typedef float f32x4 __attribute__((ext_vector_type(4)));
typedef short bf16x8 __attribute__((ext_vector_type(8)));
typedef GAS unsigned gu32;
typedef GAS unsigned long long gu64;
#define RLX_AGENT __ATOMIC_RELAXED, __HIP_MEMORY_SCOPE_AGENT
#define LDS_WAIT() asm volatile("s_waitcnt lgkmcnt(0)" ::: "memory")
#define VM_WAIT() asm volatile("s_waitcnt vmcnt(0)" ::: "memory")
__device__ __forceinline__ unsigned long long rt() { return __builtin_amdgcn_s_memrealtime(); }
__device__ __forceinline__ unsigned f2bf(float f) { unsigned u = __builtin_bit_cast(unsigned, f); return (u + 0x7fffu + ((u >> 16) & 1u)) >> 16; }
__device__ __forceinline__ unsigned pk2(float lo, float hi) { unsigned r; asm volatile("v_cvt_pk_bf16_f32 %0, %1, %2" : "=v"(r) : "v"(lo), "v"(hi)); return r; }
#define XB_TMO      128
#define XB_XCNT(j)  (256  + 64 * (j))
#define XB_XSUB(j)  (1280 + 64 * (j))
#define XB_XGEN(j)  (2304 + 64 * (j))
#define XB_TOP      3328
#define XB_TOPGEN   3392
#define XCD_BAR_WORDS 3456
#define XB_SPIN_CAP (1u << 18)

__device__ __forceinline__ unsigned xb_ld(unsigned* p)              { return __hip_atomic_load(p, __ATOMIC_RELAXED, __HIP_MEMORY_SCOPE_AGENT); }
__device__ __forceinline__ unsigned xb_add(unsigned* p, unsigned v) { return __hip_atomic_fetch_add(p, v, __ATOMIC_RELAXED, __HIP_MEMORY_SCOPE_AGENT); }
__device__ __forceinline__ unsigned xb_xcc_id() { return (unsigned)__builtin_amdgcn_s_getreg((3 << 11) | 20) & 0xFu; }
#define XB_SPIN(cond, bar) do { unsigned _sp = 0; while (cond) { __builtin_amdgcn_s_sleep(1); \
    if ((++_sp & 255u) == 0u) { if (xb_ld(&(bar)[XB_TMO])) break; if (_sp > XB_SPIN_CAP) { atomicAdd(&(bar)[XB_TMO], 1u); break; } } } } while (0)

struct XcdBarrier {
    unsigned* bar; unsigned x; int wave;
    volatile LAS unsigned* st;
};

__device__ __forceinline__ XcdBarrier xcd_barrier_post(unsigned* bar, volatile LAS unsigned* st) {
    XcdBarrier b; b.bar = bar; b.x = xb_xcc_id(); b.st = st; b.wave = 1;
    if (threadIdx.x == 0) (void)xb_add(&bar[XB_XCNT(b.x)], 1u);
    return b;
}
__device__ __forceinline__ void xcd_barrier_complete(unsigned* bar, unsigned x, unsigned& nloc, unsigned& nx) {
    const unsigned G = gridDim.x * gridDim.y * gridDim.z;
    unsigned sum, cnt, mine, sp = 0u;
    for (;;) {
        sum = 0u; cnt = 0u; mine = 0u;
#pragma unroll
        for (unsigned j = 0; j < 16; ++j) { const unsigned c = xb_ld(&bar[XB_XCNT(j)]); sum += c; cnt += (c > 0u) ? 1u : 0u; mine = (j == x) ? c : mine; }
        if (sum == G) break;
        __builtin_amdgcn_s_sleep(1);
        if ((++sp & 255u) == 0u) { if (xb_ld(&bar[XB_TMO])) break; if (sp > XB_SPIN_CAP) { atomicAdd(&bar[XB_TMO], 1u); break; } }
    }
    nloc = mine > 0u ? mine : 1u; nx = cnt > 0u ? cnt : 1u;
}

__device__ __forceinline__ void xcd_barrier(const XcdBarrier& b) {
    asm volatile("s_waitcnt vmcnt(0)" ::: "memory");
    __syncthreads();
    if (b.wave == 0 && (int)__builtin_amdgcn_mbcnt_hi(~0u, __builtin_amdgcn_mbcnt_lo(~0u, opq0())) == 0) {
        unsigned* bar = b.bar;
        __builtin_amdgcn_s_waitcnt(0);
        unsigned nloc = b.st[0], nx = b.st[1];
        if (nloc == 0u) { xcd_barrier_complete(bar, b.x, nloc, nx); b.st[0] = nloc; b.st[1] = nx; }
        const unsigned old = xb_add(&bar[XB_XSUB(b.x)], 1u);
        const unsigned gen = old / nloc;
        if (old + 1u == (gen + 1u) * nloc) {
            __builtin_amdgcn_fence(__ATOMIC_RELEASE, "agent");
            asm volatile("s_waitcnt vmcnt(0)" ::: "memory");
            const unsigned og = xb_add(&bar[XB_TOP], 1u);
            const unsigned tg = og / nx;
            if (og + 1u == (tg + 1u) * nx) xb_add(&bar[XB_TOPGEN], 1u);
            else XB_SPIN(xb_ld(&bar[XB_TOPGEN]) == tg, bar);
            __builtin_amdgcn_fence(__ATOMIC_ACQUIRE, "agent");
            xb_add(&bar[XB_XGEN(b.x)], 1u);
            asm volatile("s_waitcnt vmcnt(0)" ::: "memory");
        } else {
            XB_SPIN(xb_ld(&bar[XB_XGEN(b.x)]) == gen, bar);
            __builtin_amdgcn_fence(__ATOMIC_ACQUIRE, "agent");
            asm volatile("s_waitcnt vmcnt(0)" ::: "memory");
        }
    }
    __syncthreads();
}
#ifndef QKFUSE
#define QKFUSE 1
#endif
#ifdef PROBE_K
#define FLG(a_, m_) ((a_).flags & (m_))
#else
#define FLG(a_, m_) 0
#endif

constexpr int SEQ = 16384, DM = 1024, DEPTH = 4, NH = 8, HD = 64;
constexpr int INP = 4616, INP_PAD = 4864, MIXW = 1536, FFN = 2816, GU = 2 * FFN;
constexpr int NWAVES = 8;
constexpr float EPS = 1e-6f;
constexpr float C2 = 0.125f * 1.4426950408889634f;
constexpr int PH_PER_LAYER = 8, PH0 = 2, N_PHASES = PH0 + DEPTH * PH_PER_LAYER;
#ifndef MK_ONE_LAUNCH
#define MK_ONE_LAUNCH 1
#endif
enum { I_X = 0, I_C, I_ADAW, I_ADAB, I_NMIX, I_WIN, I_QNS, I_KNS, I_QNM, I_KNM, I_CONVW, I_CONVB, I_DTB, I_ALOG, I_DSKIP, I_SNORM, I_WOUT, I_NFFN, I_WG, I_WU, I_WD, N_IN };
constexpr size_t MiB = 1u << 20;
constexpr size_t WS_CTL = 0, CTL_ZERO_BYTES = 1 * MiB;
constexpr size_t WS_MOD = 1 * MiB;
constexpr size_t WS_GAINS = 1 * MiB + 128 * 1024;
constexpr size_t WS_ROPE = 2 * MiB;
constexpr size_t WS_KMEAN = 3 * MiB;
constexpr size_t WS_DT = 3 * MiB + 512 * 1024;
constexpr size_t WS_WIN = 4 * MiB;
constexpr size_t WS_WOUT = 42 * MiB;
constexpr size_t WS_WGU = 54 * MiB;
constexpr size_t WS_WDN = 98 * MiB;
constexpr size_t WS_H = 120 * MiB;
constexpr size_t WS_QKV = 152 * MiB;
constexpr size_t WS_HID = WS_QKV;
constexpr size_t WS_Z = 248 * MiB;
constexpr size_t WS_XBC = 264 * MiB;
constexpr size_t WS_Y = WS_XBC;
constexpr size_t WS_XC = 296 * MiB;
constexpr size_t WS_MIX = 328 * MiB;
constexpr size_t XT_XDTT = 0, XT_XWT = 16 * MiB, XT_STB = 32 * MiB;
constexpr size_t WS_ST = WS_XBC;
constexpr size_t WS_BT = 376 * MiB;
constexpr size_t WS_CS = 384 * MiB;
constexpr size_t WS_LIST = WS_XBC + 16 * MiB;
constexpr size_t WS_PO = WS_QKV;
constexpr size_t WS_PS = 385 * MiB;
constexpr size_t WS_END = 388 * MiB;
constexpr int CW_CNT = 8192;
constexpr int CW_BIAS_IN = 65536, CW_BIAS_GU = CW_BIAS_IN + DEPTH * INP_PAD;
constexpr int CW_RSS = 131072;
constexpr int CW_BAR = 4096;
constexpr float RSS_Q = 1024.f, RSS_IQ = 1.f / (1024.f * 1024.f)  , BIAS_Q = 16777216.f, BIAS_IQ = 1.f / 16777216.f;
__device__ __forceinline__ float rss_ms(const float* rss, int row) { return (float)((const unsigned*)rss)[row] * RSS_IQ; }
__device__ __forceinline__ f32x4 bias4(const float* p) { typedef int i32x4 __attribute__((ext_vector_type(4))); const i32x4 v = *(const i32x4*)p; return (f32x4){(float)v[0] * BIAS_IQ, (float)v[1] * BIAS_IQ, (float)v[2] * BIAS_IQ, (float)v[3] * BIAS_IQ}; }
constexpr int RING_BYTES = 131072, LDSCTL_OFF = RING_BYTES, MISC_OFF = LDSCTL_OFF + 320, LDS_BYTES = 163840;

__device__ __forceinline__ int bidx() { int v = blockIdx.x; asm volatile("" : "+s"(v)); return v; }
struct Args { const void* p[N_IN + 3]; int ph_lo, ph_hi, flags, pad; };
__device__ __forceinline__ const float* inp(const Args& a, int i) { asm volatile("" : "+s"(i)); return (const float*)a.p[i]; }
__device__ __forceinline__ float* outp(const Args& a) { int i = N_IN; asm volatile("" : "+s"(i)); return (float*)a.p[i]; }
__device__ __forceinline__ unsigned char* wsp(const Args& a) { int i = N_IN + 1; asm volatile("" : "+s"(i)); return (unsigned char*)a.p[i]; }

__device__ __forceinline__ float bflo(unsigned w) { return __builtin_bit_cast(float, w << 16); }
__device__ __forceinline__ float bfhi(unsigned w) { return __builtin_bit_cast(float, w & 0xffff0000u); }
__device__ __forceinline__ float bf2f(bf16 b) { return __builtin_bit_cast(float, (unsigned)b << 16); }
template <int O> __device__ __forceinline__ float shx(float x) { static_assert(O < 32, "use swap32 across the halves"); return __builtin_bit_cast(float, __builtin_amdgcn_ds_swizzle(__builtin_bit_cast(int, x), (O << 10) | 0x1f)); }
__device__ __forceinline__ void swap32(float& a, float& b) { asm volatile("s_nop 1\n\tv_permlane32_swap_b32 %0, %1" : "+v"(a), "+v"(b)); }
__device__ __forceinline__ float xadd32(float x) { float a = x, b = x; swap32(a, b); return a + b; }
__device__ __forceinline__ float wave_sum(float v) {
    v += shx<1>(v); v += shx<2>(v); v += shx<4>(v); v += shx<8>(v); v += shx<16>(v); v = xadd32(v);
    return v;
}
__device__ __forceinline__ float wave_max(float v) {
    v = fmaxf(v, shx<1>(v)); v = fmaxf(v, shx<2>(v)); v = fmaxf(v, shx<4>(v)); v = fmaxf(v, shx<8>(v)); v = fmaxf(v, shx<16>(v)); { float a = v, c = v; swap32(a, c); v = fmaxf(a, c); }
    return v;
}
__device__ __forceinline__ float siluf(float x) { return x * __builtin_amdgcn_rcpf(1.f + __expf(-x)); }
__device__ __forceinline__ void unpack8(const v4u w, float* f) {
    f[0] = bflo(w.x); f[1] = bfhi(w.x); f[2] = bflo(w.y); f[3] = bfhi(w.y); f[4] = bflo(w.z); f[5] = bfhi(w.z); f[6] = bflo(w.w); f[7] = bfhi(w.w);
}
__device__ __forceinline__ void sincos_d(float angf, float& s, float& c) {
    const double a = (double)angf;
    const double k = __builtin_rint(a * 0.63661977236758134308);
    double r = __builtin_fma(-k, 1.57079632679489655800, a);
    r = __builtin_fma(-k, 6.123233995736766036e-17, r);
    const double r2 = r * r;
    double sp = 1.0 / 6227020800.0; sp = sp * r2 - 1.0 / 39916800.0; sp = sp * r2 + 1.0 / 362880.0; sp = sp * r2 - 1.0 / 5040.0; sp = sp * r2 + 1.0 / 120.0; sp = sp * r2 - 1.0 / 6.0; sp = sp * r2 + 1.0;
    const double sr = sp * r;
    double cp = 1.0 / 479001600.0; cp = cp * r2 - 1.0 / 3628800.0; cp = cp * r2 + 1.0 / 40320.0; cp = cp * r2 - 1.0 / 720.0; cp = cp * r2 + 1.0 / 24.0; cp = cp * r2 - 0.5; cp = cp * r2 + 1.0;
    const int q = (int)((long long)k & 3);
    const double ss = (q == 0) ? sr : (q == 1) ? cp : (q == 2) ? -sr : -cp;
    const double cc = (q == 0) ? cp : (q == 1) ? -sr : (q == 2) ? -cp : sr;
    s = (float)ss; c = (float)cc;
}

namespace pg8 {
struct EpiIn {
    static constexpr bool PERM = true, AFTER_DRAIN = false;
    const Args& ar; int L;
    __device__ __forceinline__ void operator()(const f32x4 (&acc)[2][2][4][2], const Unit& u, int wr, int wc, int fr, int fq) const {
        const int colt = u.pn * BM;
        unsigned char* ws = wsp(ar);
        const float* rss = (const float*)(ws + WS_CTL) + CW_RSS + (L * 2 + 0) * SEQ; const float* bias = (const float*)(ws + WS_CTL) + CW_BIAS_IN + L * INP_PAD;
        bf16_t* qkv = (bf16_t*)(ws + WS_QKV); bf16_t* z = (bf16_t*)(ws + WS_Z); bf16_t* xbc = (bf16_t*)(ws + WS_XBC); float* dt = (float*)(ws + WS_DT);
        const float* rope = (const float*)(ws + WS_ROPE); float* kmean2 = (float*)(ws + WS_KMEAN);
        f32x4 bv[2][2];
#pragma unroll
        for (int bj = 0; bj < 2; ++bj)
#pragma unroll
            for (int n = 0; n < 2; ++n) bv[bj][n] = bias4(bias + colt + bj * HALF + wc * 32 + 8 * fq + 4 * n);
        float rms8[2][4];
#pragma unroll
        for (int ai = 0; ai < 2; ++ai)
#pragma unroll
            for (int m = 0; m < 4; ++m) rms8[ai][m] = rss_ms(rss, u.pm * BM + ai * HALF + wr * 64 + m * 16 + fr);
        asm volatile("" : "+v"(rms8[0][0]), "+v"(rms8[0][1]), "+v"(rms8[0][2]), "+v"(rms8[0][3]), "+v"(rms8[1][0]), "+v"(rms8[1][1]), "+v"(rms8[1][2]), "+v"(rms8[1][3]));
        if (QKFUSE && colt < 3072) {
            const int tsel = u.pn >> 1, head = 4 * (u.pn & 1) + wc;
            const bool isv = (tsel == 2 || tsel == 5);
            const float* gain = (const float*)(ws + WS_GAINS) + (L * 4 + ((tsel == 0) ? 0 : (tsel == 1) ? 1 : (tsel == 3) ? 2 : 3)) * 64;
            f32x4 gn[2][2];
            if (!isv) {
#pragma unroll
                for (int bj = 0; bj < 2; ++bj)
#pragma unroll
                    for (int n = 0; n < 2; ++n) gn[bj][n] = *(const f32x4*)(gain + 32 * bj + ((bj == 0 && fq < 2) ? 4 * fq + 8 * n : 8 * fq + 4 * n)) * ((tsel == 0 || tsel == 3) ? 0.125f * 1.4426950408889634f : 1.0f);
            }
            f32x4 ks[2][2];
#pragma unroll
            for (int bj = 0; bj < 2; ++bj)
#pragma unroll
                for (int n = 0; n < 2; ++n) ks[bj][n] = (f32x4){0.f, 0.f, 0.f, 0.f};
            extern __shared__ __attribute__((aligned(16))) unsigned char lds_epi[];
            PG8_LAS float* ropeL = (PG8_LAS float*)((PG8_LAS unsigned char*)lds_epi + 132096);
            if (!isv) {
                const int t_ = (wr * 4 + wc) * 64 + fq * 16 + fr, rr_ = t_ >> 1, hf_ = t_ & 1;
                const f32x4 ra = *(const f32x4*)(rope + (size_t)(u.pm * BM + rr_) * 16 + hf_ * 8), rb = *(const f32x4*)(rope + (size_t)(u.pm * BM + rr_) * 16 + hf_ * 8 + 4);
                *(PG8_LAS f32x4*)(ropeL + rr_ * 28 + hf_ * 4) = (f32x4){ra[0], ra[2], rb[0], rb[2]};
                *(PG8_LAS f32x4*)(ropeL + rr_ * 28 + 8 + hf_ * 4) = (f32x4){ra[1], ra[3], rb[1], rb[3]};
                *(PG8_LAS f32x4*)(ropeL + rr_ * 28 + 16 + hf_ * 4) = (f32x4){-ra[1], -ra[3], -rb[1], -rb[3]};
                if (t_ < 6) *(PG8_LAS f32x4*)(ropeL + 256 * 28 + t_ * 4) = (t_ < 2) ? (f32x4){1.f, 1.f, 1.f, 1.f} : (f32x4){0.f, 0.f, 0.f, 0.f};
                asm volatile("s_waitcnt lgkmcnt(0)" ::: "memory"); __builtin_amdgcn_s_barrier();
            }
            bf16_t* dbase = qkv + (size_t)(tsel * 8 + head) * SEQ * 64 + 8 * fq;
#pragma unroll
            for (int ai = 0; ai < 2; ++ai)
#pragma unroll
                for (int m = 0; m < 4; ++m) {
                    const int row = u.pm * BM + ai * HALF + wr * 64 + m * 16 + fr;
                    const float rstd = __builtin_amdgcn_rsqf(rms8[ai][m] + 1e-6f);
                    f32x4 v[2][2];
#pragma unroll
                    for (int bj = 0; bj < 2; ++bj)
#pragma unroll
                        for (int n = 0; n < 2; ++n) v[bj][n] = acc[ai][bj][m][n] * rstd + bv[bj][n];
                    if (!isv) {
                        float ss = 0.f;
#pragma unroll
                        for (int bj = 0; bj < 2; ++bj)
#pragma unroll
                            for (int n = 0; n < 2; ++n) ss += (v[bj][n][0] * v[bj][n][0] + v[bj][n][1] * v[bj][n][1]) + (v[bj][n][2] * v[bj][n][2] + v[bj][n][3] * v[bj][n][3]);
                        ss += shx<16>(ss); ss = xadd32(ss);
                        const float rh = __builtin_amdgcn_rsqf(ss * (1.0f / 64.0f) + 1e-6f);
#pragma unroll
                        for (int bj = 0; bj < 2; ++bj)
#pragma unroll
                            for (int n = 0; n < 2; ++n) v[bj][n] = v[bj][n] * rh * gn[bj][n];
                        {
                            const int rsel = (fq < 2) ? (ai * HALF + wr * 64 + m * 16 + fr) : 256;
                            const f32x4 cv = *(const PG8_LAS f32x4*)(ropeL + rsel * 28 + 4 * (fq & 1)), sv = *(const PG8_LAS f32x4*)(ropeL + rsel * 28 + 8 + 4 * (fq & 1));
                            const f32x4 x1 = v[0][0], x2 = v[0][1];
                            v[0][0] = x1 * cv - x2 * sv; v[0][1] = x2 * cv + x1 * sv; }
                        if (tsel == 4) {
#pragma unroll
                            for (int bj = 0; bj < 2; ++bj)
#pragma unroll
                                for (int n = 0; n < 2; ++n) ks[bj][n] += v[bj][n];
                        }
                    }
#pragma unroll
                    for (int bj = 0; bj < 2; ++bj) { const f32x4 v0 = v[bj][0], v1 = v[bj][1];
                        u32x4 w; w.x = cvt_pk_bf16(v0[0], v0[1]); w.y = cvt_pk_bf16(v0[2], v0[3]); w.z = cvt_pk_bf16(v1[0], v1[1]); w.w = cvt_pk_bf16(v1[2], v1[3]);
                        if (bj == 0 && !isv) {
                            typedef unsigned u32x2e __attribute__((ext_vector_type(2)));
                            const int o0 = (fq < 2) ? 4 * fq : 8 * fq, o1 = (fq < 2) ? 4 * fq + 8 : 8 * fq + 4;
                            bf16_t* d0 = dbase - 8 * fq + (size_t)row * 64;
                            *(u32x2e*)(d0 + o0) = (u32x2e){w.x, w.y}; *(u32x2e*)(d0 + o1) = (u32x2e){w.z, w.w};
                        } else *(u32x4*)(dbase + (size_t)row * 64 + 32 * bj) = w; }
                }
            if (tsel == 4) {
#pragma unroll
                for (int bj = 0; bj < 2; ++bj)
#pragma unroll
                    for (int n = 0; n < 2; ++n)
#pragma unroll
                        for (int j = 0; j < 4; ++j) { float s = ks[bj][n][j]; s += shx<1>(s); s += shx<2>(s); s += shx<4>(s); s += shx<8>(s); ks[bj][n][j] = s; }
                if (fr == 0) {
                    float* kd = kmean2 + ((size_t)(wr * 8 + head) * 64 + u.pm) * 64 + 8 * fq;
                    { const int o0 = (fq < 2) ? 4 * fq : 8 * fq, o1 = (fq < 2) ? 4 * fq + 8 : 8 * fq + 4;
                      *(f32x4*)(kd - 8 * fq + o0) = ks[0][0]; *(f32x4*)(kd - 8 * fq + o1) = ks[0][1]; *(f32x4*)(kd + 32) = ks[1][0]; *(f32x4*)(kd + 32 + 4) = ks[1][1]; }
                }
            }
            return;
        }
#pragma unroll
        for (int ai = 0; ai < 2; ++ai)
#pragma unroll
            for (int m = 0; m < 4; ++m) {
                const int row = u.pm * BM + ai * HALF + wr * 64 + m * 16 + fr;
                const float rstd = __builtin_amdgcn_rsqf(rms8[ai][m] + 1e-6f);
#pragma unroll
                for (int bj = 0; bj < 2; ++bj) {
                    const int c = colt + bj * HALF + wc * 32 + 8 * fq;
                    const f32x4 v0 = acc[ai][bj][m][0] * rstd + bv[bj][0], v1 = acc[ai][bj][m][1] * rstd + bv[bj][1];
                    if (colt < 4608) {
                        u32x4 w; w.x = cvt_pk_bf16(v0[0], v0[1]); w.y = cvt_pk_bf16(v0[2], v0[3]); w.z = cvt_pk_bf16(v1[0], v1[1]); w.w = cvt_pk_bf16(v1[2], v1[3]);
                        bf16_t* dst;
                        if (colt < 3072) dst = qkv + ((size_t)(c >> 6) * SEQ + row) * 64 + (c & 63);
                        else if (colt < 3584) dst = z + (size_t)row * 512 + (c - 3072);
                        else dst = xbc + (size_t)row * 1024 + (c - 3584);
                        *(u32x4*)dst = w;
                    } else if (c == 4608) {
                        *(f32x4*)(dt + (size_t)row * 8) = v0; *(f32x4*)(dt + (size_t)row * 8 + 4) = v1;
                    }
                }
            }
    }
};
struct EpiRes {
    static constexpr bool PERM = true, AFTER_DRAIN = false;
    float* out; const float* gate; bf16_t* xb; float* rss;
    __device__ __forceinline__ void operator()(const f32x4 (&acc)[2][2][4][2], const Unit& u, int wr, int wc, int fr, int fq) const {
        typedef unsigned u32x4 __attribute__((ext_vector_type(4)));
        const int col0 = u.pn * BM + wc * 32 + 8 * fq;
        f32x4 gv[2][2];
#pragma unroll
        for (int bj = 0; bj < 2; ++bj)
#pragma unroll
            for (int n = 0; n < 2; ++n) gv[bj][n] = *(const f32x4*)(gate + col0 + bj * HALF + n * 4);
        u32x4 bb[2][4][2];
        const size_t off0 = (size_t)(u.pm * BM + wr * 64 + fr) * DM + col0;
#pragma unroll
        for (int ai = 0; ai < 2; ++ai)
#pragma unroll
            for (int m = 0; m < 4; ++m)
#pragma unroll
                for (int bj = 0; bj < 2; ++bj) bb[ai][m][bj] = *(const u32x4*)(xb + off0 + (size_t)(ai * HALF + m * 16) * DM + bj * HALF);
#pragma unroll
        for (int ai = 0; ai < 2; ++ai)
#pragma unroll
            for (int m = 0; m < 4; ++m) {
                const int row = u.pm * BM + ai * HALF + wr * 64 + m * 16 + fr;
                const size_t off = off0 + (size_t)(ai * HALF + m * 16) * DM;
                float ss = 0.f;
#pragma unroll
                for (int bj = 0; bj < 2; ++bj) {
                    const u32x4 b_ = bb[ai][m][bj];
                    const f32x4 b0 = {__uint_as_float(b_[0] << 16), __uint_as_float(b_[0] & 0xffff0000u), __uint_as_float(b_[1] << 16), __uint_as_float(b_[1] & 0xffff0000u)};
                    const f32x4 b1 = {__uint_as_float(b_[2] << 16), __uint_as_float(b_[2] & 0xffff0000u), __uint_as_float(b_[3] << 16), __uint_as_float(b_[3] & 0xffff0000u)};
                    const f32x4 o0 = b0 + gv[bj][0] * acc[ai][bj][m][0], o1 = b1 + gv[bj][1] * acc[ai][bj][m][1];
                    if (out) { *(f32x4*)(out + off + bj * HALF) = o0; *(f32x4*)(out + off + bj * HALF + 4) = o1; }
                    *(u32x4*)(xb + off + bj * HALF) = (u32x4){cvt_pk_bf16(o0[0], o0[1]), cvt_pk_bf16(o0[2], o0[3]), cvt_pk_bf16(o1[0], o1[1]), cvt_pk_bf16(o1[2], o1[3])};
                    ss += ((o0[0] * o0[0] + o0[1] * o0[1]) + (o0[2] * o0[2] + o0[3] * o0[3])) + ((o1[0] * o1[0] + o1[1] * o1[1]) + (o1[2] * o1[2] + o1[3] * o1[3]));
                }
                ss += shx<16>(ss); ss = xadd32(ss);
                if (rss && fq == 0) atomicAdd((unsigned*)rss + row, (unsigned)__float2uint_rn(ss * RSS_Q));
            }
    }
};
struct EpiSwiglu {
    static constexpr bool PERM = true, AFTER_DRAIN = false;
    bf16_t* hid; const float* rss; const float* bias;
    __device__ __forceinline__ void operator()(const f32x4 (&acc)[2][2][4][2], const Unit& u, int wr, int wc, int fr, int fq) const {
        const int col0 = u.pn * HALF + wc * 32 + 8 * fq, bc0 = u.pn * BM + wc * 32 + 8 * fq;
        f32x4 bv[2][2];
#pragma unroll
        for (int bj = 0; bj < 2; ++bj)
#pragma unroll
            for (int n = 0; n < 2; ++n) bv[bj][n] = bias4(bias + bc0 + bj * HALF + 4 * n);
        float rms8[2][4];
#pragma unroll
        for (int ai = 0; ai < 2; ++ai)
#pragma unroll
            for (int m = 0; m < 4; ++m) rms8[ai][m] = rss_ms(rss, u.pm * BM + ai * HALF + wr * 64 + m * 16 + fr);
        asm volatile("" : "+v"(rms8[0][0]), "+v"(rms8[0][1]), "+v"(rms8[0][2]), "+v"(rms8[0][3]), "+v"(rms8[1][0]), "+v"(rms8[1][1]), "+v"(rms8[1][2]), "+v"(rms8[1][3]));
#pragma unroll
        for (int ai = 0; ai < 2; ++ai)
#pragma unroll
            for (int m = 0; m < 4; ++m) {
                const int row = u.pm * BM + ai * HALF + wr * 64 + m * 16 + fr;
                const float rstd = __builtin_amdgcn_rsqf(rms8[ai][m] + 1e-6f);
                float o[8];
#pragma unroll
                for (int n = 0; n < 2; ++n)
#pragma unroll
                    for (int j = 0; j < 4; ++j) { const float g = acc[ai][0][m][n][j] * rstd + bv[0][n][j], up = acc[ai][1][m][n][j] * rstd + bv[1][n][j]; o[4 * n + j] = g * __builtin_amdgcn_rcpf(1.f + __expf(-g)) * up; }
                u32x4 w; w.x = cvt_pk_bf16(o[0], o[1]); w.y = cvt_pk_bf16(o[2], o[3]); w.z = cvt_pk_bf16(o[4], o[5]); w.w = cvt_pk_bf16(o[6], o[7]);
                *(u32x4*)(hid + (size_t)row * FFN + col0) = w;
            }
    }
};
}

template <bool FOLD>
__device__ __forceinline__ void xpose_item(const float* W, int K, int N, bf16* WT, int k0, int n0, int drow0, LAS float* scr, int lane, const float* nw, const float* scale, const float* shift, float* bias, int qkswz = 0) {
    const int c4 = lane & 7, kk0 = lane >> 3; const bool ok = (n0 + 4 * c4) < N;
    f32x4 w[8];
#pragma unroll
    for (int i = 0; i < 8; ++i) w[i] = ok ? *(const f32x4*)(W + (size_t)(k0 + kk0 + 8 * i) * N + n0 + 4 * c4) : (f32x4){0.f, 0.f, 0.f, 0.f};
    f32x4 bsum = (f32x4){0.f, 0.f, 0.f, 0.f};
#pragma unroll
    for (int i = 0; i < 8; ++i) { const int kk = kk0 + 8 * i;
        if (FOLD) { bsum += w[i] * shift[k0 + kk]; w[i] *= nw[k0 + kk] * (1.0f + scale[k0 + kk]); }
        scr[kk * 33 + 4 * c4] = w[i].x; scr[kk * 33 + 4 * c4 + 1] = w[i].y; scr[kk * 33 + 4 * c4 + 2] = w[i].z; scr[kk * 33 + 4 * c4 + 3] = w[i].w; }
    if (FOLD) {
#pragma unroll
        for (int e = 0; e < 4; ++e) { float s = bsum[e]; s += shx<8>(s); s += shx<16>(s); s = xadd32(s); bsum[e] = s; }
        if (lane < 8 && ok) {
            { const int pc4 = (qkswz && (c4 == 1 || c4 == 2)) ? 3 - c4 : c4;
#pragma unroll
              for (int e = 0; e < 4; ++e) atomicAdd((int*)bias + drow0 + 4 * pc4 + e, __float2int_rn(bsum[e] * BIAS_Q)); } }
    }
    LDS_WAIT(); asm volatile("" ::: "memory");
    const int c = lane & 7;
#pragma unroll
    for (int j = 0; j < 4; ++j) { const int n = (lane >> 3) + 8 * j; const LAS float* s = scr + (8 * c) * 33 + n;
        v4u o; o.x = pk2(s[0 * 33], s[1 * 33]); o.y = pk2(s[2 * 33], s[3 * 33]); o.z = pk2(s[4 * 33], s[5 * 33]); o.w = pk2(s[6 * 33], s[7 * 33]);
        const int pn = (qkswz && n < 16 && ((n >> 2) == 1 || (n >> 2) == 2)) ? (n ^ 12) : n;
        *(GAS v4u*)(WT + (size_t)(drow0 + pn) * K + k0 + 8 * c) = o; }
    LDS_WAIT(); asm volatile("" ::: "memory");
}
__device__ __forceinline__ void p0_prologue(const Args& a, LAS unsigned char* lds, int tid, int lane, int wave, int G) {
    unsigned char* ws = wsp(a);
    {
        LAS float* cact = (LAS float*)lds; LAS float* red = (LAS float*)(lds + 4096);
        for (int i = tid; i < DM; i += 512) cact[i] = siluf(inp(a, I_C)[i]);
        __syncthreads();
        float* mod = (float*)(ws + WS_MOD);
        for (int item = bidx(); item < DEPTH * 96; item += G) {
            const int l = item / 96, j0 = (item % 96) * 64;
            const float* w = inp(a, I_ADAW) + ((size_t)l * DM + wave * 128) * 6144 + j0 + lane;
            float s = 0.f;
#pragma unroll 16
            for (int k = 0; k < 128; ++k) s += cact[wave * 128 + k] * w[(size_t)k * 6144];
            red[wave * 64 + lane] = s;
            __syncthreads();
            if (wave == 0) { float t = inp(a, I_ADAB)[l * 6144 + j0 + lane];
#pragma unroll
                for (int w8 = 0; w8 < 8; ++w8) t += red[w8 * 64 + lane];
                mod[l * 6144 + j0 + lane] = t; }
            __syncthreads();
        }
    }
    {
        typedef float f32x2 __attribute__((ext_vector_type(2)));
        f32x2* rope = (f32x2*)(ws + WS_ROPE);
        for (int idx = bidx() * 512 + tid; idx < SEQ * 8; idx += G * 512) {
            const int pos = idx >> 3, i = idx & 7;
            const float inv = (i == 0) ? 1.0f : (i == 1) ? 0.1939227432012558f : (i == 2) ? 0.03760603070259094f : (i == 3) ? 0.007292664609849453f : (i == 4) ? 0.0014142135623842478f
                            : (i == 5) ? 0.00027424818836152554f : (i == 6) ? 5.318296098266728e-05f : 1.0313386155758053e-05f;
            float s, c; sincos_d((float)pos * inv, s, c);
            rope[idx] = (f32x2){c, s};
        }
    }
    if (bidx() == 0) { float* gt = (float*)(ws + WS_GAINS);
        for (int i = tid; i < DEPTH * 4 * 64; i += 512) { const int l = i >> 8, t4 = (i >> 6) & 3, dd = i & 63; gt[i] = ((t4 == 0) ? inp(a, I_QNS) : (t4 == 1) ? inp(a, I_KNS) : (t4 == 2) ? inp(a, I_QNM) : inp(a, I_KNM))[l * HD + dd]; } }
    {
        bf16* win = (bf16*)(ws + WS_WIN);
        constexpr int PADCH = 224 * DM / 8;
        for (int i = bidx() * 512 + tid; i < DEPTH * PADCH; i += G * 512) { const int l = i / PADCH, r = i % PADCH;
            *(GAS v4u*)(win + (size_t)l * INP_PAD * DM + (size_t)4640 * DM + (size_t)r * 8) = (v4u){0u, 0u, 0u, 0u}; }
    }
    {
        const float* x = inp(a, I_X); bf16* hb = (bf16*)(ws + WS_H); float* rss = (float*)(ws + WS_CTL) + CW_RSS;
        for (int row = bidx() * NWAVES + wave; row < SEQ; row += G * NWAVES) {
            const f32x4* xr = (const f32x4*)(x + (size_t)row * DM) + lane; float s = 0.f;
            unsigned long long* o8 = (unsigned long long*)(hb + (size_t)row * DM) + lane;
#pragma unroll
            for (int j = 0; j < 4; ++j) { const f32x4 v = xr[64 * j]; s += (v.x * v.x + v.y * v.y) + (v.z * v.z + v.w * v.w); o8[64 * j] = (unsigned long long)pk2(v.x, v.y) | ((unsigned long long)pk2(v.z, v.w) << 32); }
            s = wave_sum(s);
            if (lane == 0) ((unsigned*)rss)[row] = (unsigned)__float2uint_rn(s * RSS_Q);
        }
    }
}
__device__ __forceinline__ void p0_weights(const Args& a, LAS unsigned char* lds, int lane, int wave, int G) {
    unsigned char* ws = wsp(a);
    {
        LAS float* scr = (LAS float*)(lds + wave * 16384);
        const int gw = bidx() * NWAVES + wave, NGW = G * NWAVES;
        constexpr int I_IN = 16 * 145, I_OUT = 24 * 32, I_G = 16 * 88, I_DN = 44 * 32, I_LAYER = I_IN + I_OUT + 2 * I_G + I_DN;
        bf16* win = (bf16*)(ws + WS_WIN); bf16* wout = (bf16*)(ws + WS_WOUT); bf16* wgu = (bf16*)(ws + WS_WGU); bf16* wdn = (bf16*)(ws + WS_WDN);
        const float* mod = (const float*)(ws + WS_MOD); float* ctlf = (float*)(ws + WS_CTL);
        for (int it = gw; it < DEPTH * I_LAYER; it += NGW) {
            const int l = it / I_LAYER; int r = it % I_LAYER; const float* md = mod + l * 6144;
            if (r < I_IN) { const int kb = r / 145, nb = r % 145, n0 = nb * 32;
                const int drow = (QKFUSE && n0 < 3072) ? (n0 & ~255) + 128 * ((n0 >> 5) & 1) + 32 * ((n0 >> 6) & 3) : n0;
                xpose_item<true>(inp(a, I_WIN) + (size_t)l * DM * INP, DM, INP, win + (size_t)l * INP_PAD * DM, kb * 64, n0, drow, scr, lane, inp(a, I_NMIX) + l * DM, md + 1024, md, ctlf + CW_BIAS_IN + l * INP_PAD, (QKFUSE && n0 < 3072 && ((n0 >> 9) % 3) != 2 && ((n0 >> 5) & 1) == 0) ? 1 : 0); continue; }
            r -= I_IN;
            if (r < I_OUT) { const int kb = r / 32, nb = r % 32; xpose_item<false>(inp(a, I_WOUT) + (size_t)l * MIXW * DM, MIXW, DM, wout + (size_t)l * DM * MIXW, kb * 64, nb * 32, nb * 32, scr, lane, nullptr, nullptr, nullptr, nullptr); continue; }
            r -= I_OUT;
            if (r < I_G) { const int kb = r / 88, n0 = (r % 88) * 32; xpose_item<true>(inp(a, I_WG) + (size_t)l * DM * FFN, DM, FFN, wgu + (size_t)l * GU * DM, kb * 64, n0, 256 * (n0 >> 7) + (n0 & 127), scr, lane, inp(a, I_NFFN) + l * DM, md + 4096, md + 3072, ctlf + CW_BIAS_GU + l * GU); continue; }
            r -= I_G;
            if (r < I_G) { const int kb = r / 88, n0 = (r % 88) * 32; xpose_item<true>(inp(a, I_WU) + (size_t)l * DM * FFN, DM, FFN, wgu + (size_t)l * GU * DM, kb * 64, n0, 256 * (n0 >> 7) + 128 + (n0 & 127), scr, lane, inp(a, I_NFFN) + l * DM, md + 4096, md + 3072, ctlf + CW_BIAS_GU + l * GU); continue; }
            r -= I_G;
            { const int kb = r / 32, nb = r % 32; xpose_item<false>(inp(a, I_WD) + (size_t)l * FFN * DM, FFN, DM, wdn + (size_t)l * DM * FFN, kb * 64, nb * 32, nb * 32, scr, lane, nullptr, nullptr, nullptr, nullptr); }
        }
    }
}

__device__ __forceinline__ void prep_phase(const Args& a, int L, LAS unsigned char* lds, int tid, int G) {
    unsigned char* ws = wsp(a);
    bf16* qkv = (bf16*)(ws + WS_QKV);
    typedef float f32x2 __attribute__((ext_vector_type(2)));
    const f32x2* rope = (const f32x2*)(ws + WS_ROPE);
    float* kmean = (float*)(ws + WS_KMEAN);
#if !QKFUSE
    for (int item = (a.flags & 1) ? 4 * NH * 64 : (int)blockIdx.x; item < 4 * NH * 64; item += G) {
        const int ts = item >> 9, h = (item >> 6) & 7, blk = item & 63;
        const int tsel = (ts < 2) ? ts : ts + 1;
        const float* gain = ((ts == 0) ? inp(a, I_QNS) : (ts == 1) ? inp(a, I_KNS) : (ts == 2) ? inp(a, I_QNM) : inp(a, I_KNM)) + L * HD;
        const int r = tid >> 1, hf = tid & 1, pos = blk * 256 + r;
        bf16* p = qkv + ((size_t)(tsel * 8 + h) * SEQ + pos) * 64 + hf * 32;
        float v[32];
#pragma unroll
        for (int i = 0; i < 4; ++i) unpack8(*(const v4u*)(p + 8 * i), v + 8 * i);
        float ss = 0.f;
#pragma unroll
        for (int i = 0; i < 32; ++i) ss += v[i] * v[i];
        ss += __shfl_xor(ss, 1);
        const float rstd = 1.0f / sqrtf(ss * (1.f / 64.f) + EPS);
        const float qs = (ts == 0 || ts == 2) ? C2 : 1.0f;
#pragma unroll
        for (int i = 0; i < 32; ++i) v[i] = v[i] * rstd * gain[hf * 32 + i] * qs;
        if (hf == 0) {
#pragma unroll
            for (int i = 0; i < 8; ++i) { const f32x2 cs = rope[pos * 8 + i]; const float x1 = v[i], x2 = v[i + 8]; v[i] = x1 * cs.x - x2 * cs.y; v[i + 8] = x2 * cs.x + x1 * cs.y; }
        }
#pragma unroll
        for (int i = 0; i < 4; ++i) { v4u w; w.x = pk2(v[8 * i], v[8 * i + 1]); w.y = pk2(v[8 * i + 2], v[8 * i + 3]); w.z = pk2(v[8 * i + 4], v[8 * i + 5]); w.w = pk2(v[8 * i + 6], v[8 * i + 7]); *(v4u*)(p + 8 * i) = w; }
        if (ts == 3) {
            LAS float* S = (LAS float*)lds;
#pragma unroll
            for (int i = 0; i < 32; ++i) S[r * 65 + hf * 32 + i] = v[i];
            __syncthreads();
            { const int col = tid & 63, part = tid >> 6; float s = 0.f;
#pragma unroll 8
                for (int rr = 0; rr < 32; ++rr) s += S[(part * 32 + rr) * 65 + col];
                __syncthreads();
                S[part * 65 + col] = s;
                __syncthreads();
                if (tid < 64) { float t = 0.f;
#pragma unroll
                    for (int pp = 0; pp < 8; ++pp) t += S[pp * 65 + tid];
                    kmean[(h * 64 + blk) * 64 + tid] = t; kmean[((8 + h) * 64 + blk) * 64 + tid] = 0.f; } }
            __syncthreads();
        }
    }
#endif
    {
        const bf16* xbc = (const bf16*)(ws + WS_XBC); bf16* xc = (bf16*)(ws + WS_XC);
        const float* cw = inp(a, I_CONVW) + (size_t)L * 4 * 1024; const float* cb = inp(a, I_CONVB) + (size_t)L * 1024;
        const float* dtraw = (const float*)(ws + WS_DT); float* csg = (float*)(ws + WS_CS);
        bf16* xdtT = (bf16*)((unsigned char*)outp(a) + XT_XDTT); bf16* xwT = (bf16*)((unsigned char*)outp(a) + XT_XWT); bf16* BT = (bf16*)(ws + WS_BT);
        const int lane = tid & 63, wave = tid >> 6;
        v4u praw[8], ph[3]; f32x4 pw[10];
        auto issue = [&](int item_) { const int c_ = item_ / 12, q_ = item_ % 12, l0_ = c_ * 256;
            const int chb_ = (q_ < 8) ? q_ * 64 : (q_ < 10) ? 512 + (q_ - 8) * 128 : 768 + (q_ - 10) * 128;
            const int oc_ = (q_ < 8) ? (tid & 7) : (tid & 15), rg_ = (q_ < 8) ? (tid >> 3) : (tid >> 4), nrow_ = (q_ < 8) ? 4 : 8, ch_ = chb_ + oc_ * 8, lb_ = rg_ * nrow_, p0_ = l0_ + lb_ - 3;
#pragma unroll
            for (int i = 0; i < 3; ++i) { const int pp = (p0_ + i < 0) ? 0 : p0_ + i; ph[i] = *(const v4u*)(xbc + (size_t)pp * 1024 + ch_); }
#pragma unroll
            for (int rr = 0; rr < 8; ++rr) if (rr < nrow_) praw[rr] = *(const v4u*)(xbc + (size_t)(l0_ + lb_ + rr) * 1024 + ch_);
#pragma unroll
            for (int jj = 0; jj < 4; ++jj) { pw[2 * jj] = *(const f32x4*)(cw + jj * 1024 + ch_); pw[2 * jj + 1] = *(const f32x4*)(cw + jj * 1024 + ch_ + 4); }
            pw[8] = *(const f32x4*)(cb + ch_); pw[9] = *(const f32x4*)(cb + ch_ + 4); };
        if ((int)bidx() < 64 * 12) issue((int)bidx());
        for (int item = bidx(); item < 64 * 12; item += G) {
            const int c = item / 12, q = item % 12, l0 = c * 256;
            const int chbase = (q < 8) ? q * 64 : (q < 10) ? 512 + (q - 8) * 128 : 768 + (q - 10) * 128;
            const int noct = (q < 8) ? 8 : 16;
            LAS float* xt = (LAS float*)lds;
            LAS bf16* bt = (LAS bf16*)lds;
            LAS float* csL = (LAS float*)(lds + 96 * 1024); LAS float* dtL = csL + 256;
            if (q < 8 && wave == 0) {
                const float av = -__expf(inp(a, I_ALOG)[L * 8 + q]), db = inp(a, I_DTB)[L * 8 + q];
                float dv[4], pc[4]; float run = 0.f;
#pragma unroll
                for (int i = 0; i < 4; ++i) { const float x = dtraw[(size_t)(l0 + 4 * lane + i) * 8 + q] + db; dv[i] = fmaxf(x, 0.f) + log1pf(__expf(-fabsf(x))); run += av * dv[i]; pc[i] = run; }
                float inc = run;
#pragma unroll
                for (int o = 1; o < 64; o <<= 1) { const float t = __builtin_bit_cast(float, __builtin_amdgcn_ds_bpermute(((lane - o) & 63) << 2, __builtin_bit_cast(int, inc))); if (lane >= o) inc += t; }
                const float ex = inc - run;
#pragma unroll
                for (int i = 0; i < 4; ++i) { csL[4 * lane + i] = ex + pc[i]; dtL[4 * lane + i] = dv[i]; }
                *(f32x4*)(csg + (size_t)(c * 8 + q) * 256 + 4 * lane) = (f32x4){ex + pc[0], ex + pc[1], ex + pc[2], ex + pc[3]};
            }
            {
                const int oc = (q < 8) ? (tid & 7) : (tid & 15), rg = (q < 8) ? (tid >> 3) : (tid >> 4), nrow = (q < 8) ? 4 : 8, ch = chbase + oc * 8, lb = rg * nrow;
                float wj[4][8], bs[8];
#pragma unroll
                for (int jj = 0; jj < 4; ++jj) { const f32x4 u = pw[2 * jj], v = pw[2 * jj + 1]; wj[jj][0] = u.x; wj[jj][1] = u.y; wj[jj][2] = u.z; wj[jj][3] = u.w; wj[jj][4] = v.x; wj[jj][5] = v.y; wj[jj][6] = v.z; wj[jj][7] = v.w; }
                { const f32x4 u = pw[8], v = pw[9]; bs[0] = u.x; bs[1] = u.y; bs[2] = u.z; bs[3] = u.w; bs[4] = v.x; bs[5] = v.y; bs[6] = v.z; bs[7] = v.w; }
                float x0[8], x1[8], x2[8], x3[8];
                { const int p0 = l0 + lb - 3;
                  if (p0 >= 0) unpack8(ph[0], x0); else {
#pragma unroll
                      for (int i = 0; i < 8; ++i) x0[i] = 0.f; }
                  if (p0 + 1 >= 0) unpack8(ph[1], x1); else {
#pragma unroll
                      for (int i = 0; i < 8; ++i) x1[i] = 0.f; }
                  if (p0 + 2 >= 0) unpack8(ph[2], x2); else {
#pragma unroll
                      for (int i = 0; i < 8; ++i) x2[i] = 0.f; } }
                v4u raw[8];
#pragma unroll
                for (int rr = 0; rr < 8; ++rr) if (rr < nrow) raw[rr] = praw[rr];
#pragma unroll
                for (int rr = 0; rr < 8; ++rr) {
                    if (rr < nrow) {
                    const int l = lb + rr, pos = l0 + l;
                    unpack8(raw[rr], x3);
                    float acc[8];
#pragma unroll
                    for (int i = 0; i < 8; ++i) acc[i] = siluf(bs[i] + wj[0][i] * x0[i] + wj[1][i] * x1[i] + wj[2][i] * x2[i] + wj[3][i] * x3[i]);
#pragma unroll
                    for (int i = 0; i < 8; ++i) { x0[i] = x1[i]; x1[i] = x2[i]; x2[i] = x3[i]; }
                    v4u w; w.x = pk2(acc[0], acc[1]); w.y = pk2(acc[2], acc[3]); w.z = pk2(acc[4], acc[5]); w.w = pk2(acc[6], acc[7]);
                    *(v4u*)(xc + (size_t)pos * 1024 + ch) = w;
                    if (q < 8) {
#pragma unroll
                        for (int i = 0; i < 8; ++i) xt[l * 65 + oc * 8 + i] = acc[i];
                    } else if (q < 10) { *(LAS v4u*)(bt + l * 136 + oc * 8) = w; }
                    }
                }
            }
            if (item + G < 64 * 12) issue(item + G);
            __syncthreads();
            if (q < 8) {
                const int p = tid & 63; const float cend = csL[255];
#pragma unroll
                for (int k = 0; k < 4; ++k) { const int lo = (tid >> 6) + 8 * k, lb = 8 * lo; float xd[8], xw[8];
#pragma unroll
                    for (int e = 0; e < 8; ++e) { const float x = xt[(lb + e) * 65 + p]; xd[e] = x * dtL[lb + e]; xw[e] = xd[e] * __expf(cend - csL[lb + e]); }
                    v4u w1, w2; w1.x = pk2(xd[0], xd[1]); w1.y = pk2(xd[2], xd[3]); w1.z = pk2(xd[4], xd[5]); w1.w = pk2(xd[6], xd[7]);
                    w2.x = pk2(xw[0], xw[1]); w2.y = pk2(xw[2], xw[3]); w2.z = pk2(xw[4], xw[5]); w2.w = pk2(xw[6], xw[7]);
                    const size_t o = ((size_t)(c * 8 + q) * 64 + p) * 256 + lb;
                    *(v4u*)(xdtT + o) = w1; *(v4u*)(xwT + o) = w2; }
            } else if (q < 10) {
                const int n = tid & 127;
#pragma unroll
                for (int k = 0; k < 8; ++k) { const int lo = (tid >> 7) + 4 * k, lb = 8 * lo; unsigned short e[8];
#pragma unroll
                    for (int i = 0; i < 8; ++i) e[i] = bt[(lb + i) * 136 + n];
                    v4u w; w.x = e[0] | ((unsigned)e[1] << 16); w.y = e[2] | ((unsigned)e[3] << 16); w.z = e[4] | ((unsigned)e[5] << 16); w.w = e[6] | ((unsigned)e[7] << 16);
                    *(v4u*)(BT + ((size_t)(c * 2 + (q - 8)) * 128 + n) * 256 + lb) = w; }
            }
            __syncthreads();
        }
    }
}

__device__ __forceinline__ float dot64(const float* q, const bf16* krow) {
    float s0 = 0.f, s1 = 0.f;
#pragma unroll
    for (int i = 0; i < 8; ++i) { const v4u w = *(const v4u*)(krow + 8 * i);
        s0 += q[8 * i] * bflo(w.x); s1 += q[8 * i + 1] * bfhi(w.x); s0 += q[8 * i + 2] * bflo(w.y); s1 += q[8 * i + 3] * bfhi(w.y);
        s0 += q[8 * i + 4] * bflo(w.z); s1 += q[8 * i + 5] * bfhi(w.z); s0 += q[8 * i + 6] * bflo(w.w); s1 += q[8 * i + 7] * bfhi(w.w); }
    return s0 + s1;
}
__device__ __forceinline__ void load_q64(const bf16* qrow, float* q) {
#pragma unroll
    for (int i = 0; i < 8; ++i) unpack8(*(const v4u*)(qrow + 8 * i), q + 8 * i);
}
typedef float f32x16 __attribute__((ext_vector_type(16)));
__device__ __forceinline__ int pi32(int r) { return (r & ~12) | ((r & 4) << 1) | ((r & 8) >> 1); }
__device__ __forceinline__ unsigned cvtpk(float lo, float hi) { unsigned r; asm volatile("v_cvt_pk_bf16_f32 %0, %1, %2" : "=v"(r) : "v"(lo), "v"(hi)); return r; }
__device__ __forceinline__ float dot2ones(unsigned w, float acc) { typedef __bf16 bf2_t __attribute__((ext_vector_type(2))); return __builtin_amdgcn_fdot2_f32_bf16(__builtin_bit_cast(bf2_t, w), __builtin_bit_cast(bf2_t, 0x3f803f80u), acc, false); }
__device__ __forceinline__ v4u pack8w(const f32x16& x, int b0) { v4u w; w.x = cvtpk(x[b0], x[b0 + 1]); w.y = cvtpk(x[b0 + 2], x[b0 + 3]); w.z = cvtpk(x[b0 + 4], x[b0 + 5]); w.w = cvtpk(x[b0 + 6], x[b0 + 7]); return w; }
__device__ __forceinline__ bf16x8 pack8(const f32x16& x, int b0) { v4u w; w.x = cvtpk(x[b0], x[b0 + 1]); w.y = cvtpk(x[b0 + 2], x[b0 + 3]); w.z = cvtpk(x[b0 + 4], x[b0 + 5]); w.w = cvtpk(x[b0 + 6], x[b0 + 7]); return __builtin_bit_cast(bf16x8, w); }
__device__ __forceinline__ bf16x8 cvt8(const float* p) { const f32x4 u = *(const f32x4*)p, v = *(const f32x4*)(p + 4); v4u w; w.x = cvtpk(u.x, u.y); w.y = cvtpk(u.z, u.w); w.z = cvtpk(v.x, v.y); w.w = cvtpk(v.z, v.w); return __builtin_bit_cast(bf16x8, w); }
__device__ __forceinline__ void ssd_states(unsigned char* ws, const unsigned char* xt, int lane, int gw, int NGW) {
    const bf16* xwT = (const bf16*)(xt + XT_XWT); const bf16* BT = (const bf16*)(ws + WS_BT); float* ST = (float*)(ws + WS_ST);
    const int r = lane & 31, hh = lane >> 5;
    for (int u = gw; u < 2048; u += NGW) {
        const int c = u >> 5, h = (u >> 2) & 7, j = u & 3, g = h >> 2;
        const bf16* A = xwT + (size_t)(c * 8 + h) * 64 * 256 + (size_t)r * 256 + hh * 8; const bf16* Bm = BT + (size_t)(c * 2 + g) * 128 * 256 + (size_t)(j * 32 + r) * 256 + hh * 8;
        f32x16 acc0 = f32x16{}, acc1 = f32x16{};
#pragma unroll
        for (int half = 0; half < 2; ++half) {
            bf16x8 a0[8], a1[8], bb[8];
#pragma unroll
            for (int k8 = 0; k8 < 8; ++k8) { const int ks = 8 * half + k8; a0[k8] = *(const bf16x8*)(A + ks * 16); a1[k8] = *(const bf16x8*)(A + 32 * 256 + ks * 16); bb[k8] = *(const bf16x8*)(Bm + ks * 16); }
            asm volatile("" : "+v"(a0[0]), "+v"(a0[1]), "+v"(a0[2]), "+v"(a0[3]), "+v"(a0[4]), "+v"(a0[5]), "+v"(a0[6]), "+v"(a0[7]), "+v"(a1[0]), "+v"(a1[1]), "+v"(a1[2]), "+v"(a1[3]), "+v"(a1[4]), "+v"(a1[5]), "+v"(a1[6]), "+v"(a1[7]),
                         "+v"(bb[0]), "+v"(bb[1]), "+v"(bb[2]), "+v"(bb[3]), "+v"(bb[4]), "+v"(bb[5]), "+v"(bb[6]), "+v"(bb[7]));
#pragma unroll
            for (int k8 = 0; k8 < 8; ++k8) { acc0 = __builtin_amdgcn_mfma_f32_32x32x16_bf16(a0[k8], bb[k8], acc0, 0, 0, 0); acc1 = __builtin_amdgcn_mfma_f32_32x32x16_bf16(a1[k8], bb[k8], acc1, 0, 0, 0); }
        }
        float* S = ST + (size_t)(c * 8 + h) * 64 * 128 + j * 32 + r;
#pragma unroll
        for (int reg = 0; reg < 16; ++reg) { const int p = (reg & 3) + 8 * (reg >> 2) + 4 * hh; S[(size_t)p * 128] = acc0[reg]; S[(size_t)(32 + p) * 128] = acc1[reg]; }
    }
}
__device__ __forceinline__ void ssd_scan(unsigned char* ws, unsigned char* xt, LAS unsigned char* lds, int tid, int G) {
    const float* ST = (const float*)(ws + WS_ST); bf16* STB = (bf16*)(xt + XT_STB); const float* csg = (const float*)(ws + WS_CS);
    LAS float* decL = (LAS float*)lds;
    for (int base = bidx() * 256; base < 8 * 8192; base += G * 256) {
        const int h = base >> 13, pn = (base & 8191) + (tid & 255);
        __syncthreads();
        if (tid < 64) decL[tid] = __expf(csg[(size_t)(tid * 8 + h) * 256 + 255]);
        __syncthreads();
        if (tid < 256) {
            float s[64];
#pragma unroll
            for (int c = 0; c < 64; ++c) s[c] = ST[(size_t)(c * 8 + h) * 8192 + pn];
            float hin = 0.f;
#pragma unroll
            for (int c = 0; c < 64; ++c) { STB[(size_t)(c * 8 + h) * 8192 + pn] = (bf16)f2bf(hin); hin = hin * decL[c] + s[c]; }
        }
    }
}
__device__ __forceinline__ void ssd_xt_tile(f32x16& acc0, f32x16& acc1, bf16x8 (&bfr)[8], const bf16x8 (&cf)[8], const bf16* At, const bf16* bnext, bool has_next, int st, const LAS float* csW, float csl, int lrel, int r, int hh) {
    f32x16 X = f32x16{};
#pragma unroll
    for (int k = 0; k < 8; ++k) X = __builtin_amdgcn_mfma_f32_32x32x16_bf16(bfr[k], cf[k], X, 0, 0, 0);
    const bf16x8 a00 = *(const bf16x8*)(At + (size_t)r * 256 + st * 32), a01 = *(const bf16x8*)(At + (size_t)r * 256 + st * 32 + 16);
    const bf16x8 a10 = *(const bf16x8*)(At + (size_t)(32 + r) * 256 + st * 32), a11 = *(const bf16x8*)(At + (size_t)(32 + r) * 256 + st * 32 + 16);
    if (has_next) {
#pragma unroll
        for (int k = 0; k < 8; ++k) bfr[k] = *(const bf16x8*)(bnext + k * 16); }
    f32x4 cw[4];
#pragma unroll
    for (int q4 = 0; q4 < 4; ++q4) cw[q4] = *(const LAS f32x4*)(csW + st * 32 + pi32(8 * q4 + 4 * hh));
    asm volatile("" : "+v"(cw[0]), "+v"(cw[1]), "+v"(cw[2]), "+v"(cw[3]));
#pragma unroll
    for (int q4 = 0; q4 < 4; ++q4) {
        const int s0 = st * 32 + pi32(8 * q4 + 4 * hh);
#pragma unroll
        for (int i = 0; i < 4; ++i) { const int reg = 4 * q4 + i; const float e = __expf(fminf(csl - cw[q4][i], 0.f)); X[reg] = (s0 + i <= lrel) ? X[reg] * e : 0.f; }
    }
    const bf16x8 m0 = pack8(X, 0), m1 = pack8(X, 8);
    acc0 = __builtin_amdgcn_mfma_f32_32x32x16_bf16(a00, m0, acc0, 0, 0, 0); acc0 = __builtin_amdgcn_mfma_f32_32x32x16_bf16(a01, m1, acc0, 0, 0, 0);
    acc1 = __builtin_amdgcn_mfma_f32_32x32x16_bf16(a10, m0, acc1, 0, 0, 0); acc1 = __builtin_amdgcn_mfma_f32_32x32x16_bf16(a11, m1, acc1, 0, 0, 0);
}
__device__ __forceinline__ void ssd_xt_tile_l(f32x16& acc0, f32x16& acc1, const LAS bf16* Bl, const bf16x8 (&cf)[8], const bf16* At, bf16x8 (&af)[4], bool has_next, int st, const LAS float* csW, float csl, int lrel, int r, int hh) {
    f32x16 X = f32x16{};
    const LAS bf16* br = Bl + (st * 32 + pi32(r)) * 136 + hh * 8;
    bf16x8 bk[8];
#pragma unroll
    for (int k = 0; k < 8; ++k) bk[k] = *(const LAS bf16x8*)(br + k * 16);
    asm volatile("" : "+v"(bk[0]), "+v"(bk[1]), "+v"(bk[2]), "+v"(bk[3]), "+v"(bk[4]), "+v"(bk[5]), "+v"(bk[6]), "+v"(bk[7]));
#pragma unroll
    for (int k = 0; k < 8; ++k) X = __builtin_amdgcn_mfma_f32_32x32x16_bf16(bk[k], cf[k], X, 0, 0, 0);
    const bf16x8 a00 = af[0], a01 = af[1], a10 = af[2], a11 = af[3];
    if (has_next) { af[0] = *(const bf16x8*)(At + (size_t)r * 256 + (st + 1) * 32); af[1] = *(const bf16x8*)(At + (size_t)r * 256 + (st + 1) * 32 + 16);
                    af[2] = *(const bf16x8*)(At + (size_t)(32 + r) * 256 + (st + 1) * 32); af[3] = *(const bf16x8*)(At + (size_t)(32 + r) * 256 + (st + 1) * 32 + 16); }
    f32x4 cw[4];
#pragma unroll
    for (int q4 = 0; q4 < 4; ++q4) cw[q4] = *(const LAS f32x4*)(csW + st * 32 + pi32(8 * q4 + 4 * hh));
    asm volatile("" : "+v"(cw[0]), "+v"(cw[1]), "+v"(cw[2]), "+v"(cw[3]));
#pragma unroll
    for (int q4 = 0; q4 < 4; ++q4) {
        const int s0 = st * 32 + pi32(8 * q4 + 4 * hh);
#pragma unroll
        for (int i = 0; i < 4; ++i) { const int reg = 4 * q4 + i; const float e = __expf(fminf(csl - cw[q4][i], 0.f)); X[reg] = (s0 + i <= lrel) ? X[reg] * e : 0.f; }
    }
    const bf16x8 m0 = pack8(X, 0), m1 = pack8(X, 8);
    acc0 = __builtin_amdgcn_mfma_f32_32x32x16_bf16(a00, m0, acc0, 0, 0, 0); acc0 = __builtin_amdgcn_mfma_f32_32x32x16_bf16(a01, m1, acc0, 0, 0, 0);
    acc1 = __builtin_amdgcn_mfma_f32_32x32x16_bf16(a10, m0, acc1, 0, 0, 0); acc1 = __builtin_amdgcn_mfma_f32_32x32x16_bf16(a11, m1, acc1, 0, 0, 0);
}
__device__ __forceinline__ void ssd_out(const Args& a, int L, LAS unsigned char* lds, int lane_in, int wave, int G) {
    unsigned char* ws = wsp(a);
    const bf16* xc = (const bf16*)(ws + WS_XC); const bf16* xdtT = (const bf16*)((const unsigned char*)outp(a) + XT_XDTT); const bf16* STB = (const bf16*)((const unsigned char*)outp(a) + XT_STB); const float* csg = (const float*)(ws + WS_CS);
    const bf16* Z = (const bf16*)(ws + WS_Z); bf16* mix = (bf16*)(ws + WS_MIX);
    LAS bf16* Bl = (LAS bf16*)lds;
    LAS unsigned char* wl = lds + ((wave < 6) ? 69632 + wave * 10240 : 132096 + (wave - 6) * 10240);
    LAS float* csW = (LAS float*)wl;
    LAS bf16* xt = (LAS bf16*)(wl + 1024);
    LAS bf16* zt = (LAS bf16*)(wl + 1024 + 4352);
    LAS float* nwL = (LAS float*)(wl + 1024 + 2 * 4352);
    LAS float* ssx = (LAS float*)(lds + 152576);
    typedef unsigned u32x2 __attribute__((ext_vector_type(2)));
    for (int unit = bidx(); unit < 256; unit += G) {
        int lane = lane_in; asm volatile("" : "+v"(lane));
        const int r = lane & 31, hh = lane >> 5;
        const int c = unit >> 2, g = (unit >> 1) & 1, hd = wave & 3, tpi = wave >> 2, tp = 2 * (unit & 1) + tpi, h = 4 * g + hd;
        {
            const int tid_ = wave * 64 + lane;
            v4u bt[8];
#pragma unroll
            for (int i = 0; i < 8; ++i) { const int id = tid_ + 512 * i; bt[i] = *(const v4u*)(xc + (size_t)(c * 256 + (id >> 4)) * 1024 + 512 + g * 128 + (id & 15) * 8); }
#pragma unroll
            for (int i = 0; i < 8; ++i) { const int id = tid_ + 512 * i; *(LAS v4u*)(Bl + (id >> 4) * 136 + (id & 15) * 8) = bt[i]; }
        }
        *(LAS f32x4*)(csW + 4 * lane) = *(const f32x4*)(csg + (size_t)(c * 8 + h) * 256 + 4 * lane);
        if (lane < 16) *(LAS f32x4*)(nwL + 4 * lane) = *(const f32x4*)(inp(a, I_SNORM) + L * 512 + h * 64 + 4 * lane);
        const float Dk = inp(a, I_DSKIP)[L * 8 + h];
        const bf16* At = xdtT + (size_t)(c * 8 + h) * 64 * 256 + hh * 8;
        const bf16* Hin = STB + (size_t)(c * 8 + h) * 8192 + hh * 8;
        LDS_WAIT(); asm volatile("" ::: "memory");
        __syncthreads();
        for (int ti = 0; ti < 2; ++ti) {
            const int w = ti ? 7 - tp : tp, l0 = 32 * w, posl = c * 256 + l0 + r;
            bf16x8 cf[8];
#pragma unroll
            for (int k = 0; k < 8; ++k) cf[k] = *(const bf16x8*)(xc + (size_t)posl * 1024 + 768 + g * 128 + k * 16 + hh * 8);
            bf16x8 af[4];
            af[0] = *(const bf16x8*)(At + (size_t)r * 256); af[1] = *(const bf16x8*)(At + (size_t)r * 256 + 16); af[2] = *(const bf16x8*)(At + (size_t)(32 + r) * 256); af[3] = *(const bf16x8*)(At + (size_t)(32 + r) * 256 + 16);
            f32x16 acc0 = f32x16{}, acc1 = f32x16{};
            if (!FLG(a, 64)) {
            bf16x8 h0[8], h1[8];
#pragma unroll
            for (int k = 0; k < 8; ++k) { h0[k] = *(const bf16x8*)(Hin + (size_t)r * 128 + k * 16); h1[k] = *(const bf16x8*)(Hin + (size_t)(32 + r) * 128 + k * 16); }
            asm volatile("" : "+v"(h0[0]), "+v"(h0[1]), "+v"(h0[2]), "+v"(h0[3]), "+v"(h0[4]), "+v"(h0[5]), "+v"(h0[6]), "+v"(h0[7]), "+v"(h1[0]), "+v"(h1[1]), "+v"(h1[2]), "+v"(h1[3]), "+v"(h1[4]), "+v"(h1[5]), "+v"(h1[6]), "+v"(h1[7]));
#pragma unroll
            for (int k = 0; k < 8; ++k) { acc0 = __builtin_amdgcn_mfma_f32_32x32x16_bf16(h0[k], cf[k], acc0, 0, 0, 0); acc1 = __builtin_amdgcn_mfma_f32_32x32x16_bf16(h1[k], cf[k], acc1, 0, 0, 0); } }
            const float csl = csW[l0 + r], el = __expf(csl);
#pragma unroll
            for (int i = 0; i < 16; ++i) { acc0[i] *= el; acc1[i] *= el; }
            v4u xvr[4], zvr[4];
#pragma unroll
            for (int k = 0; k < 4; ++k) { const int id = lane + 64 * k, row = id >> 3, oc = id & 7; const size_t pos = (size_t)(c * 256 + l0 + row);
                xvr[k] = *(const v4u*)(xc + pos * 1024 + h * 64 + oc * 8); zvr[k] = *(const v4u*)(Z + pos * 512 + h * 64 + oc * 8); }
            if (!FLG(a, 128)) for (int st = 0; st <= w; ++st) ssd_xt_tile_l(acc0, acc1, Bl, cf, At, af, st < w, st, csW, csl, l0 + r, r, hh);
            float ss = 0.f;
#pragma unroll
            for (int k = 0; k < 4; ++k) { const int id = lane + 64 * k, row = id >> 3, oc = id & 7;
                const v4u xv = xvr[k], zv = zvr[k];
                *(LAS u32x2*)(xt + row * 68 + oc * 8) = (u32x2){xv.x, xv.y}; *(LAS u32x2*)(xt + row * 68 + oc * 8 + 4) = (u32x2){xv.z, xv.w};
                *(LAS u32x2*)(zt + row * 68 + oc * 8) = (u32x2){zv.x, zv.y}; *(LAS u32x2*)(zt + row * 68 + oc * 8 + 4) = (u32x2){zv.z, zv.w}; }
            LDS_WAIT(); asm volatile("" ::: "memory");
            if (!FLG(a, 256))
#pragma unroll
            for (int q = 0; q < 4; ++q) { const int pb = 8 * q + 4 * hh;
                const u32x2 xa = *(const LAS u32x2*)(xt + r * 68 + pb), za = *(const LAS u32x2*)(zt + r * 68 + pb), xb = *(const LAS u32x2*)(xt + r * 68 + 32 + pb), zb = *(const LAS u32x2*)(zt + r * 68 + 32 + pb);
                const float x0[4] = {bflo(xa.x), bfhi(xa.x), bflo(xa.y), bfhi(xa.y)}, z0[4] = {bflo(za.x), bfhi(za.x), bflo(za.y), bfhi(za.y)};
                const float x1[4] = {bflo(xb.x), bfhi(xb.x), bflo(xb.y), bfhi(xb.y)}, z1[4] = {bflo(zb.x), bfhi(zb.x), bflo(zb.y), bfhi(zb.y)};
#pragma unroll
                for (int i = 0; i < 4; ++i) { const int reg = 4 * q + i;
                    { const float gv = (acc0[reg] + Dk * x0[i]) * siluf(z0[i]); acc0[reg] = gv; ss += gv * gv; }
                    { const float gv = (acc1[reg] + Dk * x1[i]) * siluf(z1[i]); acc1[reg] = gv; ss += gv * gv; } } }
            LDS_WAIT(); asm volatile("" ::: "memory");
            ss = xadd32(ss);
            if (lane < 32) ssx[(tpi * 4 + hd) * 32 + r] = ss;
            __syncthreads();
            const LAS float* sp = ssx + tpi * 128 + r;
            const float sst = (sp[0] + sp[32]) + (sp[64] + sp[96]);
            const float rstd = __builtin_amdgcn_rsqf(sst * (1.f / 256.f) + EPS);
#pragma unroll
            for (int q = 0; q < 4; ++q) { const int pb = 8 * q + 4 * hh; const f32x4 n0 = *(const LAS f32x4*)(nwL + pb), n1 = *(const LAS f32x4*)(nwL + 32 + pb);
                *(LAS u32x2*)(xt + r * 68 + pb) = (u32x2){cvtpk(acc0[4 * q] * rstd * n0[0], acc0[4 * q + 1] * rstd * n0[1]), cvtpk(acc0[4 * q + 2] * rstd * n0[2], acc0[4 * q + 3] * rstd * n0[3])};
                *(LAS u32x2*)(xt + r * 68 + 32 + pb) = (u32x2){cvtpk(acc1[4 * q] * rstd * n1[0], acc1[4 * q + 1] * rstd * n1[1]), cvtpk(acc1[4 * q + 2] * rstd * n1[2], acc1[4 * q + 3] * rstd * n1[3])}; }
            LDS_WAIT(); asm volatile("" ::: "memory");
            u32x2 lo[4], hi[4];
#pragma unroll
            for (int k = 0; k < 4; ++k) { const int id = lane + 64 * k, row = id >> 3, oc = id & 7; lo[k] = *(const LAS u32x2*)(xt + row * 68 + oc * 8); hi[k] = *(const LAS u32x2*)(xt + row * 68 + oc * 8 + 4); }
            asm volatile("" : "+v"(lo[0]), "+v"(lo[1]), "+v"(lo[2]), "+v"(lo[3]), "+v"(hi[0]), "+v"(hi[1]), "+v"(hi[2]), "+v"(hi[3]));
#pragma unroll
            for (int k = 0; k < 4; ++k) { const int id = lane + 64 * k, row = id >> 3, oc = id & 7; const size_t pos = (size_t)(c * 256 + l0 + row);
                *(v4u*)(mix + pos * MIXW + 512 + h * 64 + oc * 8) = (v4u){lo[k].x, lo[k].y, hi[k].x, hi[k].y}; }
            LDS_WAIT(); asm volatile("" ::: "memory");
            __syncthreads();
        }
    }
}
struct AttnAcc { f32x16 o0, o1, negm; float l; };
typedef short v4i16_t __attribute__((ext_vector_type(4)));
__device__ __forceinline__ v4i16_t vtr(const LAS bf16* p) { return __builtin_amdgcn_ds_read_tr16_b64_v4i16((LAS v4i16_t*)p); }
struct TileD { int koff, kstride; bool on, mask; };
struct TileR { bf16x8 kf[4]; v4u vv[4]; };
__device__ __forceinline__ void attn_load(TileR& R, const TileD& d, const bf16* Kh, const bf16* Vh, int lane) {
    const int r = lane & 31, hh = lane >> 5;
    int kpa = d.koff + d.kstride * pi32(r); kpa = kpa < 0 ? 0 : (kpa > SEQ - 1 ? SEQ - 1 : kpa);
#pragma unroll
    for (int k = 0; k < 4; ++k) R.kf[k] = *(const bf16x8*)(Kh + (size_t)kpa * 64 + k * 16 + hh * 8);
#pragma unroll
    for (int k = 0; k < 4; ++k) { const int id = lane + 64 * k, key = id >> 3, oc = id & 7; int kp = d.koff + d.kstride * key; kp = kp < 0 ? 0 : (kp > SEQ - 1 ? SEQ - 1 : kp);
        R.vv[k] = *(const v4u*)(Vh + (size_t)kp * 64 + oc * 8); }
}
template <int MASK>
__device__ __forceinline__ void attn_compute(AttnAcc& A, const bf16x8 (&qf)[4], const TileR& R, const TileD& d, int qp, LAS bf16* vt, int lane) {
    const int r = lane & 31, hh = lane >> 5; (void)r;
    const int koff = d.koff, kstride = d.kstride;
#pragma unroll
    for (int k = 0; k < 4; ++k) { const int id = lane + 64 * k, key = id >> 3, oc = id & 7; *(LAS v4u*)(vt + key * 64 + oc * 8) = R.vv[k]; }
    f32x16 X = __builtin_amdgcn_mfma_f32_32x32x16_bf16(R.kf[0], qf[0], A.negm, 0, 0, 0);
#pragma unroll
    for (int k = 1; k < 4; ++k) X = __builtin_amdgcn_mfma_f32_32x32x16_bf16(R.kf[k], qf[k], X, 0, 0, 0);
    if (MASK != 0 && d.mask) {
        const int dq0 = qp - koff; const unsigned lim = (MASK == 1) ? 0x7fffffffu : (unsigned)(128 * kstride);
        if (koff >= 0) {
#pragma unroll
            for (int reg = 0; reg < 16; ++reg) { const int c = pi32((reg & 3) + 8 * (reg >> 2)) ; const unsigned dq = (unsigned)(dq0 - kstride * (c + 8 * hh)); X[reg] = (dq <= lim) ? X[reg] : -INFINITY; }
        } else {
#pragma unroll
            for (int reg = 0; reg < 16; ++reg) { const int c = pi32((reg & 3) + 8 * (reg >> 2)); const int kq = kstride * (c + 8 * hh); const unsigned dq = (unsigned)(dq0 - kq); X[reg] = (dq <= lim && koff + kq >= 0) ? X[reg] : -INFINITY; }
        }
    }
    float ls = 0.f;
#pragma unroll
    for (int reg = 0; reg < 16; ++reg) { X[reg] = __builtin_amdgcn_exp2f(X[reg]); ls += X[reg]; }
    A.l += ls;
    const bf16x8 p0 = pack8(X, 0), p1 = pack8(X, 8);
    LDS_WAIT(); asm volatile("" ::: "memory");
    const LAS bf16* vb = vt + (8 * hh + ((lane & 15) >> 2)) * 64 + 16 * ((lane >> 4) & 1) + 4 * (lane & 3);
#pragma unroll
    for (int dt = 0; dt < 2; ++dt) {
        const v4i16_t a0 = vtr(vb + dt * 32), a1 = vtr(vb + dt * 32 + 4 * 64), a2 = vtr(vb + dt * 32 + 16 * 64), a3 = vtr(vb + dt * 32 + 20 * 64);
        const bf16x8 f0 = (bf16x8){a0[0], a0[1], a0[2], a0[3], a1[0], a1[1], a1[2], a1[3]}, f1 = (bf16x8){a2[0], a2[1], a2[2], a2[3], a3[0], a3[1], a3[2], a3[3]};
        if (dt == 0) { A.o0 = __builtin_amdgcn_mfma_f32_32x32x16_bf16(f0, p0, A.o0, 0, 0, 0); A.o0 = __builtin_amdgcn_mfma_f32_32x32x16_bf16(f1, p1, A.o0, 0, 0, 0); }
        else { A.o1 = __builtin_amdgcn_mfma_f32_32x32x16_bf16(f0, p0, A.o1, 0, 0, 0); A.o1 = __builtin_amdgcn_mfma_f32_32x32x16_bf16(f1, p1, A.o1, 0, 0, 0); }
    }
    LDS_WAIT(); asm volatile("" ::: "memory");
}
template <int MASK, class TF>
__device__ __forceinline__ void attn_run(AttnAcc& A, const bf16x8 (&qf)[4], const bf16* Kh, const bf16* Vh, int qp, LAS bf16* vt, int lane, int ntiles, const TF& tf) {
    TileD d0 = tf(0), d1; TileR R0, R1;
    if (d0.on) attn_load(R0, d0, Kh, Vh, lane);
    for (int n = 0; n < ntiles; n += 2) {
        d1 = (n + 1 < ntiles) ? tf(n + 1) : TileD{0, 1, false, false};
        if (d1.on) attn_load(R1, d1, Kh, Vh, lane);
        if (d0.on) attn_compute<MASK>(A, qf, R0, d0, qp, vt, lane);
        d0 = (n + 2 < ntiles) ? tf(n + 2) : TileD{0, 1, false, false};
        if (d0.on) attn_load(R0, d0, Kh, Vh, lane);
        if (d1.on) attn_compute<MASK>(A, qf, R1, d1, qp, vt, lane);
    }
}
template <int MASK>
__device__ __forceinline__ void attn_run_fast(AttnAcc& A, const bf16x8 (&qf)[4], const bf16* Kh, const bf16* Vh, int qp, LAS bf16* vt, LAS bf16* kt, int lane, int ntiles, int koff0, int kstride, unsigned maskbits) {
    const int r = lane & 31, hh = lane >> 5;
    const size_t rowoff = (size_t)(koff0 + kstride * (lane >> 3)) * 64 + (lane & 7) * 8;
    const bf16* kp = Kh + rowoff; const bf16* vp = Vh + rowoff;
    const int tstep = 32 * kstride * 64, vstep = 8 * kstride * 64;
    v4u kk[4], vv[4];
#pragma unroll
    for (int k = 0; k < 4; ++k) { kk[k] = *(const v4u*)(kp + (size_t)k * vstep); vv[k] = *(const v4u*)(vp + (size_t)k * vstep); }
    const int wrow = lane >> 3, woc = lane & 7;
    const int rho = pi32(r);
    int koff = koff0;
#pragma unroll 1
    for (int n = 0; n < ntiles; ++n) {
        const bool more = (n + 1 < ntiles);
        kp += tstep; vp += tstep;
#pragma unroll
        for (int k = 0; k < 4; ++k) { const int key = wrow + 8 * k; *(LAS v4u*)(kt + key * 64 + ((woc ^ (key & 7)) * 8)) = kk[k]; *(LAS v4u*)(vt + key * 64 + woc * 8) = vv[k]; }
        if (more) {
#pragma unroll
            for (int k = 0; k < 4; ++k) { kk[k] = *(const v4u*)(kp + (size_t)k * vstep); vv[k] = *(const v4u*)(vp + (size_t)k * vstep); } }
        bf16x8 kf[4];
#pragma unroll
        for (int k = 0; k < 4; ++k) kf[k] = *(const LAS bf16x8*)(kt + rho * 64 + (((2 * k + hh) ^ (rho & 7)) * 8));
        f32x16 X = __builtin_amdgcn_mfma_f32_32x32x16_bf16(kf[0], qf[0], A.negm, 0, 0, 0);
#pragma unroll
        for (int k = 1; k < 4; ++k) X = __builtin_amdgcn_mfma_f32_32x32x16_bf16(kf[k], qf[k], X, 0, 0, 0);
        if (MASK != 0 && ((maskbits >> n) & 1u)) {
            const int dq0 = qp - koff; const unsigned lim = (MASK == 1) ? 0x7fffffffu : (unsigned)(128 * kstride);
#pragma unroll
            for (int reg = 0; reg < 16; ++reg) { const int c = pi32((reg & 3) + 8 * (reg >> 2)); const unsigned dq = (unsigned)(dq0 - kstride * (c + 8 * hh)); X[reg] = (dq <= lim) ? X[reg] : -INFINITY; }
        }
        float ls = 0.f;
#pragma unroll
        for (int reg = 0; reg < 16; ++reg) { X[reg] = __builtin_amdgcn_exp2f(X[reg]); ls += X[reg]; }
        A.l += ls;
        const bf16x8 p0 = pack8(X, 0), p1 = pack8(X, 8);
        const LAS bf16* vb = vt + (8 * hh + ((lane & 15) >> 2)) * 64 + 16 * ((lane >> 4) & 1) + 4 * (lane & 3);
#pragma unroll
        for (int dt = 0; dt < 2; ++dt) {
            const v4i16_t a0 = vtr(vb + dt * 32), a1 = vtr(vb + dt * 32 + 4 * 64), a2 = vtr(vb + dt * 32 + 16 * 64), a3 = vtr(vb + dt * 32 + 20 * 64);
            const bf16x8 f0 = (bf16x8){a0[0], a0[1], a0[2], a0[3], a1[0], a1[1], a1[2], a1[3]}, f1 = (bf16x8){a2[0], a2[1], a2[2], a2[3], a3[0], a3[1], a3[2], a3[3]};
            if (dt == 0) { A.o0 = __builtin_amdgcn_mfma_f32_32x32x16_bf16(f0, p0, A.o0, 0, 0, 0); A.o0 = __builtin_amdgcn_mfma_f32_32x32x16_bf16(f1, p1, A.o0, 0, 0, 0); }
            else { A.o1 = __builtin_amdgcn_mfma_f32_32x32x16_bf16(f0, p0, A.o1, 0, 0, 0); A.o1 = __builtin_amdgcn_mfma_f32_32x32x16_bf16(f1, p1, A.o1, 0, 0, 0); }
        }
        koff += 32 * kstride;
    }
}
struct AttnAcc2 { f32x16 o0[2], o1[2]; float l[2], nB; };
template <int MASK>
__device__ __forceinline__ void attn_run_fast2(AttnAcc2& A, const bf16x8 (&qf)[2][4], const bf16* Kh, const bf16* Vh, const int (&qp)[2], LAS bf16* vt, LAS bf16* kt, int lane, int ntiles, int koff0, int kstride,
                                               const unsigned (&skip)[2], const unsigned (&maskb)[2], int n_start = 0) {
    const int r = lane & 31, hh = lane >> 5;
    const size_t rowoff = (size_t)(koff0 + kstride * (32 * n_start + (lane >> 3))) * 64 + (lane & 7) * 8;
    const bf16* kp = Kh + rowoff; const bf16* vp = Vh + rowoff;
    const int tstep = 32 * kstride * 64, vstep = 8 * kstride * 64;
    v4u kk[4], vv[4];
#pragma unroll
    for (int k = 0; k < 4; ++k) { kk[k] = *(const v4u*)(kp + (size_t)k * vstep); vv[k] = *(const v4u*)(vp + (size_t)k * vstep); }
    const int wrow = lane >> 3, woc = lane & 7, rho = pi32(r);
    int koff = koff0 + 32 * kstride * n_start;
#pragma unroll 1
    for (int n = n_start; n < ntiles; ++n) {
        const bool more = (n + 1 < ntiles);
        kp += tstep; vp += tstep;
#pragma unroll
        for (int k = 0; k < 4; ++k) { const int key = wrow + 8 * k; *(LAS v4u*)(kt + key * 64 + ((woc ^ ((key >> 1) & 7)) * 8)) = kk[k]; *(LAS v4u*)(vt + key * 64 + ((woc ^ (4 * ((key >> 1) & 1))) * 8)) = vv[k]; }
        if (more) {
#pragma unroll
            for (int k = 0; k < 4; ++k) { kk[k] = *(const v4u*)(kp + (size_t)k * vstep); vv[k] = *(const v4u*)(vp + (size_t)k * vstep); } }
        bf16x8 kf[4];
#pragma unroll
        for (int k = 0; k < 4; ++k) kf[k] = *(const LAS bf16x8*)(kt + rho * 64 + (((2 * k + hh) ^ ((rho >> 1) & 7)) * 8));
        const LAS bf16* vb = vt + (8 * hh + ((lane & 15) >> 2)) * 64 + ((16 * ((lane >> 4) & 1) + 4 * (lane & 3)) ^ (32 * ((lane >> 3) & 1)));
        bf16x8 vf[2][2];
#pragma unroll
        for (int dt = 0; dt < 2; ++dt) {
            const LAS bf16* vd = dt ? (const LAS bf16*)((unsigned)(size_t)vb ^ 64u) : vb;
            const v4i16_t a0 = vtr(vd), a1 = vtr(vd + 4 * 64), a2 = vtr(vd + 16 * 64), a3 = vtr(vd + 20 * 64);
            vf[dt][0] = (bf16x8){a0[0], a0[1], a0[2], a0[3], a1[0], a1[1], a1[2], a1[3]}; vf[dt][1] = (bf16x8){a2[0], a2[1], a2[2], a2[3], a3[0], a3[1], a3[2], a3[3]};
        }
#pragma unroll
        for (int g = 0; g < 2; ++g) {
            if ((skip[g] >> n) & 1u) continue;
            f32x16 X = __builtin_amdgcn_mfma_f32_32x32x16_bf16(kf[0], qf[g][0], f32x16{}, 0, 0, 0);
#pragma unroll
            for (int k = 1; k < 4; ++k) X = __builtin_amdgcn_mfma_f32_32x32x16_bf16(kf[k], qf[g][k], X, 0, 0, 0);
            if (MASK != 0 && ((maskb[g] >> n) & 1u)) {
                const int dq0 = qp[g] - koff; const unsigned lim = (MASK == 1) ? 0x7fffffffu : (unsigned)(128 * kstride);
#pragma unroll
                for (int reg = 0; reg < 16; ++reg) { const int c = pi32((reg & 3) + 8 * (reg >> 2)); const unsigned dq = (unsigned)(dq0 - kstride * (c + 8 * hh)); X[reg] = (dq <= lim) ? X[reg] : -INFINITY; }
            }
            float ls = 0.f;
#pragma unroll
            for (int reg = 0; reg < 16; ++reg) { X[reg] = __builtin_amdgcn_exp2f(X[reg] + A.nB); ls += X[reg]; }
            A.l[g] += ls;
            const bf16x8 p0 = pack8(X, 0), p1 = pack8(X, 8);
            A.o0[g] = __builtin_amdgcn_mfma_f32_32x32x16_bf16(vf[0][0], p0, A.o0[g], 0, 0, 0); A.o0[g] = __builtin_amdgcn_mfma_f32_32x32x16_bf16(vf[0][1], p1, A.o0[g], 0, 0, 0);
            A.o1[g] = __builtin_amdgcn_mfma_f32_32x32x16_bf16(vf[1][0], p0, A.o1[g], 0, 0, 0); A.o1[g] = __builtin_amdgcn_mfma_f32_32x32x16_bf16(vf[1][1], p1, A.o1[g], 0, 0, 0);
        }
        koff += 32 * kstride;
    }
}
__device__ __forceinline__ void attn_run_lds2(AttnAcc2& A, const bf16x8 (&qf)[2][4], const LAS bf16* ktS, const LAS bf16* vtS, int lane, int ntiles, const unsigned (&skip)[2]) {
    const int r = lane & 31, hh = lane >> 5, rho = pi32(r);
    const LAS bf16* kb = ktS + rho * 64;
    const LAS bf16* vb = vtS + (8 * hh + ((lane & 15) >> 2)) * 64 + ((16 * ((lane >> 4) & 1) + 4 * (lane & 3)) ^ (32 * ((lane >> 3) & 1)));
    f32x16 NB16;
#pragma unroll
    for (int i = 0; i < 16; ++i) NB16[i] = A.nB;
    asm volatile("" : "+v"(NB16));
    const bool both = (skip[1] == 0u);
    auto frags = [&](bf16x8 (&kf)[4], bf16x8 (&vf)[2][2]) {
#pragma unroll
        for (int k = 0; k < 4; ++k) kf[k] = *(const LAS bf16x8*)(kb + (((2 * k + hh) ^ ((rho >> 1) & 7)) * 8));
#pragma unroll
        for (int dt = 0; dt < 2; ++dt) {
            const LAS bf16* vd = dt ? (const LAS bf16*)((unsigned)(size_t)vb ^ 64u) : vb;
            const v4i16_t a0 = vtr(vd), a1 = vtr(vd + 4 * 64), a2 = vtr(vd + 16 * 64), a3 = vtr(vd + 20 * 64);
            vf[dt][0] = (bf16x8){a0[0], a0[1], a0[2], a0[3], a1[0], a1[1], a1[2], a1[3]}; vf[dt][1] = (bf16x8){a2[0], a2[1], a2[2], a2[3], a3[0], a3[1], a3[2], a3[3]};
        }
        kb += 2048; vb += 2048; };
    auto qk = [&](int g, const bf16x8 (&kf)[4]) { f32x16 X = __builtin_amdgcn_mfma_f32_32x32x16_bf16(kf[0], qf[g][0], NB16, 0, 0, 0);
#pragma unroll
        for (int k = 1; k < 4; ++k) X = __builtin_amdgcn_mfma_f32_32x32x16_bf16(kf[k], qf[g][k], X, 0, 0, 0);
        return X; };
    auto soft_pv = [&](int g, f32x16 X, const bf16x8 (&vf)[2][2]) {
#pragma unroll
        for (int reg = 0; reg < 16; ++reg) X[reg] = __builtin_amdgcn_exp2f(X[reg]);
        const v4u w0 = pack8w(X, 0), w1 = pack8w(X, 8);
        float la = A.l[g], lb = 0.f;
        la = dot2ones(w0.x, la); lb = dot2ones(w0.y, lb); la = dot2ones(w0.z, la); lb = dot2ones(w0.w, lb);
        la = dot2ones(w1.x, la); lb = dot2ones(w1.y, lb); la = dot2ones(w1.z, la); lb = dot2ones(w1.w, lb);
        A.l[g] = la + lb;
        bf16x8 p0, p1; __builtin_memcpy(&p0, &w0, 16); __builtin_memcpy(&p1, &w1, 16);
        A.o0[g] = __builtin_amdgcn_mfma_f32_32x32x16_bf16(vf[0][0], p0, A.o0[g], 0, 0, 0); A.o0[g] = __builtin_amdgcn_mfma_f32_32x32x16_bf16(vf[0][1], p1, A.o0[g], 0, 0, 0);
        A.o1[g] = __builtin_amdgcn_mfma_f32_32x32x16_bf16(vf[1][0], p0, A.o1[g], 0, 0, 0); A.o1[g] = __builtin_amdgcn_mfma_f32_32x32x16_bf16(vf[1][1], p1, A.o1[g], 0, 0, 0); };
    if (both) {
#pragma unroll 1
        for (int n = 0; n < ntiles; ++n) {
            bf16x8 kf[4], vf[2][2]; frags(kf, vf);
            const f32x16 X0 = qk(0, kf), X1 = qk(1, kf);
            soft_pv(0, X0, vf); soft_pv(1, X1, vf);
        }
    } else {
#pragma unroll 1
        for (int n = 0; n < ntiles; ++n) {
            bf16x8 kf[4], vf[2][2]; frags(kf, vf);
            if ((skip[0] >> n) & 1u) continue;
            soft_pv(0, qk(0, kf), vf);
        }
    }
}
__device__ __forceinline__ void attn_init2(AttnAcc2& A, float nB) {
#pragma unroll
    for (int g = 0; g < 2; ++g) { A.o0[g] = f32x16{}; A.o1[g] = f32x16{}; A.l[g] = 0.f; }
    A.nB = nB;
}
__device__ __forceinline__ void attn_init(AttnAcc& A, float nB) { A.o0 = f32x16{}; A.o1 = f32x16{};
#pragma unroll
    for (int i = 0; i < 16; ++i) A.negm[i] = nB;
    A.l = 0.f; }
__device__ __forceinline__ float attn_negB(const float* gq, const float* gk, int lane) { return __builtin_bit_cast(float, __builtin_amdgcn_readfirstlane(__builtin_bit_cast(int, -64.0f * C2 * wave_max(fabsf(gq[lane])) * wave_max(fabsf(gk[lane]))))); }
__device__ __forceinline__ void attn_store_rows2(const f32x16& o0, const f32x16& o1, float sc, LAS bf16* ot, bf16* dst0, size_t row_stride, int lane) {
    const int r = lane & 31, hh = lane >> 5;
    typedef unsigned u32x2 __attribute__((ext_vector_type(2)));
#pragma unroll
    for (int q = 0; q < 4; ++q) { const int db = 8 * q + 4 * hh;
        *(LAS u32x2*)(ot + r * 68 + db) = (u32x2){cvtpk(o0[4 * q] * sc, o0[4 * q + 1] * sc), cvtpk(o0[4 * q + 2] * sc, o0[4 * q + 3] * sc)};
        *(LAS u32x2*)(ot + r * 68 + 32 + db) = (u32x2){cvtpk(o1[4 * q] * sc, o1[4 * q + 1] * sc), cvtpk(o1[4 * q + 2] * sc, o1[4 * q + 3] * sc)}; }
    LDS_WAIT(); asm volatile("" ::: "memory");
    u32x2 lo[4], hi[4];
#pragma unroll
    for (int k = 0; k < 4; ++k) { const int id = lane + 64 * k, row = id >> 3, oc = id & 7; lo[k] = *(const LAS u32x2*)(ot + row * 68 + oc * 8); hi[k] = *(const LAS u32x2*)(ot + row * 68 + oc * 8 + 4); }
    asm volatile("" : "+v"(lo[0]), "+v"(lo[1]), "+v"(lo[2]), "+v"(lo[3]), "+v"(hi[0]), "+v"(hi[1]), "+v"(hi[2]), "+v"(hi[3]));
#pragma unroll
    for (int k = 0; k < 4; ++k) { const int id = lane + 64 * k, row = id >> 3, oc = id & 7;
        *(v4u*)(dst0 + (size_t)row * row_stride + oc * 8) = (v4u){lo[k].x, lo[k].y, hi[k].x, hi[k].y}; }
    LDS_WAIT(); asm volatile("" ::: "memory");
}
__device__ __forceinline__ void attn_store_rows(const AttnAcc& A, float sc, LAS bf16* ot, bf16* dst0, size_t row_stride, int lane) { attn_store_rows2(A.o0, A.o1, sc, ot, dst0, row_stride, lane); }
__device__ __forceinline__ void swa_pass(const Args& a, int L, LAS unsigned char* lds, int lane, int wave, int G) {
    unsigned char* ws = wsp(a);
    const float nB = attn_negB(inp(a, I_QNS) + L * HD, inp(a, I_KNS) + L * HD, lane);
    const int h = (int)bidx() & 7, slot = ((int)bidx() >> 3) * NWAVES + wave, nslots = (G >> 3) * NWAVES;
    const bf16* Q = (const bf16*)(ws + WS_QKV) + (size_t)(0 * 8 + h) * SEQ * 64; const bf16* K = (const bf16*)(ws + WS_QKV) + (size_t)(1 * 8 + h) * SEQ * 64;
    const bf16* V = (const bf16*)(ws + WS_QKV) + (size_t)(2 * 8 + h) * SEQ * 64;
    bf16* mix = (bf16*)(ws + WS_MIX); float* SL = (float*)(ws + WS_PS) + (size_t)SEQ * 8 * 3;
    LAS bf16* vt = (LAS bf16*)(lds + wave * 12800); LAS bf16* kt = (LAS bf16*)(lds + wave * 12800 + 4096); LAS bf16* ot = (LAS bf16*)(lds + wave * 12800 + 8192);
    const int r = lane & 31, hh = lane >> 5;
    bf16x8 qn[2][4];
    auto qload = [&](int uu_) { const int br_ = uu_ >> 8, tt_ = uu_ & 255, dsh_ = 2 * br_, d_ = 1 << dsh_, rr_ = tt_ & (d_ - 1), u0_ = 64 * (tt_ >> dsh_);
#pragma unroll
        for (int g = 0; g < 2; ++g) { const int qp_ = rr_ + d_ * (u0_ + 32 * g + r);
#pragma unroll
            for (int k = 0; k < 4; ++k) qn[g][k] = *(const bf16x8*)(Q + (size_t)qp_ * 64 + k * 16 + hh * 8); } };
    if (slot < 768) qload(slot);
    for (int uu = slot; uu < 768; uu += nslots) {
        const int br = uu >> 8, tt = uu & 255, dsh = 2 * br, d = 1 << dsh, rr = tt & (d - 1), u0 = 64 * (tt >> dsh);
        bf16x8 qf[2][4]; int qp[2];
#pragma unroll
        for (int g = 0; g < 2; ++g) { qp[g] = rr + d * (u0 + 32 * g + r);
#pragma unroll
            for (int k = 0; k < 4; ++k) qf[g][k] = qn[g][k]; }
        AttnAcc2 A; attn_init2(A, nB);
        const unsigned sk[2] = {0x20u, 0x01u}, mk[2] = {0x11u, 0x22u};
        const int nst = (u0 >= 128) ? 0 : (128 - u0) >> 5;
        attn_run_fast2<2>(A, qf, K, V, qp, vt, kt, lane, 6, rr + d * (u0 - 128), d, sk, mk, nst);
        if (uu + nslots < 768) qload(uu + nslots);
        asm volatile("" ::: "memory");
#pragma unroll
        for (int g = 0; g < 2; ++g) {
            const float lt = xadd32(A.l[g]);
            if (hh == 0) SL[((size_t)qp[g] * 8 + h) * 3 + br] = lt;
            { int lane2 = lane; asm volatile("" : "+v"(lane2));
              attn_store_rows2(A.o0[g], A.o1[g], 1.0f, ot, mix + (size_t)(rr + d * (u0 + 32 * g)) * MIXW + br * 512 + h * 64, (size_t)d * MIXW, lane2); }
        }
    }
}
__device__ __forceinline__ void swa_merge(unsigned char* ws, int tid, int G) {
    bf16* mix = (bf16*)(ws + WS_MIX); const float* SL = (const float*)(ws + WS_PS) + (size_t)SEQ * 8 * 3;
    for (int idx = bidx() * 512 + tid; idx < SEQ * 64; idx += G * 512) {
        const int q = idx >> 6, h = (idx >> 3) & 7, oc = idx & 7;
        bf16* p = mix + (size_t)q * MIXW + h * 64 + oc * 8;
        float o0[8], o1[8], o2[8]; unpack8(*(const v4u*)p, o0); unpack8(*(const v4u*)(p + 512), o1); unpack8(*(const v4u*)(p + 1024), o2);
        const float* sl = SL + ((size_t)q * 8 + h) * 3; const float inv = 1.0f / (sl[0] + sl[1] + sl[2]);
        float o[8];
#pragma unroll
        for (int i = 0; i < 8; ++i) o[i] = ((o0[i] + o1[i]) + o2[i]) * inv;
        v4u w; w.x = pk2(o[0], o[1]); w.y = pk2(o[2], o[3]); w.z = pk2(o[4], o[5]); w.w = pk2(o[6], o[7]);
        *(v4u*)p = w;
    }
}
__device__ __forceinline__ void top3_insert(float g, int n, float& v0, float& v1, float& v2, int& i0, int& i1, int& i2) {
    const bool c0 = g > v0, c1 = g > v1, c2 = g > v2;
    const float nv2 = c1 ? v1 : (c2 ? g : v2); const int ni2 = c1 ? i1 : (c2 ? n : i2);
    const float nv1 = c0 ? v0 : (c1 ? g : v1); const int ni1 = c0 ? i0 : (c1 ? n : i1);
    v0 = c0 ? g : v0; i0 = c0 ? n : i0; v1 = nv1; i1 = ni1; v2 = nv2; i2 = ni2;
}
__device__ __forceinline__ void gate_group(const LAS bf16* kmL, const bf16* Q, int tq, int qb, int r, int hh, int& o0, int& o1, int& o2) {
    bf16x8 qf[4];
#pragma unroll
    for (int k = 0; k < 4; ++k) qf[k] = *(const bf16x8*)(Q + (size_t)(tq + r) * 64 + k * 16 + hh * 8);
    float v0 = -INFINITY, v1 = -INFINITY, v2 = -INFINITY; int i0 = 0, i1 = 0, i2 = 0;
#pragma unroll
    for (int nt = 0; nt < 2; ++nt) {
        f32x16 X = f32x16{};
#pragma unroll
        for (int k = 0; k < 4; ++k) X = __builtin_amdgcn_mfma_f32_32x32x16_bf16(*(const LAS bf16x8*)(kmL + (nt * 32 + r) * 72 + k * 16 + hh * 8), qf[k], X, 0, 0, 0);
#pragma unroll
        for (int reg = 0; reg < 16; ++reg) { const int n = nt * 32 + (reg & 3) + 8 * (reg >> 2) + 4 * hh; top3_insert((n < qb) ? X[reg] : -INFINITY, n, v0, v1, v2, i0, i1, i2); }
    }
    float pa = v0, pb = v0, qa = v1, qb2 = v1, ra = v2, rb = v2; swap32(pa, pb); swap32(qa, qb2); swap32(ra, rb);
    float ia = __builtin_bit_cast(float, i0), ib = ia, ja = __builtin_bit_cast(float, i1), jb = ja, ka = __builtin_bit_cast(float, i2), kb = ka; swap32(ia, ib); swap32(ja, jb); swap32(ka, kb);
    const float ov0 = hh ? pa : pb, ov1 = hh ? qa : qb2, ov2 = hh ? ra : rb;
    const int oi0 = __builtin_bit_cast(int, hh ? ia : ib), oi1 = __builtin_bit_cast(int, hh ? ja : jb), oi2 = __builtin_bit_cast(int, hh ? ka : kb);
    top3_insert(ov0, oi0, v0, v1, v2, i0, i1, i2); top3_insert(ov1, oi1, v0, v1, v2, i0, i1, i2); top3_insert(ov2, oi2, v0, v1, v2, i0, i1, i2);
    o0 = i0; o1 = i1; o2 = i2;
}
__device__ __forceinline__ void moba_gate(const Args& a, int L, LAS unsigned char* lds, int tid, int G) {
    unsigned char* ws = wsp(a);
    const float* km = (const float*)(ws + WS_KMEAN); unsigned short* list = (unsigned short*)(ws + WS_LIST);
    unsigned* cnt = (unsigned*)(ws + WS_CTL) + CW_CNT + L * 512;
    LAS bf16* kmL = (LAS bf16*)lds;
    const int lane = tid & 63, wave = tid >> 6, r = lane & 31, hh = lane >> 5;
    for (int unit = bidx(); unit < 256; unit += G) {
        const int h = unit & 7, qc = unit >> 3, t0 = 512 * qc + 64 * wave, qb = t0 >> 8;
        __syncthreads();
        for (int i = tid; i < 1024; i += 512) { const f32x4 kv = (*(const f32x4*)(km + h * 4096 + 4 * i) + *(const f32x4*)(km + (8 + h) * 4096 + 4 * i)) * (1.0f / 256.0f);
            const int n = i >> 4, d4 = (i & 15) * 4; typedef unsigned u32x2 __attribute__((ext_vector_type(2)));
            *(LAS u32x2*)(kmL + n * 72 + d4) = (u32x2){pk2(kv.x, kv.y), pk2(kv.z, kv.w)}; }
        __syncthreads();
        const bf16* Q = (const bf16*)(ws + WS_QKV) + (size_t)(3 * 8 + h) * SEQ * 64;
        int a0, a1, a2, b0, b1, b2;
        gate_group(kmL, Q, t0, qb, r, hh, a0, a1, a2);
        gate_group(kmL, Q, t0 + 32, qb, r, hh, b0, b1, b2);
        const int nsel = qb < 3 ? qb : 3;
        LAS unsigned* hist = (LAS unsigned*)(lds + 16384); LAS unsigned* baseL = hist + 64;
        if (tid < 64) hist[tid] = 0u;
        __syncthreads();
        const int t = t0 + 32 * hh + r;
        const int j0 = hh ? b0 : a0, j1 = hh ? b1 : a1, j2 = hh ? b2 : a2;
        unsigned s0 = 0, s1 = 0, s2 = 0;
        if (nsel > 0) s0 = __hip_atomic_fetch_add(hist + j0, 1u, __ATOMIC_RELAXED, __HIP_MEMORY_SCOPE_WORKGROUP);
        if (nsel > 1) s1 = __hip_atomic_fetch_add(hist + j1, 1u, __ATOMIC_RELAXED, __HIP_MEMORY_SCOPE_WORKGROUP);
        if (nsel > 2) s2 = __hip_atomic_fetch_add(hist + j2, 1u, __ATOMIC_RELAXED, __HIP_MEMORY_SCOPE_WORKGROUP);
        __syncthreads();
        if (tid < 64) { const unsigned n = hist[tid]; baseL[tid] = n ? atomicAdd(cnt + h * 64 + tid, n) : 0u; }
        __syncthreads();
        if (nsel > 0) list[(size_t)(h * 64 + j0) * SEQ + baseL[j0] + s0] = (unsigned short)(t | (0 << 14));
        if (nsel > 1) list[(size_t)(h * 64 + j1) * SEQ + baseL[j1] + s1] = (unsigned short)(t | (1 << 14));
        if (nsel > 2) list[(size_t)(h * 64 + j2) * SEQ + baseL[j2] + s2] = (unsigned short)(t | (2 << 14));
    }
}
__device__ __forceinline__ void moba_bucket(const Args& a, int L, LAS unsigned char* lds, int tid, int lane, int wave, int G) {
    unsigned char* ws = wsp(a);
    const float nB = attn_negB(inp(a, I_QNM) + L * HD, inp(a, I_KNM) + L * HD, lane);
    const unsigned* cnt = (const unsigned*)(ws + WS_CTL) + CW_CNT + L * 512; const unsigned short* list = (const unsigned short*)(ws + WS_LIST);
    bf16* PO = (bf16*)(ws + WS_PO); float* PS = (float*)(ws + WS_PS);
    LAS int* pre = (LAS int*)(lds + 104 * 1024);
    LAS int* wsum = pre + 520;
    {
        const int n = (int)((__hip_atomic_load(cnt + tid, __ATOMIC_RELAXED, __HIP_MEMORY_SCOPE_AGENT) + 63u) >> 6);
        int inc = n;
#pragma unroll
        for (int o = 1; o < 64; o <<= 1) { const int t = __builtin_amdgcn_ds_bpermute(((lane - o) & 63) << 2, inc); if (lane >= o) inc += t;     }
        if (lane == 63) wsum[wave] = inc;
        __syncthreads();
        int base = 0;
#pragma unroll
        for (int w8 = 0; w8 < 8; ++w8) base += (w8 < wave) ? wsum[w8] : 0;
        pre[tid] = base + inc - n;
        if (tid == 511) pre[512] = base + inc;
        __syncthreads();
    }
    const int T = pre[512];
    LAS bf16* vt = (LAS bf16*)(lds + wave * 12800); LAS bf16* kt = (LAS bf16*)(lds + wave * 12800 + 4096); LAS bf16* ot = (LAS bf16*)(lds + wave * 12800 + 8192);
    const int r = lane & 31, hh = lane >> 5;
    typedef unsigned u32x2 __attribute__((ext_vector_type(2)));
    for (int ti = (int)bidx() * NWAVES + wave; ti < T; ti += G * NWAVES) {
        int lo = 0, hi = 512;
        while (hi - lo > 1) { const int mid = (lo + hi) >> 1; if (pre[mid] <= ti) lo = mid; else hi = mid; }
        const int bkt = lo, tq = ti - pre[bkt], h = bkt >> 6, j = bkt & 63;
        const int n = (int)__hip_atomic_load(cnt + bkt, __ATOMIC_RELAXED, __HIP_MEMORY_SCOPE_AGENT);
        const bf16* Q = (const bf16*)(ws + WS_QKV) + (size_t)(3 * 8 + h) * SEQ * 64; const bf16* K = (const bf16*)(ws + WS_QKV) + (size_t)(4 * 8 + h) * SEQ * 64;
        const bf16* V = (const bf16*)(ws + WS_QKV) + (size_t)(5 * 8 + h) * SEQ * 64;
        bool okr[2]; size_t slot[2]; bf16x8 qf[2][4];
#pragma unroll
        for (int g = 0; g < 2; ++g) {
            okr[g] = (64 * tq + 32 * g + r) < n;
            const unsigned e = okr[g] ? (unsigned)list[(size_t)bkt * SEQ + 64 * tq + 32 * g + r] : 0u;
            const int t = (int)(e & 16383u), ks = (int)(e >> 14);
            slot[g] = ((size_t)t * 8 + h) * 3 + ks;
#pragma unroll
            for (int k = 0; k < 4; ++k) qf[g][k] = *(const bf16x8*)(Q + (size_t)t * 64 + k * 16 + hh * 8);
        }
        AttnAcc2 A; attn_init2(A, nB);
        const int qpd[2] = {0, 0}; const unsigned sk[2] = {0u, (64 * tq + 32 < n) ? 0u : 0xffu}, mk[2] = {0u, 0u};
        attn_run_fast2<0>(A, qf, K, V, qpd, vt, kt, lane, 8, 256 * j, 1, sk, mk);
#pragma unroll
        for (int g = 0; g < 2; ++g) {
            if (g == 1 && !(64 * tq + 32 < n)) break;
            const float lt = xadd32(A.l[g]), sc = 1.0f / lt;
#pragma unroll
            for (int q = 0; q < 4; ++q) { const int db = 8 * q + 4 * hh;
                    *(LAS u32x2*)(ot + r * 68 + db) = (u32x2){cvtpk(A.o0[g][4 * q] * sc, A.o0[g][4 * q + 1] * sc), cvtpk(A.o0[g][4 * q + 2] * sc, A.o0[g][4 * q + 3] * sc)};
                    *(LAS u32x2*)(ot + r * 68 + 32 + db) = (u32x2){cvtpk(A.o1[g][4 * q] * sc, A.o1[g][4 * q + 1] * sc), cvtpk(A.o1[g][4 * q + 2] * sc, A.o1[g][4 * q + 3] * sc)}; }
            if (okr[g] && hh == 0) PS[slot[g]] = lt;
            LDS_WAIT(); asm volatile("" ::: "memory");
#pragma unroll
            for (int k = 0; k < 4; ++k) { const int id = lane + 64 * k, row = id >> 3, oc = id & 7;
                const unsigned slo = (unsigned)__builtin_amdgcn_ds_bpermute(row << 2, (int)(unsigned)slot[g]), shi = (unsigned)__builtin_amdgcn_ds_bpermute(row << 2, (int)(unsigned)(slot[g] >> 32));
                const unsigned long long srow = ((unsigned long long)shi << 32) | slo;
                const int okrow = __builtin_amdgcn_ds_bpermute(row << 2, (int)okr[g]);
                const u32x2 lo2 = *(const LAS u32x2*)(ot + row * 68 + oc * 8), hi2 = *(const LAS u32x2*)(ot + row * 68 + oc * 8 + 4);
                if (okrow) *(v4u*)(PO + (size_t)srow * 64 + oc * 8) = (v4u){lo2.x, lo2.y, hi2.x, hi2.y}; }
            LDS_WAIT(); asm volatile("" ::: "memory");
        }
    }
}
__device__ __forceinline__ void moba_bucket_wg(const Args& a, int L, LAS unsigned char* lds, int tid, int lane, int wave, int G) {
    unsigned char* ws = wsp(a);
    const float nB = attn_negB(inp(a, I_QNM) + L * HD, inp(a, I_KNM) + L * HD, lane);
    const unsigned* cnt = (const unsigned*)(ws + WS_CTL) + CW_CNT + L * 512; const unsigned short* list = (const unsigned short*)(ws + WS_LIST);
    bf16* PO = (bf16*)(ws + WS_PO); float* PS = (float*)(ws + WS_PS);
    LAS int* pre = (LAS int*)(lds + 104 * 1024);
    LAS int* wsum = pre + 520;
    {
        const int n = (int)((((__hip_atomic_load(cnt + tid, __ATOMIC_RELAXED, __HIP_MEMORY_SCOPE_AGENT) + 63u) >> 6) + 7u) >> 3);
        int inc = n;
#pragma unroll
        for (int o = 1; o < 64; o <<= 1) { const int t = __builtin_amdgcn_ds_bpermute(((lane - o) & 63) << 2, inc); if (lane >= o) inc += t;     }
        if (lane == 63) wsum[wave] = inc;
        __syncthreads();
        int base = 0;
#pragma unroll
        for (int w8 = 0; w8 < 8; ++w8) base += (w8 < wave) ? wsum[w8] : 0;
        pre[tid] = base + inc - n;
        if (tid == 511) pre[512] = base + inc;
        __syncthreads();
    }
    const int T = pre[512];
    LAS bf16* ktS = (LAS bf16*)lds; LAS bf16* vtS = (LAS bf16*)(lds + 32768); LAS bf16* ot = (LAS bf16*)(lds + 65536 + wave * 4608);
    const int r = lane & 31, hh = lane >> 5;
    typedef unsigned u32x2 __attribute__((ext_vector_type(2)));
    const int lrow = tid >> 3, loc = tid & 7, lkey = lrow & 31;
    LAS bf16* kw = ktS + (lrow >> 5) * 2048 + lkey * 64 + ((loc ^ ((lkey >> 1) & 7)) * 8); LAS bf16* vw = vtS + (lrow >> 5) * 2048 + lkey * 64 + ((loc ^ (4 * ((lkey >> 1) & 1))) * 8);
    v4u kr[4], vr[4];
    int it = (int)bidx();
    auto find = [&](int item, int& bkt, int& grp) { int lo = 0, hi = 512; while (hi - lo > 1) { const int mid = (lo + hi) >> 1; if (pre[mid] <= item) lo = mid; else hi = mid; }
        bkt = __builtin_amdgcn_readfirstlane(lo); grp = __builtin_amdgcn_readfirstlane(item - pre[lo]); };
    auto fetch = [&](int bkt) { const int h = bkt >> 6, j = bkt & 63;
        const bf16* Kb = (const bf16*)(ws + WS_QKV) + ((size_t)(4 * 8 + h) * SEQ + 256 * j) * 64 + (size_t)lrow * 64 + loc * 8; const bf16* Vb = Kb + (size_t)8 * SEQ * 64;
#pragma unroll
        for (int i = 0; i < 4; ++i) { kr[i] = *(const v4u*)(Kb + (size_t)i * 64 * 64); vr[i] = *(const v4u*)(Vb + (size_t)i * 64 * 64); } };
    int bkt = 0, grp = 0;
    if (it < T) { find(it, bkt, grp); fetch(bkt); }
    while (it < T) {
        __syncthreads();
#pragma unroll
        for (int i = 0; i < 4; ++i) { *(LAS v4u*)(kw + i * 4096) = kr[i]; *(LAS v4u*)(vw + i * 4096) = vr[i]; }
        __syncthreads();
        const int cb = bkt, cg = grp;
        it += G;
        if (it < T) { find(it, bkt, grp); fetch(bkt); }
        const int h = cb >> 6, tq = 8 * cg + wave;
        const int n = (int)__hip_atomic_load(cnt + cb, __ATOMIC_RELAXED, __HIP_MEMORY_SCOPE_AGENT);
        if (64 * tq < n) {
            const bf16* Q = (const bf16*)(ws + WS_QKV) + (size_t)(3 * 8 + h) * SEQ * 64;
            bool okr[2]; size_t slot[2]; bf16x8 qf[2][4];
#pragma unroll
            for (int g = 0; g < 2; ++g) {
                okr[g] = (64 * tq + 32 * g + r) < n;
                const unsigned e = okr[g] ? (unsigned)list[(size_t)cb * SEQ + 64 * tq + 32 * g + r] : 0u;
                const int t = (int)(e & 16383u), ks = (int)(e >> 14);
                slot[g] = ((size_t)t * 8 + h) * 3 + ks;
#pragma unroll
                for (int k = 0; k < 4; ++k) qf[g][k] = *(const bf16x8*)(Q + (size_t)t * 64 + k * 16 + hh * 8);
            }
            AttnAcc2 A; attn_init2(A, nB);
            const unsigned sk[2] = {0u, (64 * tq + 32 < n) ? 0u : 0xffu};
            attn_run_lds2(A, qf, ktS, vtS, lane, 8, sk);
#pragma unroll
            for (int g = 0; g < 2; ++g) {
                if (g == 1 && !(64 * tq + 32 < n)) break;
                const float lt = xadd32(A.l[g]), sc = 1.0f / lt;
#pragma unroll
                for (int q = 0; q < 4; ++q) { const int db = 8 * q + 4 * hh;
                    *(LAS u32x2*)(ot + r * 68 + db) = (u32x2){cvtpk(A.o0[g][4 * q] * sc, A.o0[g][4 * q + 1] * sc), cvtpk(A.o0[g][4 * q + 2] * sc, A.o0[g][4 * q + 3] * sc)};
                    *(LAS u32x2*)(ot + r * 68 + 32 + db) = (u32x2){cvtpk(A.o1[g][4 * q] * sc, A.o1[g][4 * q + 1] * sc), cvtpk(A.o1[g][4 * q + 2] * sc, A.o1[g][4 * q + 3] * sc)}; }
                if (okr[g] && hh == 0) PS[slot[g]] = lt;
                LDS_WAIT(); asm volatile("" ::: "memory");
                {
                    const int sv = (int)((unsigned)slot[g] | (okr[g] ? 0x80000000u : 0u));
                    int sr[4]; u32x2 lo2[4], hi2[4];
#pragma unroll
                    for (int k = 0; k < 4; ++k) { const int id = lane + 64 * k, row = id >> 3, oc = id & 7;
                        sr[k] = __builtin_amdgcn_ds_bpermute(row << 2, sv);
                        lo2[k] = *(const LAS u32x2*)(ot + row * 68 + oc * 8); hi2[k] = *(const LAS u32x2*)(ot + row * 68 + oc * 8 + 4); }
                    asm volatile("" : "+v"(sr[0]), "+v"(sr[1]), "+v"(sr[2]), "+v"(sr[3]), "+v"(lo2[0]), "+v"(lo2[1]), "+v"(lo2[2]), "+v"(lo2[3]), "+v"(hi2[0]), "+v"(hi2[1]), "+v"(hi2[2]), "+v"(hi2[3]));
#pragma unroll
                    for (int k = 0; k < 4; ++k) { const int oc = (lane + 64 * k) & 7;
                        if (sr[k] < 0) *(v4u*)(PO + (size_t)(sr[k] & 0x7fffffff) * 64 + oc * 8) = (v4u){lo2[k].x, lo2[k].y, hi2[k].x, hi2[k].y}; }
                }
                LDS_WAIT(); asm volatile("" ::: "memory");
            }
        }
    }
}
__device__ __forceinline__ void moba_final(const Args& a, int L, LAS unsigned char* lds, int lane, int wave, int G) {
    unsigned char* ws = wsp(a);
    const float nB = attn_negB(inp(a, I_QNM) + L * HD, inp(a, I_KNM) + L * HD, lane);
    const int h = (int)bidx() & 7, slot0 = ((int)bidx() >> 3) * NWAVES + wave, nslots = (G >> 3) * NWAVES;
    const bf16* Q = (const bf16*)(ws + WS_QKV) + (size_t)(3 * 8 + h) * SEQ * 64; const bf16* K = (const bf16*)(ws + WS_QKV) + (size_t)(4 * 8 + h) * SEQ * 64;
    const bf16* V = (const bf16*)(ws + WS_QKV) + (size_t)(5 * 8 + h) * SEQ * 64;
    const bf16* PO = (const bf16*)(ws + WS_PO); const float* PS = (const float*)(ws + WS_PS);
    bf16* mix = (bf16*)(ws + WS_MIX);
    LAS bf16* vt = (LAS bf16*)(lds + wave * 12800); LAS bf16* kt = (LAS bf16*)(lds + wave * 12800 + 4096); LAS bf16* ot = (LAS bf16*)(lds + wave * 12800 + 8192);
    const int r = lane & 31, hh = lane >> 5;
    typedef unsigned u32x2 __attribute__((ext_vector_type(2)));
    for (int uu = slot0; uu < 256; uu += nslots) {
        const int t0 = 64 * uu, qb = t0 >> 8, nsel = qb < 3 ? qb : 3;
        bf16x8 qf[2][4]; int qp[2];
#pragma unroll
        for (int g = 0; g < 2; ++g) { qp[g] = t0 + 32 * g + r;
#pragma unroll
            for (int k = 0; k < 4; ++k) qf[g][k] = *(const bf16x8*)(Q + (size_t)qp[g] * 64 + k * 16 + hh * 8); }
        AttnAcc2 A; attn_init2(A, nB);
        const int ntile = ((t0 & 255) >> 5) + 2;
        const unsigned sk[2] = {1u << (ntile - 1), 0u}, mk[2] = {1u << (ntile - 2), 1u << (ntile - 1)};
        attn_run_fast2<1>(A, qf, K, V, qp, vt, kt, lane, ntile, 256 * qb, 1, sk, mk);
        v4u pn[4]; float wn = 0.f;
        auto req = [&](int g, int k) {
            wn = PS[((size_t)qp[g] * 8 + h) * 3 + k];
#pragma unroll
            for (int kk2 = 0; kk2 < 4; ++kk2) { const int id = lane + 64 * kk2, row = id >> 3, oc = id & 7;
                pn[kk2] = *(const v4u*)(PO + (((size_t)(t0 + 32 * g + row) * 8 + h) * 3 + k) * 64 + oc * 8); } };
        if (nsel > 0) req(0, 0);
#pragma unroll
        for (int g = 0; g < 2; ++g) {
            float lt = xadd32(A.l[g]);
#pragma unroll
            for (int k = 0; k < 3; ++k) {
                if (k < nsel) {
                    const float wk = wn; lt += wk;
#pragma unroll
                    for (int kk2 = 0; kk2 < 4; ++kk2) { const int id = lane + 64 * kk2, row = id >> 3, oc = id & 7;
                        const v4u p4 = pn[kk2];
                        *(LAS u32x2*)(ot + row * 68 + oc * 8) = (u32x2){p4.x, p4.y}; *(LAS u32x2*)(ot + row * 68 + oc * 8 + 4) = (u32x2){p4.z, p4.w}; }
                    if (k + 1 < nsel) req(g, k + 1); else if (g == 0) req(1, 0);
                    LDS_WAIT(); asm volatile("" ::: "memory");
#pragma unroll
                    for (int q = 0; q < 4; ++q) { const int db = 8 * q + 4 * hh; const u32x2 pa = *(const LAS u32x2*)(ot + r * 68 + db), pb = *(const LAS u32x2*)(ot + r * 68 + 32 + db);
                        A.o0[g][4 * q] += wk * bflo(pa.x); A.o0[g][4 * q + 1] += wk * bfhi(pa.x); A.o0[g][4 * q + 2] += wk * bflo(pa.y); A.o0[g][4 * q + 3] += wk * bfhi(pa.y);
                        A.o1[g][4 * q] += wk * bflo(pb.x); A.o1[g][4 * q + 1] += wk * bfhi(pb.x); A.o1[g][4 * q + 2] += wk * bflo(pb.y); A.o1[g][4 * q + 3] += wk * bfhi(pb.y); }
                    LDS_WAIT(); asm volatile("" ::: "memory");
                }
            }
            attn_store_rows2(A.o0[g], A.o1[g], 1.0f / lt, ot, mix + (size_t)(t0 + 32 * g) * MIXW + 1024 + h * 64, (size_t)MIXW, lane);
        }
    }
}
__device__ __forceinline__ void mixer_phase(const Args& a, int L, LAS unsigned char* lds, int tid, int lane, int wave, int G) {
    if (!FLG(a, 16)) ssd_states(wsp(a), (const unsigned char*)outp(a), lane, (int)bidx() * NWAVES + wave, G * NWAVES);
    if (!FLG(a, 1)) moba_gate(a, L, lds, tid, G);
    __syncthreads();
    if (!FLG(a, 32)) swa_pass(a, L, lds, lane, wave, G);
}

#ifdef TSPROBE
#define TSP_LASTBAR 1
#else
#define TSP_LASTBAR 0
#endif
__global__ void __launch_bounds__(NWAVES * 64, 2) mk_fwd(Args args) {
    extern __shared__ __attribute__((aligned(16))) unsigned char lds_raw[];
    LAS unsigned char* lds_k = (LAS unsigned char*)lds_raw;
    volatile LAS unsigned* MISC = (volatile LAS unsigned*)(lds_k + MISC_OFF);
    const int G_k = gridDim.x, wave0 = __builtin_amdgcn_readfirstlane(threadIdx.x >> 6);
    gu32* ctl = (gu32*)(wsp(args) + WS_CTL);
    for (int u = threadIdx.x; u < (LDS_BYTES - LDSCTL_OFF) / 4; u += NWAVES * 64) ((LAS unsigned*)(lds_k + LDSCTL_OFF))[u] = 0u;
    __syncthreads();
    XcdBarrier bar; bar.bar = (unsigned*)(ctl + CW_BAR); bar.x = 0; bar.st = nullptr; bar.wave = 1;
    const bool fused = (args.ph_hi - args.ph_lo) > 1;
    if (fused) bar = xcd_barrier_post((unsigned*)(ctl + CW_BAR), MISC + 8);
    bar.wave = wave0;
    if (threadIdx.x == 0) MISC[10] = bar.x;
    __syncthreads();
#ifdef TSPROBE
    unsigned long long* tsb = (unsigned long long*)(wsp(args) + WS_CTL + 448 * 1024);
    if (bidx() == 0 && threadIdx.x == 0) tsb[63] = __builtin_amdgcn_s_memrealtime();
#define TSTAMP(i) do { if (bidx() == 0 && wave0 == 0 && (int)__builtin_amdgcn_mbcnt_hi(~0u, __builtin_amdgcn_mbcnt_lo(~0u, opq0())) == 0) tsb[i] = __builtin_amdgcn_s_memrealtime(); } while (0)
#else
#define TSTAMP(i) do {} while (0)
#endif
    int ph0 = args.ph_lo;
    if (ph0 == 0) {
        { int lane = (int)__builtin_amdgcn_mbcnt_hi(~0u, __builtin_amdgcn_mbcnt_lo(~0u, opq0())); asm volatile("" : "+v"(lane)); p0_prologue(args, lds_k, wave0 * 64 + lane, lane, wave0, G_k); }
        if (1 < args.ph_hi) { XcdBarrier b2; b2.bar = (unsigned*)((gu32*)(wsp(args) + WS_CTL) + CW_BAR); b2.wave = wave0; asm volatile("" : "+s"(b2.wave)); b2.x = (unsigned)__builtin_amdgcn_readfirstlane((int)*(volatile LAS unsigned*)(lds_k + MISC_OFF + 40)); { int mo_ = MISC_OFF + 32; asm volatile("" : "+s"(mo_)); b2.st = (volatile LAS unsigned*)(lds_k + mo_); } xcd_barrier(b2); }
        TSTAMP(0);
        ph0 = 1;
    }
    if (ph0 == 1 && ph0 < args.ph_hi) {
        { int lane = (int)__builtin_amdgcn_mbcnt_hi(~0u, __builtin_amdgcn_mbcnt_lo(~0u, opq0())); asm volatile("" : "+v"(lane)); p0_weights(args, lds_k, lane, wave0, G_k); }
        if (2 < args.ph_hi) { XcdBarrier b2; b2.bar = (unsigned*)((gu32*)(wsp(args) + WS_CTL) + CW_BAR); b2.wave = wave0; asm volatile("" : "+s"(b2.wave)); b2.x = (unsigned)__builtin_amdgcn_readfirstlane((int)*(volatile LAS unsigned*)(lds_k + MISC_OFF + 40)); { int mo_ = MISC_OFF + 32; asm volatile("" : "+s"(mo_)); b2.st = (volatile LAS unsigned*)(lds_k + mo_); } xcd_barrier(b2); }
        TSTAMP(1);
        ph0 = 2;
    }
#define PHW() ({ int w_ = wave0; asm volatile("" : "+s"(w_)); (volatile LAS int*)(lds_k + MISC_OFF + 64) + w_; })
    *PHW() = ph0;
    for (;;) {
        const int ph = __builtin_amdgcn_readfirstlane(*PHW());
        if (ph >= args.ph_hi || FLG(args, 2)) break;
        LAS unsigned char* lds = lds_k; int G = G_k; asm volatile("" : "+s"(lds), "+s"(G));
        unsigned char* ws = wsp(args);
        bf16* hb = (bf16*)(ws + WS_H);
#define LANE_TID() int lane = (int)__builtin_amdgcn_mbcnt_hi(~0u, __builtin_amdgcn_mbcnt_lo(~0u, opq0())); asm volatile("" : "+v"(lane)); int wave_ = wave0; asm volatile("" : "+s"(wave_)); const int wave = wave_, tid = wave * 64 + lane; (void)tid
#define MD() ((const float*)(wsp(args) + WS_MOD) + L * 6144)
#define CTLF() ((float*)(wsp(args) + WS_CTL))
        {
            const int L = (ph - PH0) / PH_PER_LAYER, k = (ph - PH0) % PH_PER_LAYER;
            if (k == 0) {
                pg8::Gemm g{hb, (const bf16*)(ws + WS_WIN) + (size_t)L * INP_PAD * DM, SEQ, INP_PAD, DM}; pg8::StaticOrder S; S.init(SEQ, INP_PAD, G, (int)bidx());
                LANE_TID(); pg8::EpiIn E{args, L};
                pg8::gemm_phase<pg8::EpiIn, pg8::StaticOrder, true, true, DM>(lds, g, S, E, wave);
            }
            else if (k == 1) { LANE_TID(); prep_phase(args, L, lds, tid, G); }
            else if (k == 2) { LANE_TID(); mixer_phase(args, L, lds, tid, lane, wave, G); }
            else if (k == 3) { LANE_TID(); if (!FLG(args, 1)) ssd_scan(ws, (unsigned char*)outp(args), lds, tid, G); swa_merge(ws, tid, G); moba_bucket_wg(args, L, lds, tid, lane, wave, G); }
            else if (k == 4) { LANE_TID(); if (!FLG(args, 4)) ssd_out(args, L, lds, lane, wave, G); __syncthreads(); if (!FLG(args, 8)) moba_final(args, L, lds, lane, wave, G); }
            else if (k == 5) {
                pg8::Gemm g{(const bf16*)(ws + WS_MIX), (const bf16*)(ws + WS_WOUT) + (size_t)L * DM * MIXW, SEQ, DM, MIXW}; pg8::StaticOrder S; S.init(SEQ, DM, G, (int)bidx());
                LANE_TID(); pg8::EpiRes E{nullptr, MD() + 2048, hb, CTLF() + CW_RSS + (L * 2 + 1) * SEQ};
                pg8::gemm_phase<pg8::EpiRes, pg8::StaticOrder, true, true, MIXW>(lds, g, S, E, wave);
            }
            else if (k == 6) {
                pg8::Gemm g{hb, (const bf16*)(ws + WS_WGU) + (size_t)L * GU * DM, SEQ, GU, DM}; pg8::StaticOrder S; S.init(SEQ, GU, G, (int)bidx());
                LANE_TID(); pg8::EpiSwiglu E{(bf16*)(ws + WS_HID), CTLF() + CW_RSS + (L * 2 + 1) * SEQ, CTLF() + CW_BIAS_GU + L * GU};
                pg8::gemm_phase<pg8::EpiSwiglu, pg8::StaticOrder, true, true, DM>(lds, g, S, E, wave);
            }
            else {
                pg8::Gemm g{(const bf16*)(ws + WS_HID), (const bf16*)(ws + WS_WDN) + (size_t)L * DM * FFN, SEQ, DM, FFN}; pg8::StaticOrder S; S.init(SEQ, DM, G, (int)bidx());
                LANE_TID(); pg8::EpiRes E{(L == DEPTH - 1) ? outp(args) : nullptr, MD() + 5120, hb, (L < DEPTH - 1) ? CTLF() + CW_RSS + ((L + 1) * 2 + 0) * SEQ : nullptr};
                pg8::gemm_phase<pg8::EpiRes, pg8::StaticOrder, true, true, FFN>(lds, g, S, E, wave);
            }
        }
        const int ph2 = __builtin_amdgcn_readfirstlane(*PHW()); *PHW() = ph2 + 1;
        if (ph2 + 1 < args.ph_hi || TSP_LASTBAR) { XcdBarrier b2; b2.bar = (unsigned*)((gu32*)(wsp(args) + WS_CTL) + CW_BAR); b2.wave = wave0; asm volatile("" : "+s"(b2.wave)); b2.x = (unsigned)__builtin_amdgcn_readfirstlane((int)*(volatile LAS unsigned*)(lds_k + MISC_OFF + 40)); { int mo_ = MISC_OFF + 32; asm volatile("" : "+s"(mo_)); b2.st = (volatile LAS unsigned*)(lds_k + mo_); } xcd_barrier(b2); }
        TSTAMP(ph2);
    }
}

#ifdef TSPROBE
__global__ void tsp_emit(Args args) {
    const unsigned long long* tsb = (const unsigned long long*)((const unsigned char*)args.p[N_IN + 1] + WS_CTL + 448 * 1024);
    float T1 = 0.f, T2 = 0.f;
    for (int L = 0; L < DEPTH; ++L) {
        if (TSP_K1 < PH_PER_LAYER) { const int p = PH0 + L * PH_PER_LAYER + TSP_K1; T1 += (float)(tsb[p] - tsb[p - 1]) * 0.01f; }
        if (TSP_K2 < PH_PER_LAYER) { const int p = PH0 + L * PH_PER_LAYER + TSP_K2; T2 += (float)(tsb[p] - tsb[p - 1]) * 0.01f; }
    }
    if (TSP_K1 == 10) T1 = (float)(tsb[1] - tsb[63]) * 0.01f;
    if (TSP_K2 == 10) T2 = (float)(tsb[1] - tsb[63]) * 0.01f;
    if (TSP_K1 == 11) T1 = 100.f;
    if (TSP_K2 == 11) T2 = 100.f;
    float* o = (float*)args.p[N_IN];
    const int gt = bidx() * blockDim.x + threadIdx.x;
    if (gt == 0) o[0] += T1 * 0.005f;
    for (int i = 1 + gt; i <= 262144; i += gridDim.x * blockDim.x) o[64 * i - 1] += floorf(T2 * 0.125f + 0.5f) * 8.0f * TSP_SCALE;
}
#endif
extern "C" void kernel_launch(void* const* d_in, const int* in_sizes, int n_in, void* d_out, int out_size, void* d_ws, size_t ws_size, hipStream_t stream) {
    static int grid = 0;
    if (grid == 0) {
        if (n_in != N_IN || in_sizes[0] != SEQ * DM || out_size != SEQ * DM || ws_size < WS_END) { fprintf(stderr, "kernel_launch: unexpected shapes (n_in %d, in0 %d, out %d, ws %zu < %zu)\n", n_in, n_in > 0 ? in_sizes[0] : -1, out_size, ws_size, (size_t)WS_END); grid = -1; return; }
        int dev = 0, cus = 0, per_cu = 0;
        if (hipGetDevice(&dev) != hipSuccess || hipDeviceGetAttribute(&cus, hipDeviceAttributeMultiprocessorCount, dev) != hipSuccess) { grid = -1; return; }
        if (hipFuncSetAttribute((const void*)mk_fwd, hipFuncAttributeMaxDynamicSharedMemorySize, LDS_BYTES) != hipSuccess) { fprintf(stderr, "kernel_launch: hipFuncSetAttribute failed\n"); grid = -1; return; }
        if (hipOccupancyMaxActiveBlocksPerMultiprocessor(&per_cu, (const void*)mk_fwd, NWAVES * 64, LDS_BYTES) != hipSuccess || per_cu < 1) { fprintf(stderr, "kernel_launch: occupancy query says %d\n", per_cu); per_cu = 1; }
        (void)hipGetLastError();
        grid = cus;
        if (grid != 256) { fprintf(stderr, "kernel_launch: expected 256 CUs, got %d\n", grid); if (grid > 256) grid = 256; if (grid < 64 || (grid & 7)) { grid = -1; return; } }
    }
    if (grid < 0) return;
    if (hipMemsetAsync((char*)d_ws + WS_CTL, 0, CTL_ZERO_BYTES, stream) != hipSuccess) return;
    Args a{};
    for (int i = 0; i < N_IN; ++i) a.p[i] = d_in[i];
    a.p[N_IN] = d_out; a.p[N_IN + 1] = d_ws; a.p[N_IN + 2] = nullptr;
#if MK_ONE_LAUNCH
    a.ph_lo = 0; a.ph_hi = N_PHASES;
    hipLaunchKernelGGL(mk_fwd, dim3(grid), dim3(NWAVES * 64), LDS_BYTES, stream, a);
#ifdef TSPROBE
    hipLaunchKernelGGL(tsp_emit, dim3(64), dim3(256), 0, stream, a);
#endif
#else
    for (int ph = 0; ph < N_PHASES; ++ph) { a.ph_lo = ph; a.ph_hi = ph + 1;
#ifdef PROBE_K
        if ((ph >= PH0 && (ph - PH0) % PH_PER_LAYER == PROBE_K) || (ph < PH0 && PROBE_K == 100)) { a.flags = PROBE_FLAGS; for (int rep = 0; rep < PROBE_N; ++rep) hipLaunchKernelGGL(mk_fwd, dim3(grid), dim3(NWAVES * 64), LDS_BYTES, stream, a); }
#endif
        a.flags = 0; hipLaunchKernelGGL(mk_fwd, dim3(grid), dim3(NWAVES * 64), LDS_BYTES, stream, a);
    }
#endif
}
```
